# Optimizing an MI355X kernel written in HIP

```python
import jax, jax.numpy as jnp
from jax import lax
import numpy as np

D_MODEL = 4096
BATCH = 4
SEQ = 4096
DEPTH = 4

GLA_HEADS = 8
GLA_DK = 128
GLA_DV = 256
GLA_QK_WIDTH = GLA_HEADS * GLA_DK
GLA_V_WIDTH = GLA_HEADS * GLA_DV
GLA_DECAY_RANK = 16
GLA_GATE_NORMALIZER = 16.0
GLA_LOG_DECAY_MIN = -1.0
GLA_CHUNK = 64
SWA_Q_HEADS = 32
SWA_KV_HEADS = 8
SWA_HEAD_DIM = 64
SWA_WINDOW = 128
SWA_Q_WIDTH = SWA_Q_HEADS * SWA_HEAD_DIM
SWA_KV_WIDTH = SWA_KV_HEADS * SWA_HEAD_DIM

IN_SPLITS = (GLA_QK_WIDTH, GLA_QK_WIDTH, GLA_V_WIDTH, GLA_V_WIDTH, GLA_DECAY_RANK,
             SWA_Q_WIDTH, SWA_KV_WIDTH, SWA_KV_WIDTH, SWA_Q_WIDTH, D_MODEL, D_MODEL)
IN_WIDTH = sum(IN_SPLITS)
RMS_EPS = 1e-6

kernel_name = "gla_swa_sink_gated_hybrid"


def rms_norm(x, g):
    xf = x.astype(jnp.float32)
    y = xf * lax.rsqrt(jnp.mean(xf * xf, axis=-1, keepdims=True) + RMS_EPS)
    return (y * g.astype(jnp.float32)).astype(x.dtype)


def split_columns(z, sizes):
    out, off = [], 0
    for s in sizes:
        out.append(z[..., off:off + s])
        off += s
    return out


def gla_mix(q, k, v, log_a):
    B_, S_, H, DK = q.shape
    DV = v.shape[-1]
    C = GLA_CHUNK
    N = S_ // C

    def chunk(t):
        return t.astype(jnp.float32).reshape(B_, N, C, H, t.shape[-1]).transpose(0, 3, 1, 2, 4)

    qf = chunk(q) * (DK ** -0.5)
    kf, vf, la = chunk(k), chunk(v), chunk(log_a)
    b = jnp.cumsum(la, axis=3)
    b_ref = b[:, :, :, C // 2:C // 2 + 1]
    b_last = b[:, :, :, C - 1:C]
    A = jnp.einsum('bhnid,bhnjd->bhnij', qf * jnp.exp(b - b_ref), kf * jnp.exp(b_ref - b))
    causal = jnp.tril(jnp.ones((C, C), dtype=bool))
    A = jnp.where(causal, A, 0.0)
    o_intra = jnp.einsum('bhnij,bhnjv->bhniv', A, vf)
    q_inter = qf * jnp.exp(b)
    k_state = kf * jnp.exp(b_last - b)
    decay = jnp.exp(b_last[:, :, :, 0, :])

    def step(state, xs):
        qn, kn, vn, dn = xs
        o = jnp.einsum('bhcd,bhdv->bhcv', qn, state)
        state = dn[..., None] * state + jnp.einsum('bhcd,bhcv->bhdv', kn, vn)
        return state, o

    xs = (jnp.moveaxis(q_inter, 2, 0), jnp.moveaxis(k_state, 2, 0),
          jnp.moveaxis(vf, 2, 0), jnp.moveaxis(decay, 2, 0))
    s0 = jnp.zeros((B_, H, DK, DV), jnp.float32)
    _, o_inter = lax.scan(step, s0, xs)
    o = o_intra + jnp.moveaxis(o_inter, 0, 2)
    return o.transpose(0, 2, 3, 1, 4).reshape(B_, S_, H, DV)


def swa_sink_mix(q, k, v, sinks):
    B_, S_, HQ, HD = q.shape
    G = SWA_KV_HEADS
    R = HQ // G
    W = SWA_WINDOW
    N = S_ // W
    qb = q.astype(jnp.float32).reshape(B_, N, W, G, R, HD)

    def band(t):
        tp = jnp.pad(t.astype(jnp.float32), ((0, 0), (W, 0), (0, 0), (0, 0))).reshape(B_, N + 1, W, G, HD)
        return jnp.concatenate([tp[:, :-1], tp[:, 1:]], axis=2)

    kb, vb = band(k), band(v)
    s = jnp.einsum('bnqgrd,bnkgd->bngrqk', qb, kb) * (HD ** -0.5)
    qi = jnp.arange(W)[:, None]
    kj = jnp.arange(2 * W)[None, :]
    local = (kj > qi) & (kj <= qi + W)
    key_pos = jnp.arange(N)[:, None, None] * W + kj[None] - W
    valid = local[None] & (key_pos >= 0)
    s = jnp.where(valid[None, :, None, None], s, jnp.finfo(jnp.float32).min)
    sink = sinks.astype(jnp.float32).reshape(1, 1, G, R, 1, 1)
    m = jnp.maximum(jnp.max(s, axis=-1, keepdims=True), sink)
    p = jnp.exp(s - m)
    probs = p / (jnp.sum(p, axis=-1, keepdims=True) + jnp.exp(sink - m))
    o = jnp.einsum('bngrqk,bnkgd->bnqgrd', probs, vb)
    return o.reshape(B_, S_, HQ * HD)


def setup_inputs(seed: int = 0) -> dict:
    key = jax.random.key(seed)
    ks = jax.random.split(key, 13)
    f32 = jnp.float32
    x = jax.random.normal(ks[0], (BATCH, SEQ, D_MODEL), f32)
    norm_gains = 1.0 + 0.02 * jax.random.normal(ks[1], (DEPTH, D_MODEL), f32)
    w_in = jax.random.normal(ks[2], (DEPTH, D_MODEL, IN_WIDTH), f32) * D_MODEL ** -0.5
    b_gates = 0.1 * jax.random.normal(ks[3], (DEPTH, 2, D_MODEL), f32)
    w_decay_up = jax.random.normal(ks[4], (DEPTH, GLA_DECAY_RANK, GLA_QK_WIDTH), f32) * GLA_DECAY_RANK ** -0.5
    b_decay = 0.1 * jax.random.normal(ks[5], (DEPTH, GLA_QK_WIDTH), f32)
    gla_norm_gains = 1.0 + 0.02 * jax.random.normal(ks[6], (DEPTH, GLA_DV), f32)
    sinks = 0.5 * jax.random.normal(ks[7], (DEPTH, SWA_Q_HEADS), f32)
    w_gla_out = jax.random.normal(ks[8], (DEPTH, GLA_V_WIDTH, D_MODEL), f32) * GLA_V_WIDTH ** -0.5
    w_swa_out = jax.random.normal(ks[9], (DEPTH, SWA_Q_WIDTH, D_MODEL), f32) * SWA_Q_WIDTH ** -0.5
    w_out = jax.random.normal(ks[10], (DEPTH, D_MODEL, D_MODEL), f32) * D_MODEL ** -0.5
    final_norm_gain = 1.0 + 0.02 * jax.random.normal(ks[11], (D_MODEL,), f32)
    return {"x": x, "norm_gains": norm_gains, "w_in": w_in, "b_gates": b_gates,
            "w_decay_up": w_decay_up, "b_decay": b_decay, "gla_norm_gains": gla_norm_gains,
            "sinks": sinks, "w_gla_out": w_gla_out, "w_swa_out": w_swa_out,
            "w_out": w_out, "final_norm_gain": final_norm_gain}


def reference(x, norm_gains, w_in, b_gates, w_decay_up, b_decay, gla_norm_gains,
              sinks, w_gla_out, w_swa_out, w_out, final_norm_gain):
    B_, S_, _ = x.shape
    for l in range(DEPTH):
        h = rms_norm(x, norm_gains[l])
        z = h @ w_in[l]
        (gq, gk, gv, gg, gdec, sq, sk, sv, sg, ga, gb) = split_columns(z, IN_SPLITS)
        logit = (gdec @ w_decay_up[l] + b_decay[l]).astype(jnp.float32)
        log_a = jnp.maximum(jax.nn.log_sigmoid(logit) / GLA_GATE_NORMALIZER, GLA_LOG_DECAY_MIN)
        o_a = gla_mix(gq.reshape(B_, S_, GLA_HEADS, GLA_DK),
                      gk.reshape(B_, S_, GLA_HEADS, GLA_DK),
                      gv.reshape(B_, S_, GLA_HEADS, GLA_DV),
                      log_a.reshape(B_, S_, GLA_HEADS, GLA_DK))
        o_a = rms_norm(o_a, gla_norm_gains[l]).reshape(B_, S_, GLA_V_WIDTH).astype(x.dtype)
        y_a = (o_a * jax.nn.silu(gg)) @ w_gla_out[l]
        o_b = swa_sink_mix(sq.reshape(B_, S_, SWA_Q_HEADS, SWA_HEAD_DIM),
                           sk.reshape(B_, S_, SWA_KV_HEADS, SWA_HEAD_DIM),
                           sv.reshape(B_, S_, SWA_KV_HEADS, SWA_HEAD_DIM),
                           sinks[l]).astype(x.dtype)
        y_b = (o_b * jax.nn.silu(sg)) @ w_swa_out[l]
        merged = jax.nn.sigmoid(ga + b_gates[l, 0]) * y_a + jax.nn.sigmoid(gb + b_gates[l, 1]) * y_b
        x = x + merged @ w_out[l]
    return rms_norm(x, final_norm_gain)
```

```cpp
#include <hip/hip_runtime.h>
#include <cstdio>
#include <cstdint>
namespace pg8 {
#define PG8_LAS __attribute__((address_space(3)))
typedef unsigned short bf16_t;
typedef short bf16x8 __attribute__((ext_vector_type(8)));
typedef float f32x4 __attribute__((ext_vector_type(4)));
typedef unsigned u32x4 __attribute__((ext_vector_type(4)));
typedef int i32x4 __attribute__((ext_vector_type(4)));
typedef int i32x8 __attribute__((ext_vector_type(8)));
constexpr int BM = 256, BK = 64, HALF = 128, HTB = HALF * BK * 2  , STAGE_BYTES = 8 * HTB, NXCD = 8, WGM = 8;

__host__ __device__ __forceinline__ int lds_byte(int r, int c) { const int st = (r >> 4) * 2 + (c >> 5), rr = r & 15, cc = c & 31, ob = rr * 64 + cc * 2; return st * 1024 + (ob ^ (((ob >> 9) & 1) << 5)); }
__host__ __device__ __forceinline__ void stage_rc(int b, int& R, int& C) { const int st = b / 1024, sb = b % 1024, swz = sb ^ (((sb >> 9) & 1) << 5); R = (st >> 1) * 16 + swz / 64; C = (st & 1) * 32 + (swz % 64) / 2; }
__host__ __device__ __forceinline__ int perm32(int rho) { const int n = rho >> 4, i = rho & 15; return 8 * (i >> 2) + 4 * n + (i & 3); }

struct Unit { int pm, pn; };
struct Gemm { const bf16_t* A; const bf16_t* Bt; int M, N, K; };

struct StaticOrder {
    int nM, nN, nwg, G, c;
    __host__ __device__ void init(int M, int N, int G_, int c_) { nM = M / BM; nN = N / BM; nwg = nM * nN; G = G_; c = c_; }
    __host__ __device__ bool next(int i, Unit& u) const {
        const long L = (long)i * G + c; if (L >= nwg) return false;
        int wgid = (int)L; { const int q = nwg / NXCD, r = nwg % NXCD, xcd = wgid % NXCD, off = wgid / NXCD; wgid = (xcd < r ? xcd * (q + 1) : r * (q + 1) + (xcd - r) * q) + off; }
        const int nig = WGM * nN, gid = wgid / nig, fm = gid * WGM, gsz = (nM - fm) < WGM ? (nM - fm) : WGM;
        u.pm = fm + ((wgid % nig) % gsz); u.pn = (wgid % nig) / gsz; return true;
    }
    __device__ __forceinline__ void a_ready(const Unit&) const {}
    __device__ __forceinline__ void done(const Unit&) const {}
};
typedef unsigned u32x2 __attribute__((ext_vector_type(2)));
typedef float f32x2c __attribute__((ext_vector_type(2))); typedef __bf16 bf16x2c __attribute__((ext_vector_type(2)));
__device__ __forceinline__ unsigned cvt_pk_bf16(float lo, float hi) { const f32x2c v = {lo, hi}; return __builtin_bit_cast(unsigned, __builtin_convertvector(v, bf16x2c)); }
typedef float f32x2 __attribute__((ext_vector_type(2)));
struct HotOrder : StaticOrder { __host__ __device__ bool next(int i, Unit& u) const { const bool r = StaticOrder::next(i, u); u.pm = c & 7; u.pn = 0; return r; } };
constexpr int LDZ = 19456;
__device__ __forceinline__ float bf_lo(unsigned w) { return __uint_as_float(w << 16); }
__device__ __forceinline__ float bf_hi(unsigned w) { return __uint_as_float(w & 0xffff0000u); }
__device__ __forceinline__ float sigmoidf_(float x) { return __builtin_amdgcn_rcpf(1.0f + __expf(-x)); }
__host__ __device__ __forceinline__ int kperm8(int k) { return (k & ~63) | ((k & 0x18) << 1) | ((k >> 2) & 8) | (k & 7); }
__device__ __forceinline__ unsigned q8x4(float a, float b, float c, float d, float q) {
    const float MG = 12582912.0f, LO = MG - 127.0f, HI = MG + 127.0f;
    const unsigned i0 = __float_as_uint(__builtin_amdgcn_fmed3f(__builtin_fmaf(a, q, MG), LO, HI)), i1 = __float_as_uint(__builtin_amdgcn_fmed3f(__builtin_fmaf(b, q, MG), LO, HI));
    const unsigned i2 = __float_as_uint(__builtin_amdgcn_fmed3f(__builtin_fmaf(c, q, MG), LO, HI)), i3 = __float_as_uint(__builtin_amdgcn_fmed3f(__builtin_fmaf(d, q, MG), LO, HI));
    return __builtin_amdgcn_perm(i1, i0, 0x0c0c0400u) | __builtin_amdgcn_perm(i3, i2, 0x04000c0cu);
}
__device__ __forceinline__ float shx(float v, int lane, int mask) { return __int_as_float(__builtin_amdgcn_ds_bpermute((lane ^ mask) << 2, __float_as_int(v))); }
__device__ __forceinline__ float row_ssq(const float* P, int row) {
    const f32x4* p = (const f32x4*)(P + (size_t)row * 64); float s = 0.f;
#pragma unroll
    for (int j = 0; j < 16; ++j) { const f32x4 v = p[j]; s += (v[0] + v[1]) + (v[2] + v[3]); }
    return s;
}
__device__ __forceinline__ float row_rstd(const float* P, int row) { return __builtin_amdgcn_rsqf(row_ssq(P, row) * (1.0f / 4096.0f) + 1e-6f); }
__device__ __forceinline__ float row_rstd_slow(const float* P, int row) {
    const f32x4* p = (const f32x4*)(P + (size_t)row * 64); float s = 0.f;
#pragma unroll 1
    for (int j = 0; j < 16; ++j) { const f32x4 v = p[j]; s += (v[0] + v[1]) + (v[2] + v[3]); }
    return __builtin_amdgcn_rsqf(s * (1.0f / 4096.0f) + 1e-6f);
}
struct EpiZ {
    static constexpr bool PERM = true, AFTER_DRAIN = false, IDEMP = true;
    bf16_t* Z; const float* P; int pm0; const PG8_LAS float* rsl; float mul;
    __device__ __forceinline__ void operator()(const f32x4 (&acc)[2][2][4][2], const Unit& u, int wr, int wc, int fr_in, int fq_in) const {
        int fr = fr_in, fq = fq_in; asm volatile("" : "+v"(fr), "+v"(fq));
        const int row0 = u.pm * BM + wr * 64 + fr, col0 = u.pn * BM + wc * 64 + 8 * fq;
#pragma unroll
        for (int ai = 0; ai < 2; ++ai)
#pragma unroll
            for (int m = 0; m < 4; ++m) { const int row = row0 + ai * HALF + m * 16; const float r = ((u.pm == pm0) ? rsl[ai * HALF + wr * 64 + m * 16 + fr] : row_rstd_slow(P, row)) * mul;
                bf16_t* rowp = Z + (size_t)row * LDZ + col0;
#pragma unroll
                for (int bj = 0; bj < 2; ++bj) { const f32x4 v0 = acc[ai][bj][m][0] * r, v1 = acc[ai][bj][m][1] * r;
                    u32x4 w; w.x = cvt_pk_bf16(v0[0], v0[1]); w.y = cvt_pk_bf16(v0[2], v0[3]); w.z = cvt_pk_bf16(v1[0], v1[1]); w.w = cvt_pk_bf16(v1[2], v1[3]);
                    *(u32x4*)(rowp + bj * 32) = w; } }
    }
};
struct EpiZ8 {
    static constexpr bool PERM = true, AFTER_DRAIN = false, IDEMP = true;
    bf16_t* Z; const float* P; const float* SX; float iwq; int pm0; const PG8_LAS float* rsl; unsigned char* GT; int gpn0;
    __device__ __forceinline__ void operator()(const f32x4 (&acc)[2][2][4][2], const Unit& u, int wr, int wc, int fr_in, int fq_in) const {
        int fr = fr_in, fq = fq_in; asm volatile("" : "+v"(fr), "+v"(fq));
        const int row0 = u.pm * BM + wr * 64 + fr, col0 = u.pn * BM + wc * 64 + 8 * fq;
#pragma unroll
        for (int ai = 0; ai < 2; ++ai)
#pragma unroll
            for (int m = 0; m < 4; ++m) { const int row = row0 + ai * HALF + m * 16; const float r = (u.pm == pm0) ? rsl[ai * HALF + wr * 64 + m * 16 + fr] : row_rstd_slow(P, row) * iwq * __builtin_amdgcn_rcpf(SX[row]);
                const bool gate = u.pn >= gpn0; const int gi = u.pn - gpn0;
                unsigned char* dst = gate ? GT + (((size_t)((gi >> 4) * 1024 + u.pm * 16 + (gi & 15)) * 8 + (wr * 4 + wc)) * 16 + (ai * 4 + m) * 2) * 1024 + (fr + 16 * fq) * 16 : (unsigned char*)(Z + (size_t)row * LDZ + col0);
                const int bstep = gate ? 1024 : 64;
#pragma unroll
                for (int bj = 0; bj < 2; ++bj) { const i32x4 i0 = __builtin_bit_cast(i32x4, acc[ai][bj][m][0]), i1 = __builtin_bit_cast(i32x4, acc[ai][bj][m][1]);
                    const f32x4 v0 = (f32x4){(float)i0[0], (float)i0[1], (float)i0[2], (float)i0[3]} * r, v1 = (f32x4){(float)i1[0], (float)i1[1], (float)i1[2], (float)i1[3]} * r;
                    u32x4 w; w.x = cvt_pk_bf16(v0[0], v0[1]); w.y = cvt_pk_bf16(v0[2], v0[3]); w.z = cvt_pk_bf16(v1[0], v1[1]); w.w = cvt_pk_bf16(v1[2], v1[3]);
                    *(u32x4*)(dst + bj * bstep) = w; } }
    }
};
#define PG8_SIG8(s0, s1, g, b0, b1) do { s0[0] = sigmoidf_(bf_lo(g.x) + b0[0]); s0[1] = sigmoidf_(bf_hi(g.x) + b0[1]); s0[2] = sigmoidf_(bf_lo(g.y) + b0[2]); s0[3] = sigmoidf_(bf_hi(g.y) + b0[3]); \
    s1[0] = sigmoidf_(bf_lo(g.z) + b1[0]); s1[1] = sigmoidf_(bf_hi(g.z) + b1[1]); s1[2] = sigmoidf_(bf_lo(g.w) + b1[2]); s1[3] = sigmoidf_(bf_hi(g.w) + b1[3]); } while (0)
struct EpiGateA {
    static constexpr bool PERM = true, AFTER_DRAIN = false, IDEMP = true;
    const unsigned char* G; const float* bias; unsigned char* T; PG8_LAS float* SS;
    __device__ __forceinline__ void operator()(const f32x4 (&acc)[2][2][4][2], const Unit& u, int wr, int wc, int fr_in, int fq_in) const {
        int fr = fr_in, fq = fq_in; asm volatile("" : "+v"(fr), "+v"(fq));
        const int row0 = u.pm * BM + wr * 64 + fr, col0 = u.pn * BM + wc * 64 + 8 * fq;
        f32x4 bv[2][2]; u32x4 gl[8][2], w[8][2]; float ss = 0.f;
        const size_t tofs = ((size_t)(u.pm * 16 + u.pn) * 8 + (wr * 4 + wc)) * 16384 + (fr + 16 * fq) * 16;
#pragma unroll
        for (int g = 0; g < 8; ++g) { const unsigned char* gp = G + tofs + g * 2048; gl[g][0] = *(const u32x4*)gp; gl[g][1] = *(const u32x4*)(gp + 1024); }
#pragma unroll
        for (int bj = 0; bj < 2; ++bj)
#pragma unroll
            for (int n = 0; n < 2; ++n) bv[bj][n] = *(const f32x4*)(bias + col0 + bj * 32 + 4 * n);
#pragma unroll
        for (int g = 0; g < 8; ++g) { const int ai = g >> 2, m = g & 3;
#pragma unroll
            for (int bj = 0; bj < 2; ++bj) { const u32x4 gg = gl[g][bj]; f32x4 s0, s1; PG8_SIG8(s0, s1, gg, bv[bj][0], bv[bj][1]); const f32x4 v0 = s0 * acc[ai][bj][m][0], v1 = s1 * acc[ai][bj][m][1];
                ss += ((v0[0] * v0[0] + v0[1] * v0[1]) + (v0[2] * v0[2] + v0[3] * v0[3])) + ((v1[0] * v1[0] + v1[1] * v1[1]) + (v1[2] * v1[2] + v1[3] * v1[3]));
                w[g][bj].x = cvt_pk_bf16(v0[0], v0[1]); w[g][bj].y = cvt_pk_bf16(v0[2], v0[3]); w[g][bj].z = cvt_pk_bf16(v1[0], v1[1]); w[g][bj].w = cvt_pk_bf16(v1[2], v1[3]); }
            asm volatile("" : "+v"(w[g][0]), "+v"(w[g][1])); }
        asm volatile("" ::: "memory");
#pragma unroll
        for (int g = 0; g < 8; ++g) { unsigned char* tp = T + tofs + g * 2048; *(u32x4*)tp = w[g][0]; *(u32x4*)(tp + 1024) = w[g][1]; }
        { const int ln = fr + 16 * fq;
#pragma unroll
          for (int o = 1; o < 64; o <<= 1) ss += shx(ss, ln, o);
          if (ln == 0) { PG8_LAS float* sp = SS + wr * 4 + wc; *sp = *sp + ss; } }
    }
};
struct EpiGateB {
    static constexpr bool PERM = true, AFTER_DRAIN = false, IDEMP = true;
    const bf16_t* G; const float* bias; const bf16_t* T; bf16_t* O; float mul;
    __device__ __forceinline__ void operator()(const f32x4 (&acc)[2][2][4][2], const Unit& u, int wr, int wc, int fr_in, int fq_in) const {
        int fr = fr_in, fq = fq_in; asm volatile("" : "+v"(fr), "+v"(fq));
        const int row0 = u.pm * BM + wr * 64 + fr, col0 = u.pn * BM + wc * 64 + 8 * fq;
        f32x4 bv[2][2]; u32x4 w[8][2];
#pragma unroll
        for (int bj = 0; bj < 2; ++bj)
#pragma unroll
            for (int n = 0; n < 2; ++n) bv[bj][n] = *(const f32x4*)(bias + col0 + bj * 32 + 4 * n);
#pragma unroll
        for (int ai = 0; ai < 2; ++ai) { u32x4 gl[4][2], tl[4][2];
#pragma unroll
            for (int m = 0; m < 4; ++m) { const int r = row0 + ai * HALF + m * 16; const bf16_t* gp = G + (size_t)r * LDZ + col0; const bf16_t* tp = T + (size_t)r * 4096 + col0;
                gl[m][0] = *(const u32x4*)gp; gl[m][1] = *(const u32x4*)(gp + 32); tl[m][0] = *(const u32x4*)tp; tl[m][1] = *(const u32x4*)(tp + 32); }
#pragma unroll
            for (int m = 0; m < 4; ++m) { const int g = ai * 4 + m;
#pragma unroll
                for (int bj = 0; bj < 2; ++bj) { const u32x4 gg = gl[m][bj], tt = tl[m][bj]; f32x4 s0, s1; PG8_SIG8(s0, s1, gg, bv[bj][0], bv[bj][1]);
                    f32x4 v0 = s0 * (acc[ai][bj][m][0] * mul), v1 = s1 * (acc[ai][bj][m][1] * mul);
                    v0[0] += bf_lo(tt.x); v0[1] += bf_hi(tt.x); v0[2] += bf_lo(tt.y); v0[3] += bf_hi(tt.y); v1[0] += bf_lo(tt.z); v1[1] += bf_hi(tt.z); v1[2] += bf_lo(tt.w); v1[3] += bf_hi(tt.w);
                    w[g][bj].x = cvt_pk_bf16(v0[0], v0[1]); w[g][bj].y = cvt_pk_bf16(v0[2], v0[3]); w[g][bj].z = cvt_pk_bf16(v1[0], v1[1]); w[g][bj].w = cvt_pk_bf16(v1[2], v1[3]); }
                asm volatile("" : "+v"(w[g][0]), "+v"(w[g][1])); } }
        asm volatile("" ::: "memory");
#pragma unroll
        for (int g = 0; g < 8; ++g) { bf16_t* op = O + (size_t)(row0 + (g >> 2) * HALF + (g & 3) * 16) * 4096 + col0; *(u32x4*)op = w[g][0]; *(u32x4*)(op + 32) = w[g][1]; }
    }
};
struct EpiGateB8 {
    static constexpr bool PERM = true, AFTER_DRAIN = false, IDEMP = true;
    const unsigned char* G; const float* bias; const unsigned char* T; unsigned char* O; float mul, qm;
    __device__ __forceinline__ void operator()(const f32x4 (&acc)[2][2][4][2], const Unit& u, int wr, int wc, int fr_in, int fq_in) const {
        int fr = fr_in, fq = fq_in; asm volatile("" : "+v"(fr), "+v"(fq));
        const int row0 = u.pm * BM + wr * 64 + fr, col0 = u.pn * BM + wc * 64 + 8 * fq;
        f32x4 bv[2][2]; u32x2 w[8][2];
#pragma unroll
        for (int bj = 0; bj < 2; ++bj)
#pragma unroll
            for (int n = 0; n < 2; ++n) bv[bj][n] = *(const f32x4*)(bias + col0 + bj * 32 + 4 * n);
#pragma unroll
        for (int ai = 0; ai < 2; ++ai) { u32x4 gl[4][2], tl[4][2];
#pragma unroll
            for (int m = 0; m < 4; ++m) { const size_t o_ = ((size_t)(u.pm * 16 + u.pn) * 8 + (wr * 4 + wc)) * 16384 + (fr + 16 * fq) * 16 + (ai * 4 + m) * 2048; const unsigned char* gp = G + o_; const unsigned char* tp = T + o_;
                gl[m][0] = *(const u32x4*)gp; gl[m][1] = *(const u32x4*)(gp + 1024); tl[m][0] = *(const u32x4*)tp; tl[m][1] = *(const u32x4*)(tp + 1024); }
#pragma unroll
            for (int m = 0; m < 4; ++m) { const int g = ai * 4 + m;
#pragma unroll
                for (int bj = 0; bj < 2; ++bj) { const u32x4 gg = gl[m][bj], tt = tl[m][bj]; f32x4 s0, s1; PG8_SIG8(s0, s1, gg, bv[bj][0], bv[bj][1]);
                    f32x4 v0 = s0 * (acc[ai][bj][m][0] * mul), v1 = s1 * (acc[ai][bj][m][1] * mul);
                    v0[0] += bf_lo(tt.x); v0[1] += bf_hi(tt.x); v0[2] += bf_lo(tt.y); v0[3] += bf_hi(tt.y); v1[0] += bf_lo(tt.z); v1[1] += bf_hi(tt.z); v1[2] += bf_lo(tt.w); v1[3] += bf_hi(tt.w);
                    { f32x4 p0 = (f32x4){v0[0] + v0[1], v0[0] - v0[1], v0[2] + v0[3], v0[2] - v0[3]}, p1 = (f32x4){v1[0] + v1[1], v1[0] - v1[1], v1[2] + v1[3], v1[2] - v1[3]};
                      f32x4 r0 = (f32x4){p0[0] + p0[2], p0[1] + p0[3], p0[0] - p0[2], p0[1] - p0[3]}, r1 = (f32x4){p1[0] + p1[2], p1[1] + p1[3], p1[0] - p1[2], p1[1] - p1[3]};
                      v0 = r0 + r1; v1 = r0 - r1; }
                    w[g][bj].x = q8x4(v0[0], v0[1], v0[2], v0[3], qm); w[g][bj].y = q8x4(v1[0], v1[1], v1[2], v1[3], qm); }
                asm volatile("" : "+v"(w[g][0]), "+v"(w[g][1])); } }
        asm volatile("" ::: "memory");
#pragma unroll
        for (int g = 0; g < 8; ++g) { unsigned char* op = O + (size_t)(row0 + (g >> 2) * HALF + (g & 3) * 16) * 4096 + u.pn * BM + wc * 64 + 16 * fq; *(u32x4*)op = (u32x4){w[g][0].x, w[g][0].y, w[g][1].x, w[g][1].y}; }
    }
};
struct EpiRes {
    static constexpr bool PERM = true, AFTER_DRAIN = false, IDEMP = false;
    bf16_t* XB; float* P; unsigned char* X8; const float* SXN; const PG8_LAS float* rq; int pm0; float dsc;
    __device__ __forceinline__ void operator()(const f32x4 (&acc)[2][2][4][2], const Unit& u, int wr, int wc, int fr_in, int fq_in) const {
        int fr = fr_in, fq = fq_in; asm volatile("" : "+v"(fr), "+v"(fq));
        const int row0 = u.pm * BM + wr * 64 + fr, col0 = u.pn * BM + wc * 64 + 8 * fq;
        int di_ = __builtin_amdgcn_readfirstlane(__float_as_int(dsc)); asm volatile("" : "+s"(di_)); const float dv = __int_as_float(di_);
        u32x4 xl[8][2], w[8][2]; u32x2 w8[8][2]; float s_lo = 0.f, s_hi = 0.f;
#pragma unroll
        for (int g = 0; g < 8; ++g) { const bf16_t* xp = XB + (size_t)(row0 + (g >> 2) * HALF + (g & 3) * 16) * 4096 + col0; xl[g][0] = *(const u32x4*)xp; xl[g][1] = *(const u32x4*)(xp + 32); }
#pragma unroll
        for (int g = 0; g < 8; ++g) { const int ai = g >> 2, m = g & 3; float ss = 0.f; const float qg = (u.pm == pm0) ? rq[ai * HALF + wr * 64 + m * 16 + fr] : SXN[row0 + ai * HALF + m * 16];
#pragma unroll
            for (int bj = 0; bj < 2; ++bj) { const u32x4 xx = xl[g][bj]; const i32x4 ia = __builtin_bit_cast(i32x4, acc[ai][bj][m][0]), ib = __builtin_bit_cast(i32x4, acc[ai][bj][m][1]);
                const f32x4 a = (f32x4){(float)ia[0], (float)ia[1], (float)ia[2], (float)ia[3]} * dv, b = (f32x4){(float)ib[0], (float)ib[1], (float)ib[2], (float)ib[3]} * dv;
                u32x4 o; o.x = cvt_pk_bf16(bf_lo(xx.x) + a[0], bf_hi(xx.x) + a[1]); o.y = cvt_pk_bf16(bf_lo(xx.y) + a[2], bf_hi(xx.y) + a[3]); o.z = cvt_pk_bf16(bf_lo(xx.z) + b[0], bf_hi(xx.z) + b[1]); o.w = cvt_pk_bf16(bf_lo(xx.w) + b[2], bf_hi(xx.w) + b[3]);
                w[g][bj] = o;
                const float r0 = bf_lo(o.x), r1 = bf_hi(o.x), r2 = bf_lo(o.y), r3 = bf_hi(o.y), r4 = bf_lo(o.z), r5 = bf_hi(o.z), r6 = bf_lo(o.w), r7 = bf_hi(o.w);
                w8[g][bj].x = q8x4(r0, r1, r2, r3, qg); w8[g][bj].y = q8x4(r4, r5, r6, r7, qg);
                ss += ((r0 * r0 + r1 * r1) + (r2 * r2 + r3 * r3)) + ((r4 * r4 + r5 * r5) + (r6 * r6 + r7 * r7)); }
            ss += shx(ss, fr + 16 * fq, 16); ss += shx(ss, fr + 16 * fq, 32); if (m == fq) { if (ai == 0) s_lo = ss; else s_hi = ss; }
            asm volatile("" : "+v"(w[g][0]), "+v"(w[g][1]), "+v"(s_lo), "+v"(s_hi), "+v"(w8[g][0]), "+v"(w8[g][1])); }
        asm volatile("" ::: "memory");
#pragma unroll
        for (int g = 0; g < 8; ++g) { const int row = row0 + (g >> 2) * HALF + (g & 3) * 16; bf16_t* xp = XB + (size_t)row * 4096 + col0; *(u32x4*)xp = w[g][0]; *(u32x4*)(xp + 32) = w[g][1];
            unsigned char* x8 = X8 + (size_t)row * 4096 + u.pn * BM + wc * 64 + 16 * fq; *(u32x4*)x8 = (u32x4){w8[g][0].x, w8[g][0].y, w8[g][1].x, w8[g][1].y};
            }
        P[(size_t)(row0 + fq * 16) * 64 + u.pn * 4 + wc] = s_lo; P[(size_t)(row0 + HALF + fq * 16) * 64 + u.pn * 4 + wc] = s_hi;
    }
};

__device__ __forceinline__ f32x4 zero4() { f32x4 z; asm volatile("v_mov_b32 %0, 0\n\tv_mov_b32 %1, 0\n\tv_mov_b32 %2, 0\n\tv_mov_b32 %3, 0" : "=v"(z[0]), "=v"(z[1]), "=v"(z[2]), "=v"(z[3])); return z; }
template <class Epi, class Sched, bool ALIGN_EPI = false, bool SP2 = false, bool F8 = false, bool BAL = false, bool I8 = false>
__device__ __forceinline__ void gemm_phase(PG8_LAS unsigned char* lds, const Gemm g, const Sched& S, const Epi& E, const int tid_in) {
    const int tid = tid_in, wid = __builtin_amdgcn_readfirstlane(tid >> 6), lane = tid & 63, wr = wid >> 2, wc = wid & 3, fr = lane & 15, fq = lane >> 4;
    const int K = g.K, nt = K / BK;
    unsigned voffA[2], voffB[2];
#pragma unroll
    for (int i = 0; i < 2; ++i) { int R, C; stage_rc(tid * 16 + i * 8192, R, C); const int Rb = (R >> 5) * 64 + (Epi::PERM ? perm32(R & 31) : (R & 31));
        voffA[i] = (unsigned)(R * K + C) * 2u; voffB[i] = (unsigned)(Rb * K + C) * 2u; }
    const unsigned kstep = (unsigned)(BK * 2);
    const unsigned hstep = (unsigned)HALF * (unsigned)K * 2u;
    const unsigned hstepB = 32u * (unsigned)K * 2u;
    const unsigned tstep = 2u * hstep;
    const unsigned ldsw = (unsigned)wid * 1024u;
    const int aoff = lds_byte(wr * 64 + fr, fq * 8), boff = lds_byte(wc * 32 + fr, fq * 8);
#define PG8_SA(b, h) (((b) * 2 + (h)) * HTB)
#define PG8_SB(b, h) ((4 + (b) * 2 + (h)) * HTB)
#define PG8_STAGE(bufoff, rs, gbase, voff) do { _Pragma("unroll") for (int _i = 0; _i < 2; ++_i) \
        __builtin_amdgcn_raw_ptr_buffer_load_lds(rs, (PG8_LAS void*)(lds + (bufoff) + ldsw + _i * 8192), 16, (int)(voff)[_i], (int)(gbase), 0, 0); } while (0)
#define PG8_STAGE_A(bufoff, gbase, voff) PG8_STAGE(bufoff, rsA, gbase, voff)
#define PG8_STAGE_B(bufoff, gbase, voff) PG8_STAGE(bufoff, rsB, gbase, voff)
#define PG8_LDA(dst, b, h) do { _Pragma("unroll") for (int m = 0; m < 4; ++m) _Pragma("unroll") for (int k = 0; k < 2; ++k) dst[m][k] = *(const PG8_LAS bf16x8*)(lds + PG8_SA(b, h) + aoff + m * 2048 + k * 1024); } while (0)
#define PG8_LDB(dst, b, h) do { _Pragma("unroll") for (int n = 0; n < 2; ++n) _Pragma("unroll") for (int k = 0; k < 2; ++k) dst[n][k] = *(const PG8_LAS bf16x8*)(lds + PG8_SB(b, h) + boff + n * 2048 + k * 1024); } while (0)
#define PG8_MMA(ai, bj, At, Bt) do { __builtin_amdgcn_s_setprio(1); if constexpr (I8) { \
          \
        _Pragma("unroll") for (int m = 0; m < 4; ++m) _Pragma("unroll") for (int n = 0; n < 2; ++n) _Pragma("unroll") for (int k = 0; k < 2; ++k) { \
            const i32x4 b_ = __builtin_bit_cast(i32x4, Bt[n][k]), a_ = __builtin_bit_cast(i32x4, At[m][k]); \
            asm volatile("v_mfma_i32_16x16x64_i8 %0, %1, %2, %0" : "+v"(acc[ai][bj][m][n]) : "v"(b_), "v"(a_)); } } else if constexpr (!F8) { _Pragma("unroll") for (int m = 0; m < 4; ++m) _Pragma("unroll") for (int n = 0; n < 2; ++n) _Pragma("unroll") for (int k = 0; k < 2; ++k) \
        acc[ai][bj][m][n] = __builtin_amdgcn_mfma_f32_16x16x32_bf16(Bt[n][k], At[m][k], acc[ai][bj][m][n], 0, 0, 0); } else { \
          \
          \
        _Pragma("unroll") for (int m = 0; m < 4; ++m) _Pragma("unroll") for (int n = 0; n < 2; ++n) { \
            const i32x4 b0_ = __builtin_bit_cast(i32x4, Bt[n][0]), b1_ = __builtin_bit_cast(i32x4, Bt[n][1]), a0_ = __builtin_bit_cast(i32x4, At[m][0]), a1_ = __builtin_bit_cast(i32x4, At[m][1]); \
            const i32x8 bb_ = __builtin_shufflevector(b0_, b1_, 0, 1, 2, 3, 4, 5, 6, 7), aa_ = __builtin_shufflevector(a0_, a1_, 0, 1, 2, 3, 4, 5, 6, 7); \
            asm volatile("v_mfma_f32_16x16x128_f8f6f4 %0, %1, %2, %0" : "+v"(acc[ai][bj][m][n]) : "v"(bb_), "v"(aa_)); } } \
        __builtin_amdgcn_s_setprio(0); } while (0)
#define PG8_WAIT_V(n) asm volatile("s_waitcnt vmcnt(" #n ")" ::: "memory")
#define PG8_WAIT_L(n) asm volatile("s_waitcnt lgkmcnt(" #n ")" ::: "memory")
#define PG8_BAR __builtin_amdgcn_s_barrier()
#define PG8_SCHED __builtin_amdgcn_sched_barrier(0)
    Unit cur, nxt; int ui = 0;
    if (!S.next(0, cur)) return;
    f32x4 acc[2][2][4][2];
#pragma unroll
    for (int a = 0; a < 2; ++a)
#pragma unroll
        for (int b = 0; b < 2; ++b)
#pragma unroll
            for (int m = 0; m < 4; ++m)
#pragma unroll
                for (int n = 0; n < 2; ++n) acc[a][b][m][n] = zero4();
    bf16x8 At[4][2], B0[2][2], B1[2][2];
    unsigned cA = (unsigned)cur.pm * tstep, cB = (unsigned)cur.pn * tstep;
    const __amdgpu_buffer_rsrc_t rsA = __builtin_amdgcn_make_buffer_rsrc((void*)g.A, 0, (int)((unsigned)g.M * (unsigned)K * 2u), 0x00020000), rsB = __builtin_amdgcn_make_buffer_rsrc((void*)g.Bt, 0, (int)((unsigned)g.N * (unsigned)K * 2u), 0x00020000);
    S.a_ready(cur);
    if constexpr (SP2) {
        PG8_STAGE_B(PG8_SB(0, 0), cB, voffB); PG8_STAGE_B(PG8_SB(0, 1), cB + hstepB, voffB); PG8_STAGE_A(PG8_SA(0, 0), cA, voffA); PG8_STAGE_A(PG8_SA(0, 1), cA + hstep, voffA);
        if (wr == 1) PG8_BAR;
        PG8_WAIT_V(2); PG8_BAR;
        if constexpr (BAL) { PG8_STAGE_B(PG8_SB(1, 0), cB + kstep, voffB); PG8_STAGE_B(PG8_SB(1, 1), cB + hstepB + kstep, voffB); PG8_WAIT_V(4); PG8_BAR; }
        else {
        PG8_STAGE_B(PG8_SB(1, 0), cB + kstep, voffB); PG8_STAGE_A(PG8_SA(1, 0), cA + kstep, voffA); PG8_STAGE_B(PG8_SB(1, 1), cB + hstepB + kstep, voffB);
        PG8_WAIT_V(6); PG8_BAR;
        }
    } else {
        PG8_STAGE_B(PG8_SB(0, 0), cB, voffB); PG8_STAGE_A(PG8_SA(0, 0), cA, voffA); PG8_STAGE_B(PG8_SB(0, 1), cB + hstepB, voffB); PG8_STAGE_A(PG8_SA(0, 1), cA + hstep, voffA);
        if (wr == 1) PG8_BAR;
        PG8_WAIT_V(4); PG8_BAR;
        PG8_STAGE_B(PG8_SB(1, 0), cB + kstep, voffB); PG8_STAGE_A(PG8_SA(1, 0), cA + kstep, voffA); PG8_STAGE_B(PG8_SB(1, 1), cB + hstepB + kstep, voffB);
        PG8_WAIT_V(6); PG8_BAR;
    }
    for (;;) {
        const bool has_next = S.next(ui + 1, nxt);
        const unsigned nA = has_next ? (unsigned)nxt.pm * tstep : cA, nB = has_next ? (unsigned)nxt.pn * tstep : cB;
        for (int t = 0; t < nt; t += 2) {
            const bool last = (t == nt - 2);
            const unsigned a1 = cA + (unsigned)(t + 1) * kstep;
            const unsigned a2 = last ? nA : cA + (unsigned)(t + 2) * kstep, b2 = last ? nB : cB + (unsigned)(t + 2) * kstep;
            const unsigned a3 = a2 + kstep, b3 = b2 + kstep;
            if (last && has_next) S.a_ready(nxt);
            if constexpr (SP2 && BAL) {
            PG8_LDB(B0, 0, 0); PG8_LDB(B1, 0, 1); PG8_SCHED; PG8_LDA(At, 0, 0); PG8_STAGE_A(PG8_SA(1, 0), a1, voffA); PG8_STAGE_A(PG8_SA(1, 1), a1 + hstep, voffA);
            PG8_WAIT_V(8); PG8_WAIT_L(0); PG8_BAR; PG8_MMA(0, 0, At, B0); PG8_MMA(0, 1, At, B1); PG8_BAR; PG8_SCHED;
            PG8_LDA(At, 0, 1); PG8_STAGE_B(PG8_SB(0, 0), b2, voffB); PG8_STAGE_B(PG8_SB(0, 1), b2 + hstepB, voffB);
            PG8_WAIT_V(6); PG8_WAIT_L(0); PG8_BAR; PG8_MMA(1, 0, At, B0); PG8_MMA(1, 1, At, B1); PG8_BAR; PG8_SCHED;
            PG8_LDB(B0, 1, 0); PG8_LDB(B1, 1, 1); PG8_SCHED; PG8_LDA(At, 1, 0); PG8_STAGE_A(PG8_SA(0, 0), a2, voffA); PG8_STAGE_A(PG8_SA(0, 1), a2 + hstep, voffA);
            PG8_WAIT_V(8); PG8_WAIT_L(0); PG8_BAR; PG8_MMA(0, 0, At, B0); PG8_MMA(0, 1, At, B1); PG8_BAR; PG8_SCHED;
            PG8_LDA(At, 1, 1); PG8_STAGE_B(PG8_SB(1, 0), b3, voffB); PG8_STAGE_B(PG8_SB(1, 1), b3 + hstepB, voffB);
            PG8_WAIT_V(6); PG8_WAIT_L(0); PG8_BAR; PG8_MMA(1, 0, At, B0); PG8_MMA(1, 1, At, B1); PG8_BAR; PG8_SCHED;
            } else if constexpr (SP2) {
            PG8_LDB(B0, 0, 0); PG8_LDB(B1, 0, 1); PG8_SCHED; PG8_LDA(At, 0, 0); PG8_STAGE_A(PG8_SA(1, 1), a1 + hstep, voffA);
            PG8_WAIT_V(8); PG8_WAIT_L(0); PG8_BAR; PG8_MMA(0, 0, At, B0); PG8_MMA(0, 1, At, B1); PG8_BAR; PG8_SCHED;
            PG8_LDA(At, 0, 1); PG8_STAGE_B(PG8_SB(0, 0), b2, voffB); PG8_STAGE_B(PG8_SB(0, 1), b2 + hstepB, voffB); PG8_STAGE_A(PG8_SA(0, 0), a2, voffA);
            PG8_WAIT_V(8); PG8_WAIT_L(0); PG8_BAR; PG8_MMA(1, 0, At, B0); PG8_MMA(1, 1, At, B1); PG8_BAR; PG8_SCHED;
            PG8_LDB(B0, 1, 0); PG8_LDB(B1, 1, 1); PG8_SCHED; PG8_LDA(At, 1, 0); PG8_STAGE_A(PG8_SA(0, 1), a2 + hstep, voffA);
            PG8_WAIT_V(8); PG8_WAIT_L(0); PG8_BAR; PG8_MMA(0, 0, At, B0); PG8_MMA(0, 1, At, B1); PG8_BAR; PG8_SCHED;
            PG8_LDA(At, 1, 1); PG8_STAGE_B(PG8_SB(1, 0), b3, voffB); PG8_STAGE_B(PG8_SB(1, 1), b3 + hstepB, voffB); PG8_STAGE_A(PG8_SA(1, 0), a3, voffA);
            PG8_WAIT_V(8); PG8_WAIT_L(0); PG8_BAR; PG8_MMA(1, 0, At, B0); PG8_MMA(1, 1, At, B1); PG8_BAR; PG8_SCHED;
            } else {
            PG8_LDB(B0, 0, 0); PG8_SCHED; PG8_LDA(At, 0, 0); PG8_STAGE_A(PG8_SA(1, 1), a1 + hstep, voffA);
            PG8_WAIT_L(8); PG8_BAR; PG8_WAIT_L(0); PG8_MMA(0, 0, At, B0); PG8_BAR; PG8_SCHED;
            PG8_LDB(B1, 0, 1); PG8_STAGE_B(PG8_SB(0, 0), b2, voffB);
            PG8_BAR; PG8_WAIT_L(0); PG8_MMA(0, 1, At, B1); PG8_BAR;
            PG8_LDA(At, 0, 1); PG8_STAGE_A(PG8_SA(0, 0), a2, voffA);
            PG8_BAR; PG8_WAIT_L(0); PG8_MMA(1, 0, At, B0); PG8_BAR; PG8_SCHED;
            PG8_STAGE_B(PG8_SB(0, 1), b2 + hstepB, voffB);
            PG8_WAIT_V(6); PG8_BAR; PG8_MMA(1, 1, At, B1); PG8_BAR;
            PG8_LDB(B0, 1, 0); PG8_SCHED; PG8_LDA(At, 1, 0); PG8_STAGE_A(PG8_SA(0, 1), a2 + hstep, voffA);
            PG8_WAIT_L(8); PG8_BAR; PG8_WAIT_L(0); PG8_MMA(0, 0, At, B0); PG8_BAR; PG8_SCHED;
            PG8_LDB(B1, 1, 1); PG8_STAGE_B(PG8_SB(1, 0), b3, voffB);
            PG8_BAR; PG8_WAIT_L(0); PG8_MMA(0, 1, At, B1); PG8_BAR;
            PG8_LDA(At, 1, 1); PG8_STAGE_A(PG8_SA(1, 0), a3, voffA);
            PG8_BAR; PG8_WAIT_L(0); PG8_MMA(1, 0, At, B0); PG8_BAR; PG8_SCHED;
            PG8_STAGE_B(PG8_SB(1, 1), b3 + hstepB, voffB);
            PG8_WAIT_V(6); PG8_BAR; PG8_MMA(1, 1, At, B1); PG8_BAR;
            }
        }
        if constexpr (F8 || I8) asm volatile("s_nop 15\n\ts_nop 15" ::: "memory");
        if constexpr (ALIGN_EPI) { if (wr == 0) PG8_BAR; }
        if constexpr (!Epi::AFTER_DRAIN) { int tl_ = tid; asm volatile("" : "+v"(tl_)); E(acc, cur, wr, wc, tl_ & 15, (tl_ >> 4) & 3); S.done(cur); }
        if (!has_next) break;
#pragma unroll
        for (int a = 0; a < 2; ++a)
#pragma unroll
            for (int b = 0; b < 2; ++b)
#pragma unroll
                for (int m = 0; m < 4; ++m)
#pragma unroll
                    for (int n = 0; n < 2; ++n) acc[a][b][m][n] = zero4();
        cur = nxt; cA = nA; cB = nB; ++ui;
        if constexpr (ALIGN_EPI) { if (wr == 1) PG8_BAR; }
    }
    PG8_WAIT_V(0);
    if constexpr (!ALIGN_EPI) { if (wr == 0) PG8_BAR; }
    PG8_BAR;
    if constexpr (Epi::AFTER_DRAIN) { E.fused(acc, cur, wr, wc, fr, fq, lds, wid, lane); S.done(cur); }
#undef PG8_SA
#undef PG8_SB
#undef PG8_STAGE
#undef PG8_STAGE_A
#undef PG8_STAGE_B
#undef PG8_LDA
#undef PG8_LDB
#undef PG8_MMA
#undef PG8_WAIT_V
#undef PG8_WAIT_L
#undef PG8_BAR
#undef PG8_SCHED
}
}
constexpr int NWAVES = 8;
#ifndef MK_PER_PHASE
#define MK_PER_PHASE 0
#endif
constexpr int D = 4096, BATCH = 4, SEQ = 4096, M = BATCH * SEQ, DEPTH = 4, IN_W = 19472, NZ = 19456;
constexpr int OFF_GQ = 0, OFF_GK = 1024, OFF_GV = 2048, OFF_GG = 4096, OFF_SQ = 6144, OFF_SK = 8192, OFF_SV = 8704, OFF_SG = 9216, OFF_GA = 11264, OFF_GB = 15360;
constexpr int LDZ = NZ;
#ifndef NZ_BF_COLS
#define NZ_BF_COLS 3072
#endif
constexpr int NZ_BF = NZ_BF_COLS, NZ_F8 = NZ - NZ_BF;
constexpr float QC_W = 4.0f, QC_X0 = 4.25f, QC_XP = 4.5f, QC_M = 4.3f;
constexpr float W8_SCALE = 64.0f, AB8_SCALE = 8.0f;
constexpr float RMS_EPS = 1e-6f;
constexpr int N_PHASES = 2 + 6 * DEPTH;
constexpr size_t MiB = 1u << 20;
constexpr size_t WS_CTL = 0, CTL_ZERO_BYTES = 1 * MiB;
constexpr size_t WS_WIN = 1 * MiB, WS_WDEC = 609 * MiB, WS_WGLA = 610 * MiB, WS_WSWA = 674 * MiB, WS_WOUT = 738 * MiB;
constexpr size_t WS_XRES = 866 * MiB, WS_XB = 1122 * MiB, WS_Z = 1250 * MiB, WS_GDEC = 1858 * MiB;
constexpr size_t WS_QT = 1859 * MiB, WS_KT = 1891 * MiB, WS_QI = 1923 * MiB, WS_U = 1955 * MiB, WS_SP = 2083 * MiB, WS_DECAY = 2211 * MiB;
constexpr size_t WS_AA = 2212 * MiB, WS_AB = 2276 * MiB, WS_TMP = 2340 * MiB, WS_MERGED = 2596 * MiB, WS_SSQP = 2724 * MiB, WS_X8 = 2936 * MiB, WS_SX = 3000 * MiB, WS_WIN8 = 3001 * MiB, WS_GT = 3321 * MiB, WS_END = 3577 * MiB;
static_assert(WS_WIN8 + (size_t)DEPTH * NZ_F8 * D <= WS_GT && WS_SSQP + 4 * MiB <= WS_X8, "int8 weight copies");
static_assert(WS_WIN + (size_t)DEPTH * NZ * D * 2 <= WS_WDEC && WS_Z + (size_t)M * NZ * 2 <= WS_GDEC && WS_XRES + (size_t)M * D * 4 <= WS_XB, "ws map");
constexpr int CW_TMO = 0, CW_BAR = 4096, CW_TS = 8192;
static_assert(CW_BAR + 3456 <= CW_TS && (size_t)(CW_TS + DEPTH * 256 * 8) * 4 <= CTL_ZERO_BYTES, "CTL map");
constexpr int RING_BYTES = 131072, LDSCTL_OFF = RING_BYTES, MISC_OFF = LDSCTL_OFF + 320, RS_OFF = LDSCTL_OFF + 1024, RS2_OFF = LDSCTL_OFF + 2048, WQ_OFF = LDSCTL_OFF + 3072, RS3_OFF = LDSCTL_OFF + 4096, MQ_OFF = LDSCTL_OFF + 3072 + 512, LDS_BYTES = 147456;

#define GAS __attribute__((address_space(1)))
#define LAS __attribute__((address_space(3)))
typedef unsigned short bf16;
typedef unsigned v4u __attribute__((ext_vector_type(4)));
typedef unsigned v2u __attribute__((ext_vector_type(2)));
typedef float f32x4 __attribute__((ext_vector_type(4)));
typedef short bf16x8 __attribute__((ext_vector_type(8)));
typedef short s16x4 __attribute__((ext_vector_type(4)));
typedef GAS unsigned gu32;
#define RLX_AGENT __ATOMIC_RELAXED, __HIP_MEMORY_SCOPE_AGENT
#define LDS_WAIT() asm volatile("s_waitcnt lgkmcnt(0)" ::: "memory")
__device__ __forceinline__ unsigned f2bf(float f) { unsigned u = __builtin_bit_cast(unsigned, f); return (u + 0x7fffu + ((u >> 16) & 1u)) >> 16; }
__device__ __forceinline__ unsigned pk2(float lo, float hi) { return pg8::cvt_pk_bf16(lo, hi); }
__device__ __forceinline__ float bf2f(unsigned short b) { return __uint_as_float(((unsigned)b) << 16); }
__device__ __forceinline__ float bflo(unsigned w) { return __uint_as_float(w << 16); }
__device__ __forceinline__ float bfhi(unsigned w) { return __uint_as_float(w & 0xffff0000u); }
#define MFMA16(a, b, c) __builtin_amdgcn_mfma_f32_16x16x32_bf16((a), (b), (c), 0, 0, 0)
__device__ __forceinline__ bf16x8 tr_frag(LAS unsigned char* base, int rs, int k0, int n0, int lane) {
    const int g = lane >> 4, q = (lane & 15) >> 2, p = lane & 3;
    LAS unsigned char* a = base + (k0 + 8 * g + q) * rs + (n0 + 4 * p) * 2;
    const s16x4 lo = __builtin_amdgcn_ds_read_tr16_b64_v4i16((LAS s16x4*)a);
    const s16x4 hi = __builtin_amdgcn_ds_read_tr16_b64_v4i16((LAS s16x4*)(a + 4 * rs));
    return (bf16x8){lo[0], lo[1], lo[2], lo[3], hi[0], hi[1], hi[2], hi[3]};
}
#define XB_TMO      128
#define XB_XCNT(j)  (256  + 64 * (j))
#define XB_XSUB(j)  (1280 + 64 * (j))
#define XB_XGEN(j)  (2304 + 64 * (j))
#define XB_TOP      3328
#define XB_TOPGEN   3392
#define XCD_BAR_WORDS 3456
#define XB_SPIN_CAP (1u << 18)

__device__ __forceinline__ unsigned xb_ld(unsigned* p)              { return __hip_atomic_load(p, __ATOMIC_RELAXED, __HIP_MEMORY_SCOPE_AGENT); }
__device__ __forceinline__ unsigned xb_add(unsigned* p, unsigned v) { return __hip_atomic_fetch_add(p, v, __ATOMIC_RELAXED, __HIP_MEMORY_SCOPE_AGENT); }
__device__ __forceinline__ unsigned xb_xcc_id() { return (unsigned)__builtin_amdgcn_s_getreg((3 << 11) | 20) & 0xFu; }
#define XB_SPIN(cond, bar) do { unsigned _sp = 0; while (cond) { __builtin_amdgcn_s_sleep(1); \
    if ((++_sp & 255u) == 0u) { if (xb_ld(&(bar)[XB_TMO])) break; if (_sp > XB_SPIN_CAP) { atomicAdd(&(bar)[XB_TMO], 1u); break; } } } } while (0)

struct XcdBarrier {
    unsigned* bar; unsigned x;
    volatile LAS unsigned* st;
};

__device__ __forceinline__ XcdBarrier xcd_barrier_post(unsigned* bar, volatile LAS unsigned* st) {
    XcdBarrier b; b.bar = bar; b.x = xb_xcc_id(); b.st = st;
    if (threadIdx.x == 0) (void)xb_add(&bar[XB_XCNT(b.x)], 1u);
    return b;
}
__device__ __forceinline__ void xcd_barrier_complete(unsigned* bar, unsigned x, unsigned& nloc, unsigned& nx) {
    const unsigned G = gridDim.x * gridDim.y * gridDim.z;
    unsigned sum, cnt, mine, sp = 0u;
    for (;;) {
        sum = 0u; cnt = 0u; mine = 0u;
#pragma unroll
        for (unsigned j = 0; j < 16; ++j) { const unsigned c = xb_ld(&bar[XB_XCNT(j)]); sum += c; cnt += (c > 0u) ? 1u : 0u; mine = (j == x) ? c : mine; }
        if (sum == G) break;
        __builtin_amdgcn_s_sleep(1);
        if ((++sp & 255u) == 0u) { if (xb_ld(&bar[XB_TMO])) break; if (sp > XB_SPIN_CAP) { atomicAdd(&bar[XB_TMO], 1u); break; } }
    }
    nloc = mine > 0u ? mine : 1u; nx = cnt > 0u ? cnt : 1u;
}

__device__ __forceinline__ void xcd_barrier(const XcdBarrier& b) {
    asm volatile("s_waitcnt vmcnt(0)" ::: "memory");
    __syncthreads();
    if (threadIdx.x == 0) {
        unsigned* bar = b.bar;
        __builtin_amdgcn_s_waitcnt(0);
        unsigned nloc = b.st[0], nx = b.st[1];
        if (nloc == 0u) { xcd_barrier_complete(bar, b.x, nloc, nx); b.st[0] = nloc; b.st[1] = nx; }
        const unsigned old = xb_add(&bar[XB_XSUB(b.x)], 1u);
        const unsigned gen = old / nloc;
        if (old + 1u == (gen + 1u) * nloc) {
            __builtin_amdgcn_fence(__ATOMIC_RELEASE, "agent");
            asm volatile("s_waitcnt vmcnt(0)" ::: "memory");
            const unsigned og = xb_add(&bar[XB_TOP], 1u);
            const unsigned tg = og / nx;
            if (og + 1u == (tg + 1u) * nx) xb_add(&bar[XB_TOPGEN], 1u);
            else XB_SPIN(xb_ld(&bar[XB_TOPGEN]) == tg, bar);
            __builtin_amdgcn_fence(__ATOMIC_ACQUIRE, "agent");
            xb_add(&bar[XB_XGEN(b.x)], 1u);
            asm volatile("s_waitcnt vmcnt(0)" ::: "memory");
        } else {
            XB_SPIN(xb_ld(&bar[XB_XGEN(b.x)]) == gen, bar);
            __builtin_amdgcn_fence(__ATOMIC_ACQUIRE, "agent");
            asm volatile("s_waitcnt vmcnt(0)" ::: "memory");
        }
    }
    __syncthreads();
}
struct Frame {
    LAS unsigned char* lds; volatile LAS unsigned* MISC; gu32* ctl; unsigned char* ws;
    int tid, lane, wave, G;
    const float *x, *norm_g, *w_in, *b_gates, *w_up, *b_dec, *gla_g, *sinks, *w_gla, *w_swa, *w_out, *fin_g; float* out;
};
__device__ __forceinline__ float wave_sum(float v, int lane_) {
#pragma unroll
    for (int o = 1; o < 64; o <<= 1) v += pg8::shx(v, lane_, o);
    return v;
}

__device__ __forceinline__ void p0_transpose_item(const float* W, size_t ldw, int scol, int K, bf16* WT, int drow, const float* gain, float scale, int mode  , LAS unsigned char* scr, int kb, int lane) {
    const bool f8 = mode != 0, had = mode == 3; if (mode == 3) mode = 2;
    const int k0 = 64 * kb, lr = lane >> 4, lc = lane & 15;
    f32x4 v[16];
#pragma unroll
    for (int i = 0; i < 16; ++i) v[i] = *(const GAS f32x4*)(W + (size_t)(k0 + 4 * i + lr) * ldw + scol + 4 * lc);
    if (had) {
#pragma unroll
        for (int i = 0; i < 16; ++i) {
#pragma unroll
            for (int e = 0; e < 4; ++e) { const float o = pg8::shx(v[i][e], lane, 16); v[i][e] = (lane & 16) ? o - v[i][e] : v[i][e] + o; }
#pragma unroll
            for (int e = 0; e < 4; ++e) { const float o = pg8::shx(v[i][e], lane, 32); v[i][e] = (lane & 32) ? o - v[i][e] : v[i][e] + o; } }
#pragma unroll
        for (int i = 0; i < 16; i += 2) { const f32x4 a = v[i] + v[i + 1], b = v[i] - v[i + 1]; v[i] = a; v[i + 1] = b; }
    }
#pragma unroll
    for (int i = 0; i < 16; ++i) { const float gk = gain ? gain[k0 + 4 * i + lr] * scale : scale; f32x4 a = v[i] * gk;
        v2u o;
        if (mode == 2) { unsigned u[4];
            _Pragma("unroll") for (int e = 0; e < 4; ++e) u[e] = __float_as_uint(__builtin_amdgcn_fmed3f(__builtin_fmaf(v[i][e], gk, 12582912.0f), 12582912.0f - 127.0f, 12582912.0f + 127.0f));
            o.x = __builtin_amdgcn_perm(u[1], u[0], 0x05040100u); o.y = __builtin_amdgcn_perm(u[3], u[2], 0x05040100u); }
        else { o.x = pk2(a[0], a[1]); o.y = pk2(a[2], a[3]); }
        *(LAS v2u*)(scr + (4 * i + lr) * 144 + 8 * lc) = o; }
    LDS_WAIT(); asm volatile("" ::: "memory");
#pragma unroll
    for (int kh = 0; kh < 2; ++kh)
#pragma unroll
        for (int nq = 0; nq < 4; ++nq) { const bf16x8 t = tr_frag(scr, 144, 32 * kh, 16 * nq, lane);
            if (!f8) *(GAS bf16x8*)(WT + (size_t)(drow + 16 * nq + lc) * K + k0 + 32 * kh + 8 * lr) = t;
            else if (mode == 2) { const v4u tt = __builtin_bit_cast(v4u, t); v2u o; o.x = __builtin_amdgcn_perm(tt.y, tt.x, 0x06040200u); o.y = __builtin_amdgcn_perm(tt.w, tt.z, 0x06040200u);
                   *(GAS v2u*)((unsigned char*)WT + (size_t)(drow + 16 * nq + lc) * K + pg8::kperm8(k0 + 32 * kh + 8 * lr)) = o; }
            else { int q0 = __builtin_amdgcn_cvt_pk_fp8_f32(bf2f((unsigned short)t[0]), bf2f((unsigned short)t[1]), 0, false); q0 = __builtin_amdgcn_cvt_pk_fp8_f32(bf2f((unsigned short)t[2]), bf2f((unsigned short)t[3]), q0, true);
                   int q1 = __builtin_amdgcn_cvt_pk_fp8_f32(bf2f((unsigned short)t[4]), bf2f((unsigned short)t[5]), 0, false); q1 = __builtin_amdgcn_cvt_pk_fp8_f32(bf2f((unsigned short)t[6]), bf2f((unsigned short)t[7]), q1, true);
                   v2u o; o.x = (unsigned)q0; o.y = (unsigned)q1; *(GAS v2u*)((unsigned char*)WT + (size_t)(drow + 16 * nq + lc) * K + k0 + 32 * kh + 8 * lr) = o; } }
    LDS_WAIT(); asm volatile("" ::: "memory");
}
__device__ __forceinline__ void p0_prologue(Frame& F) {
    LAS unsigned char* scr = F.lds + F.wave * 16384;
    const int gw = blockIdx.x * NWAVES + F.wave, NGW = F.G * NWAVES;
    LAS float* wq = (LAS float*)(F.lds + WQ_OFF); LAS float* wred = (LAS float*)(F.lds + WQ_OFF + 64);
    for (int l = 0; l < DEPTH; ++l) { float s = 0.f;
#pragma unroll 4
        for (int j = 0; j < 16; ++j) { const int k = 256 * j; const float gk = F.norm_g[l * D + k]; const float a = F.w_in[((size_t)l * D + k) * IN_W + 8192 + 2 * F.tid] * gk, b = F.w_in[((size_t)l * D + k) * IN_W + 8192 + 2 * F.tid + 1] * gk; s += a * a + b * b; }
        s = wave_sum(s, F.lane); if (F.lane == 0) wred[l * 8 + F.wave] = s;
        float s2 = 0.f;
#pragma unroll 4
        for (int j = 0; j < 16; ++j) { const float a = F.w_out[((size_t)l * D + 256 * j) * D + 2 * F.tid], b = F.w_out[((size_t)l * D + 256 * j) * D + 2 * F.tid + 1]; s2 += a * a + b * b; }
        s2 = wave_sum(s2, F.lane); if (F.lane == 0) wred[(DEPTH + l) * 8 + F.wave] = s2; }
    __syncthreads();
    if (F.tid < 2 * DEPTH) { float s = 0.f;
#pragma unroll
        for (int w_ = 0; w_ < 8; ++w_) s += wred[F.tid * 8 + w_];
        const float q = 127.0f / QC_W * __builtin_amdgcn_rsqf(s * (1.0f / 16384.0f) + 1e-30f); wq[F.tid] = q; ((float*)(F.ws + WS_SX))[2 * M + F.tid] = q; }
    __syncthreads();
    constexpr int I_IN = 64 * 304, I_GLA = 32 * 64, I_OUT = 64 * 64, I_L = I_IN + 2 * I_GLA + I_OUT;
    for (int it = gw; it < DEPTH * I_L; it += NGW) {
        const int l = it / I_L; int r = it - l * I_L;
        if (r < I_IN) { const int kb = r / 304, nb = r - kb * 304; const int scol = nb < 96 ? nb * 64 : nb * 64 + 16;
            if (nb < NZ_BF / 64) p0_transpose_item(F.w_in + (size_t)l * D * IN_W, IN_W, scol, D, (bf16*)(F.ws + WS_WIN) + (size_t)l * NZ * D, nb * 64, F.norm_g + l * D, 1.0f, 0, scr, kb, F.lane);
            else p0_transpose_item(F.w_in + (size_t)l * D * IN_W, IN_W, scol, D, (bf16*)(F.ws + WS_WIN8 + (size_t)l * NZ_F8 * D), nb * 64 - NZ_BF, F.norm_g + l * D, wq[l], 2, scr, kb, F.lane);
            continue; }
        r -= I_IN;
        if (r < I_GLA) { const int kb = r >> 6, nb = r & 63; p0_transpose_item(F.w_gla + (size_t)l * 2048 * D, D, nb * 64, 2048, (bf16*)(F.ws + WS_WGLA) + (size_t)l * D * 2048, nb * 64, nullptr, 1.0f, 0, scr, kb, F.lane); continue; }
        r -= I_GLA;
        if (r < I_GLA) { const int kb = r >> 6, nb = r & 63; p0_transpose_item(F.w_swa + (size_t)l * 2048 * D, D, nb * 64, 2048, (bf16*)(F.ws + WS_WSWA + (size_t)l * D * 2048), nb * 64, nullptr, W8_SCALE, 1, scr, kb, F.lane); continue; }
        r -= I_GLA;
        { const int kb = r >> 6, nb = r & 63; p0_transpose_item(F.w_out + (size_t)l * D * D, D, nb * 64, D, (bf16*)(F.ws + WS_WOUT + (size_t)l * D * D), nb * 64, nullptr, wq[DEPTH + l] * 0.35355339f, 3, scr, kb, F.lane); }
    }
    for (int idx = blockIdx.x * (NWAVES * 64) + F.tid; idx < DEPTH * 16 * D; idx += F.G * NWAVES * 64) {
        const int l = idx >> 16, j = (idx >> 12) & 15, k = idx & 4095;
        ((bf16*)(F.ws + WS_WDEC))[idx] = (bf16)f2bf(F.norm_g[l * D + k] * F.w_in[((size_t)l * D + k) * IN_W + 6144 + j]);
    }
    float* ssqp = (float*)(F.ws + WS_SSQP); float* sx0 = (float*)(F.ws + WS_SX);
    for (int m = gw; m < M; m += NGW) {
        const GAS f32x4* xr = (const GAS f32x4*)(F.x + (size_t)m * D) + F.lane; GAS v2u* o8 = (GAS v2u*)((bf16*)(F.ws + WS_XB) + (size_t)m * D) + F.lane; GAS unsigned* q8 = (GAS unsigned*)(F.ws + WS_X8 + (size_t)m * D) + F.lane; float s = 0.f;
        v2u w[16];
#pragma unroll
        for (int j = 0; j < 16; ++j) { const f32x4 v = xr[64 * j]; w[j].x = pk2(v.x, v.y); w[j].y = pk2(v.z, v.w); o8[64 * j] = w[j];
            const float r0 = bflo(w[j].x), r1 = bfhi(w[j].x), r2 = bflo(w[j].y), r3 = bfhi(w[j].y); s += (r0 * r0 + r1 * r1) + (r2 * r2 + r3 * r3); }
        s = wave_sum(s, F.lane); ssqp[(size_t)m * 64 + F.lane] = (F.lane == 0) ? s : 0.f;
        const float q = 127.0f / QC_X0 * __builtin_amdgcn_rsqf(s * (1.0f / D) + RMS_EPS);
        if (F.lane == 0) sx0[m] = q;
#pragma unroll
        for (int j = 0; j < 16; ++j) { const int c = 4 * F.lane + 256 * j; *(GAS unsigned*)(F.ws + WS_X8 + (size_t)m * D + pg8::kperm8(c & ~7) + (c & 7)) = pg8::q8x4(bflo(w[j].x), bfhi(w[j].x), bflo(w[j].y), bfhi(w[j].y), q); }
    }
}
__device__ __forceinline__ void final_norm(Frame& F) {
    const int gw = blockIdx.x * NWAVES + F.wave, NGW = F.G * NWAVES;
    const bf16* X = (const bf16*)(F.ws + WS_XB);
    for (int m = gw; m < M; m += NGW) {
        const GAS v4u* xr = (const GAS v4u*)(X + (size_t)m * D) + F.lane; const GAS f32x4* gr = (const GAS f32x4*)F.fin_g + 2 * F.lane; GAS f32x4* orow = (GAS f32x4*)(F.out + (size_t)m * D) + 2 * F.lane;
        v4u v[8]; float s = 0.f;
#pragma unroll
        for (int j = 0; j < 8; ++j) { v[j] = xr[64 * j]; const float r0 = bflo(v[j].x), r1 = bfhi(v[j].x), r2 = bflo(v[j].y), r3 = bfhi(v[j].y), r4 = bflo(v[j].z), r5 = bfhi(v[j].z), r6 = bflo(v[j].w), r7 = bfhi(v[j].w);
            s += ((r0 * r0 + r1 * r1) + (r2 * r2 + r3 * r3)) + ((r4 * r4 + r5 * r5) + (r6 * r6 + r7 * r7)); }
        const float rs = __builtin_amdgcn_rsqf(wave_sum(s, F.lane) * (1.0f / D) + RMS_EPS);
#pragma unroll
        for (int j = 0; j < 8; ++j) { const f32x4 g0 = gr[128 * j], g1 = gr[128 * j + 1];
            orow[128 * j] = (f32x4){bflo(v[j].x) * rs * g0[0], bfhi(v[j].x) * rs * g0[1], bflo(v[j].y) * rs * g0[2], bfhi(v[j].y) * rs * g0[3]};
            orow[128 * j + 1] = (f32x4){bflo(v[j].z) * rs * g1[0], bfhi(v[j].z) * rs * g1[1], bflo(v[j].w) * rs * g1[2], bfhi(v[j].w) * rs * g1[3]}; }
    }
}
__device__ __forceinline__ void gdec_phase(Frame& F, int l) {
    LAS float* red = (LAS float*)F.lds;
    const bf16* Wd = (const bf16*)(F.ws + WS_WDEC) + (size_t)l * 16 * D; const bf16* XBp = (const bf16*)(F.ws + WS_XB); const float* ssqp = (const float*)(F.ws + WS_SSQP); float* GD = (float*)(F.ws + WS_GDEC);
    const int lane = F.lane, fr = lane & 15, fq = lane >> 4;
    for (int rb = blockIdx.x; rb < M / 64; rb += F.G) {
        const int r0 = (F.G == 256) ? ((8 * (rb & 7) + ((rb >> 3) & 7)) * 256 + (rb >> 6) * 64) : rb * 64, k0 = F.wave * 512;
        f32x4 acc[4];
#pragma unroll
        for (int rt = 0; rt < 4; ++rt) acc[rt] = (f32x4){0.f, 0.f, 0.f, 0.f};
#pragma unroll 4
        for (int ks = 0; ks < 16; ++ks) { const int k = k0 + ks * 32 + 8 * fq;
            const bf16x8 X = *(const GAS bf16x8*)(Wd + (size_t)fr * D + k);
#pragma unroll
            for (int rt = 0; rt < 4; ++rt) { const bf16x8 Y = *(const GAS bf16x8*)(XBp + (size_t)(r0 + rt * 16 + fr) * D + k); acc[rt] = MFMA16(X, Y, acc[rt]); } }
#pragma unroll
        for (int rt = 0; rt < 4; ++rt) *(LAS f32x4*)(red + ((F.wave * 4 + rt) * 64 + lane) * 4) = acc[rt];
        __syncthreads();
        if (F.tid < 256) { const int rt = F.tid >> 6, ln = F.tid & 63; f32x4 s = (f32x4){0.f, 0.f, 0.f, 0.f};
#pragma unroll
            for (int w = 0; w < 8; ++w) s += *(LAS f32x4*)(red + ((w * 4 + rt) * 64 + ln) * 4);
            const int row = r0 + rt * 16 + (ln & 15); const float rs = pg8::row_rstd(ssqp, row);
            *(GAS f32x4*)(GD + (size_t)row * 16 + 4 * (ln >> 4)) = s * rs; }
        __syncthreads();
    }
}
constexpr int NGROUP = BATCH * 8 * 8;
constexpr int GA_GD = 0, GA_BL = 4096, GA_KS = GA_BL + 64 * 528, GA_V = GA_KS + 64 * 272, GA_SEG = GA_V + 64 * 528, GA_BRL = GA_SEG + 2048, GA_EB = GA_BRL + 1024, GA_EL = GA_EB + 512, GA_END = GA_EL + 512;
static_assert(GA_END <= RING_BYTES, "GLA-a LDS map");
__device__ __forceinline__ void gla_a_phase(Frame& F, int l) {
    LAS unsigned char* lds = F.lds;
    LAS float* gd = (LAS float*)(lds + GA_GD); LAS float* bL = (LAS float*)(lds + GA_BL); LAS unsigned char* ksL = lds + GA_KS; LAS unsigned char* Vl = lds + GA_V; LAS float* seg = (LAS float*)(lds + GA_SEG); LAS float* brl = (LAS float*)(lds + GA_BRL); LAS float* ebL = (LAS float*)(lds + GA_EB); LAS float* elL = (LAS float*)(lds + GA_EL);
    const int tid = F.tid, lane = F.lane, w = F.wave, d = tid & 127, tq = tid >> 7, fr = lane & 15, fq = lane >> 4;
    const bf16* Z = (const bf16*)(F.ws + WS_Z); const float* GD = (const float*)(F.ws + WS_GDEC);
    bf16* QT = (bf16*)(F.ws + WS_QT); bf16* KT = (bf16*)(F.ws + WS_KT); bf16* SLOC = (bf16*)(F.ws + WS_U);
    float* EBREF = (float*)(F.ws + WS_QI); float* ELR = EBREF + (size_t)BATCH * 8 * 64 * 128; float* DG = ELR + (size_t)BATCH * 8 * 64 * 128;
    const float SC = 0.08838834764831845f;
    f32x4 pgd; v4u pv[4], pq[2], pk[2];
#define GA_FETCH(item_) do { const int n_ = (item_) & 63, h_ = ((item_) >> 6) & 7, b_ = (item_) >> 9, t0_ = b_ * SEQ + n_ * 64; \
        pgd = *(const GAS f32x4*)(GD + (size_t)t0_ * 16 + (tid & 255) * 4); \
        _Pragma("unroll") for (int i = 0; i < 4; ++i) { const int c = tid + 512 * i, t = c >> 5, dv0 = (c & 31) * 8; pv[i] = *(const GAS v4u*)(Z + (size_t)(t0_ + t) * LDZ + OFF_GV + h_ * 256 + dv0); } \
        _Pragma("unroll") for (int i = 0; i < 2; ++i) { const int id = tid + 512 * i, t = id >> 4, d0 = (id & 15) * 8; const size_t zr = (size_t)(t0_ + t) * LDZ + h_ * 128 + d0; pq[i] = *(const GAS v4u*)(Z + zr + OFF_GQ); pk[i] = *(const GAS v4u*)(Z + zr + OFF_GK); } } while (0)
    { const int g0_ = (int)blockIdx.x < NGROUP ? (int)blockIdx.x : NGROUP - 1; GA_FETCH((g0_ >> 3) * 64 + (g0_ & 7) * 8); }
    for (int gi = blockIdx.x; gi < NGROUP; gi += F.G) {
        const int bh = gi >> 3, g = gi & 7, h = bh & 7, b = bh >> 3;
        float wu[16];
#pragma unroll
        for (int r = 0; r < 16; ++r) wu[r] = F.w_up[(size_t)(l * 16 + r) * 1024 + h * 128 + d];
        const float bias = F.b_dec[l * 1024 + h * 128 + d];
        f32x4 acc[8][2];
#pragma unroll
        for (int i = 0; i < 8; ++i) { acc[i][0] = (f32x4){0.f, 0.f, 0.f, 0.f}; acc[i][1] = (f32x4){0.f, 0.f, 0.f, 0.f}; }
        float sumbl = 0.f;
#pragma unroll 1
        for (int j = 0; j < 8; ++j) {
            const int n = 8 * g + j, item = bh * 64 + n, t0 = b * SEQ + n * 64;
            if (tid < 256) *(LAS f32x4*)(gd + tid * 4) = pgd;
#pragma unroll
            for (int i = 0; i < 4; ++i) { const int c = tid + 512 * i, t = c >> 5, dv0 = (c & 31) * 8; *(LAS v4u*)(Vl + t * 528 + dv0 * 2) = pv[i]; }
            v4u q8[2], k8[2];
#pragma unroll
            for (int i = 0; i < 2; ++i) { q8[i] = pq[i]; k8[i] = pk[i]; }
            __syncthreads();
            { const int nx = (j < 7) ? item + 1 : ((gi + F.G) >> 3) * 64 + ((gi + F.G) & 7) * 8; if (j < 7 || gi + F.G < NGROUP) GA_FETCH(nx); }
            float c[16]; float run = 0.f;
#pragma unroll
            for (int i = 0; i < 16; ++i) { const int t = 16 * tq + i; float lg = bias; const f32x4 g0 = *(LAS f32x4*)(gd + t * 16), g1 = *(LAS f32x4*)(gd + t * 16 + 4), g2 = *(LAS f32x4*)(gd + t * 16 + 8), g3 = *(LAS f32x4*)(gd + t * 16 + 12);
                lg += g0[0] * wu[0] + g0[1] * wu[1] + g0[2] * wu[2] + g0[3] * wu[3]; lg += g1[0] * wu[4] + g1[1] * wu[5] + g1[2] * wu[6] + g1[3] * wu[7];
                lg += g2[0] * wu[8] + g2[1] * wu[9] + g2[2] * wu[10] + g2[3] * wu[11]; lg += g3[0] * wu[12] + g3[1] * wu[13] + g3[2] * wu[14] + g3[3] * wu[15];
                const float ls = fminf(lg, 0.f) - __logf(1.0f + __expf(-fabsf(lg))); const float la = fmaxf(ls * (1.0f / 16.0f), -1.0f); run += la; c[i] = run; }
            seg[tq * 128 + d] = run;
            __syncthreads();
            float pre = 0.f;
            if (tq > 0) pre += seg[d]; if (tq > 1) pre += seg[128 + d]; if (tq > 2) pre += seg[256 + d];
#pragma unroll
            for (int i = 0; i < 16; ++i) bL[(16 * tq + i) * 132 + d] = c[i] + pre;
            if (tq == 2) brl[d] = c[0] + pre;
            if (tq == 3) brl[128 + d] = c[15] + pre;
            __syncthreads();
            if (tid < 128) { const float bref = brl[tid], blast = brl[128 + tid], eb = __expf(bref), el = __expf(blast - bref); ebL[tid] = eb; elL[tid] = el; sumbl += blast;
                EBREF[(size_t)item * 128 + tid] = eb; ELR[(size_t)item * 128 + tid] = el; }
#pragma unroll
            for (int i = 0; i < 2; ++i) { const int id = tid + 512 * i, t = id >> 4, d0 = (id & 15) * 8;
                const f32x4 b0 = *(LAS f32x4*)(bL + t * 132 + d0), b1 = *(LAS f32x4*)(bL + t * 132 + d0 + 4), r0 = *(LAS f32x4*)(brl + d0), r1 = *(LAS f32x4*)(brl + d0 + 4);
                const float bb[8] = {b0[0], b0[1], b0[2], b0[3], b1[0], b1[1], b1[2], b1[3]}, rr[8] = {r0[0], r0[1], r0[2], r0[3], r1[0], r1[1], r1[2], r1[3]};
                const unsigned qw[4] = {q8[i].x, q8[i].y, q8[i].z, q8[i].w}, kw[4] = {k8[i].x, k8[i].y, k8[i].z, k8[i].w};
                float oq[8], ok[8];
#pragma unroll
                for (int jj = 0; jj < 8; ++jj) { const float q = ((jj & 1) ? bfhi(qw[jj >> 1]) : bflo(qw[jj >> 1])) * SC, k = (jj & 1) ? bfhi(kw[jj >> 1]) : bflo(kw[jj >> 1]);
                    const float e1 = __expf(bb[jj] - rr[jj]), e2 = __builtin_amdgcn_rcpf(e1);
                    oq[jj] = q * e1; ok[jj] = k * e2; }
                const size_t o = (size_t)(t0 + t) * 1024 + h * 128 + d0;
                v4u w4; w4.x = pk2(oq[0], oq[1]); w4.y = pk2(oq[2], oq[3]); w4.z = pk2(oq[4], oq[5]); w4.w = pk2(oq[6], oq[7]); *(GAS v4u*)(QT + o) = w4;
                w4.x = pk2(ok[0], ok[1]); w4.y = pk2(ok[2], ok[3]); w4.z = pk2(ok[4], ok[5]); w4.w = pk2(ok[6], ok[7]); *(GAS v4u*)(KT + o) = w4; *(LAS v4u*)(ksL + t * 272 + d0 * 2) = w4; }
            __syncthreads();
#pragma unroll
            for (int dkt = 0; dkt < 8; ++dkt) { const f32x4 e4 = *(LAS f32x4*)(ebL + dkt * 16 + 4 * fq); acc[dkt][0] *= e4; acc[dkt][1] *= e4; }
#pragma unroll
            for (int ks = 0; ks < 2; ++ks) { bf16x8 Y[2];
#pragma unroll
                for (int jv = 0; jv < 2; ++jv) Y[jv] = tr_frag(Vl, 528, ks * 32, (2 * w + jv) * 16, lane);
#pragma unroll
                for (int dkt = 0; dkt < 8; ++dkt) { const bf16x8 X = tr_frag(ksL, 272, ks * 32, dkt * 16, lane);
                    acc[dkt][0] = MFMA16(X, Y[0], acc[dkt][0]); acc[dkt][1] = MFMA16(X, Y[1], acc[dkt][1]); } }
#pragma unroll
            for (int dkt = 0; dkt < 8; ++dkt) { const f32x4 e4 = *(LAS f32x4*)(elL + dkt * 16 + 4 * fq); acc[dkt][0] *= e4; acc[dkt][1] *= e4; }
            __syncthreads();
        }
#pragma unroll
        for (int dkt = 0; dkt < 8; ++dkt)
#pragma unroll
            for (int jv = 0; jv < 2; ++jv) { const int dv = (2 * w + jv) * 16 + fr, dk = dkt * 16 + 4 * fq; const f32x4 a = acc[dkt][jv];
                v2u o; o.x = pk2(a[0], a[1]); o.y = pk2(a[2], a[3]); *(GAS v2u*)(SLOC + ((size_t)gi * 256 + dv) * 128 + dk) = o; }
        if (tid < 128) DG[(size_t)gi * 128 + tid] = __expf(sumbl);
    }
#undef GA_FETCH
}
__device__ __forceinline__ void gla_scan_phase(Frame& F) {
    const bf16* SLOC = (const bf16*)(F.ws + WS_U); bf16* SST = (bf16*)(F.ws + WS_SP); const float* DG = (const float*)(F.ws + WS_QI) + (size_t)2 * BATCH * 8 * 64 * 128;
    for (int idx = blockIdx.x * (NWAVES * 64) + F.tid; idx < BATCH * 8 * 256 * 16; idx += F.G * NWAVES * 64) {
        const int bh = idx >> 12, dv = (idx >> 4) & 255, dk0 = (idx & 15) * 8;
        float S[8]; float z0_; asm volatile("v_mov_b32 %0, 0" : "=v"(z0_));
#pragma unroll
        for (int j = 0; j < 8; ++j) S[j] = z0_;
#pragma unroll
        for (int g = 0; g < 8; ++g) { const size_t gi = (size_t)bh * 8 + g, off = (gi * 256 + dv) * 128 + dk0;
            const v4u u = *(const GAS v4u*)(SLOC + off); const f32x4 d0 = *(const GAS f32x4*)(DG + gi * 128 + dk0), d1 = *(const GAS f32x4*)(DG + gi * 128 + dk0 + 4);
            v4u o; o.x = pk2(S[0], S[1]); o.y = pk2(S[2], S[3]); o.z = pk2(S[4], S[5]); o.w = pk2(S[6], S[7]); *(GAS v4u*)(SST + off) = o;
            S[0] = d0[0] * S[0] + bflo(u.x); S[1] = d0[1] * S[1] + bfhi(u.x); S[2] = d0[2] * S[2] + bflo(u.y); S[3] = d0[3] * S[3] + bfhi(u.y);
            S[4] = d1[0] * S[4] + bflo(u.z); S[5] = d1[1] * S[5] + bfhi(u.z); S[6] = d1[2] * S[6] + bflo(u.w); S[7] = d1[3] * S[7] + bfhi(u.w); }
    }
}
constexpr int GC_QT = 0, GC_KT = 17408, GC_V = 34816, GC_AL = GC_V + 64 * 528, GC_PART = GC_AL + 64 * 144, GC_EB = GC_PART + 2048, GC_EL = GC_EB + 512, GC_END = GC_EL + 512;
static_assert(GC_END <= RING_BYTES, "GLA-c LDS map");
__device__ __forceinline__ void gla_c_phase(Frame& F, int l) {
    LAS unsigned char* lds = F.lds;
    LAS bf16* qT = (LAS bf16*)(lds + GC_QT); LAS bf16* kT = (LAS bf16*)(lds + GC_KT); LAS unsigned char* Vl = lds + GC_V; LAS bf16* Al = (LAS bf16*)(lds + GC_AL);
    LAS float* part = (LAS float*)(lds + GC_PART); LAS float* ebL = (LAS float*)(lds + GC_EB); LAS float* elL = (LAS float*)(lds + GC_EL);
    const int tid = F.tid, lane = F.lane, w = F.wave, fr = lane & 15, fq = lane >> 4;
    const bf16* Z = (const bf16*)(F.ws + WS_Z); const bf16* QT = (const bf16*)(F.ws + WS_QT); const bf16* KT = (const bf16*)(F.ws + WS_KT); const bf16* SST = (const bf16*)(F.ws + WS_SP);
    const float* EBREF = (const float*)(F.ws + WS_QI); const float* ELR = EBREF + (size_t)BATCH * 8 * 64 * 128;
    bf16* AA = (bf16*)(F.ws + WS_AA);
    v4u rq[2], rk[2], rv[4]; float reb, rel;
#define GC_FETCH(item_) do { const int n_ = (item_) & 63, h_ = ((item_) >> 6) & 7, b_ = (item_) >> 9, t0_ = b_ * SEQ + n_ * 64; \
        _Pragma("unroll") for (int i = 0; i < 2; ++i) { const int c = tid + 512 * i, t = c >> 4, d0 = (c & 15) * 8; const size_t g_ = (size_t)(t0_ + t) * 1024 + h_ * 128 + d0; rq[i] = *(const GAS v4u*)(QT + g_); rk[i] = *(const GAS v4u*)(KT + g_); } \
        _Pragma("unroll") for (int i = 0; i < 4; ++i) { const int c = tid + 512 * i, t = c >> 5, dv0 = (c & 31) * 8; rv[i] = *(const GAS v4u*)(Z + (size_t)(t0_ + t) * LDZ + OFF_GV + h_ * 256 + dv0); } \
        reb = EBREF[(size_t)(item_) * 128 + (tid & 127)]; rel = ELR[(size_t)(item_) * 128 + (tid & 127)]; } while (0)
    { const int g0_ = (int)blockIdx.x < NGROUP ? (int)blockIdx.x : NGROUP - 1; GC_FETCH((g0_ >> 3) * 64 + (g0_ & 7) * 8); }
    for (int gi = blockIdx.x; gi < NGROUP; gi += F.G) {
        const int bh = gi >> 3, g = gi & 7, h = bh & 7, b = bh >> 3;
        f32x4 Sa[8][2];
#pragma unroll
        for (int dkt = 0; dkt < 8; ++dkt)
#pragma unroll
            for (int jv = 0; jv < 2; ++jv) { const v2u s = *(const GAS v2u*)(SST + ((size_t)gi * 256 + (2 * w + jv) * 16 + fr) * 128 + dkt * 16 + 4 * fq); Sa[dkt][jv] = (f32x4){bflo(s.x), bfhi(s.x), bflo(s.y), bfhi(s.y)}; }
#pragma unroll 1
        for (int j = 0; j < 8; ++j) {
            const int n = 8 * g + j, item = bh * 64 + n, t0 = b * SEQ + n * 64;
#pragma unroll
            for (int i = 0; i < 2; ++i) { const int c = tid + 512 * i, t = c >> 4, d0 = (c & 15) * 8; *(LAS v4u*)(qT + t * 136 + d0) = rq[i]; *(LAS v4u*)(kT + t * 136 + d0) = rk[i]; }
#pragma unroll
            for (int i = 0; i < 4; ++i) { const int c = tid + 512 * i, t = c >> 5, dv0 = (c & 31) * 8; *(LAS v4u*)(Vl + t * 528 + dv0 * 2) = rv[i]; }
            if (tid < 128) { ebL[tid] = reb; elL[tid] = rel; }
            __syncthreads();
            { const int nx = (j < 7) ? item + 1 : ((gi + F.G) >> 3) * 64 + ((gi + F.G) & 7) * 8; if (j < 7 || gi + F.G < NGROUP) GC_FETCH(nx); }
            { const int it = w >> 1;
#pragma unroll
              for (int jj = 0; jj < 2; ++jj) { const int jt = 2 * (w & 1) + jj; f32x4 a = (f32x4){0.f, 0.f, 0.f, 0.f};
                  if (jt <= it) {
#pragma unroll
                      for (int ks = 0; ks < 4; ++ks) { const bf16x8 X = *(LAS bf16x8*)(kT + (jt * 16 + fr) * 136 + ks * 32 + 8 * fq); const bf16x8 Y = *(LAS bf16x8*)(qT + (it * 16 + fr) * 136 + ks * 32 + 8 * fq); a = MFMA16(X, Y, a); }
                      const int ii = it * 16 + fr, j0 = jt * 16 + 4 * fq;
#pragma unroll
                      for (int e = 0; e < 4; ++e) if (j0 + e > ii) a[e] = 0.f;
                  }
                  v2u o; o.x = pk2(a[0], a[1]); o.y = pk2(a[2], a[3]); *(LAS v2u*)(Al + (it * 16 + fr) * 72 + jt * 16 + 4 * fq) = o; } }
#pragma unroll
            for (int dkt = 0; dkt < 8; ++dkt) { const f32x4 e4 = *(LAS f32x4*)(ebL + dkt * 16 + 4 * fq); Sa[dkt][0] *= e4; Sa[dkt][1] *= e4; }
            __syncthreads();
            f32x4 acc[2][4];
#pragma unroll
            for (int jv = 0; jv < 2; ++jv)
#pragma unroll
                for (int tt = 0; tt < 4; ++tt) acc[jv][tt] = (f32x4){0.f, 0.f, 0.f, 0.f};
#pragma unroll
            for (int ks = 0; ks < 4; ++ks) { bf16x8 X[2];
#pragma unroll
                for (int jv = 0; jv < 2; ++jv) { const f32x4 s0 = Sa[2 * ks][jv], s1 = Sa[2 * ks + 1][jv]; v4u p; p.x = pk2(s0[0], s0[1]); p.y = pk2(s0[2], s0[3]); p.z = pk2(s1[0], s1[1]); p.w = pk2(s1[2], s1[3]); X[jv] = __builtin_bit_cast(bf16x8, p); }
#pragma unroll
                for (int tt = 0; tt < 4; ++tt) { const v2u y0 = *(LAS v2u*)(qT + (tt * 16 + fr) * 136 + ks * 32 + 4 * fq), y1 = *(LAS v2u*)(qT + (tt * 16 + fr) * 136 + ks * 32 + 16 + 4 * fq);
                    v4u yy; yy.x = y0.x; yy.y = y0.y; yy.z = y1.x; yy.w = y1.y; const bf16x8 Y = __builtin_bit_cast(bf16x8, yy);
                    acc[0][tt] = MFMA16(X[0], Y, acc[0][tt]); acc[1][tt] = MFMA16(X[1], Y, acc[1][tt]); } }
#pragma unroll
            for (int ks = 0; ks < 2; ++ks) { bf16x8 X[2];
#pragma unroll
                for (int jv = 0; jv < 2; ++jv) X[jv] = tr_frag(Vl, 528, ks * 32, (2 * w + jv) * 16, lane);
#pragma unroll
                for (int tt = 0; tt < 4; ++tt) { if (ks == 1 && tt < 2) continue; const bf16x8 Y = *(LAS bf16x8*)(Al + (tt * 16 + fr) * 72 + ks * 32 + 8 * fq); acc[0][tt] = MFMA16(X[0], Y, acc[0][tt]); acc[1][tt] = MFMA16(X[1], Y, acc[1][tt]); }
#pragma unroll
                for (int dkt = 0; dkt < 8; ++dkt) { const bf16x8 K = tr_frag((LAS unsigned char*)kT, 272, ks * 32, dkt * 16, lane);
                    Sa[dkt][0] = MFMA16(K, X[0], Sa[dkt][0]); Sa[dkt][1] = MFMA16(K, X[1], Sa[dkt][1]); } }
#pragma unroll
            for (int dkt = 0; dkt < 8; ++dkt) { const f32x4 e4 = *(LAS f32x4*)(elL + dkt * 16 + 4 * fq); Sa[dkt][0] *= e4; Sa[dkt][1] *= e4; }
            v2u gg[4][2];
#pragma unroll
            for (int jv = 0; jv < 2; ++jv)
#pragma unroll
                for (int tt = 0; tt < 4; ++tt) gg[tt][jv] = *(const GAS v2u*)(Z + (size_t)(t0 + tt * 16 + fr) * LDZ + OFF_GG + h * 256 + (2 * w + jv) * 16 + 4 * fq);
#pragma unroll
            for (int tt = 0; tt < 4; ++tt) { float s = 0.f;
#pragma unroll
                for (int jv = 0; jv < 2; ++jv) { const f32x4 a = acc[jv][tt]; s += (a[0] * a[0] + a[1] * a[1]) + (a[2] * a[2] + a[3] * a[3]); }
                s += pg8::shx(s, lane, 16); s += pg8::shx(s, lane, 32);
                if (fq == 0) part[(tt * 16 + fr) * 8 + w] = s; }
            __syncthreads();
#pragma unroll
            for (int tt = 0; tt < 4; ++tt) { const int t = tt * 16 + fr; const f32x4 p0 = *(LAS f32x4*)(part + t * 8), p1 = *(LAS f32x4*)(part + t * 8 + 4);
                const float rs = __builtin_amdgcn_rsqf(((p0[0] + p0[1]) + (p0[2] + p0[3]) + (p1[0] + p1[1]) + (p1[2] + p1[3])) * (1.0f / 256.0f) + RMS_EPS);
#pragma unroll
                for (int jv = 0; jv < 2; ++jv) { const int dv = (2 * w + jv) * 16 + 4 * fq; const v2u gv = gg[tt][jv]; const f32x4 a = acc[jv][tt]; const f32x4 gn = *(const GAS f32x4*)(F.gla_g + l * 256 + dv);
                    const float g0 = bflo(gv.x), g1 = bfhi(gv.x), g2 = bflo(gv.y), g3 = bfhi(gv.y);
                    const float o0 = a[0] * rs * gn[0] * g0 * __builtin_amdgcn_rcpf(1.0f + __expf(-g0)), o1 = a[1] * rs * gn[1] * g1 * __builtin_amdgcn_rcpf(1.0f + __expf(-g1));
                    const float o2 = a[2] * rs * gn[2] * g2 * __builtin_amdgcn_rcpf(1.0f + __expf(-g2)), o3 = a[3] * rs * gn[3] * g3 * __builtin_amdgcn_rcpf(1.0f + __expf(-g3));
                    v2u o; o.x = pk2(o0, o1); o.y = pk2(o2, o3); *(GAS v2u*)(AA + (size_t)(t0 + t) * 2048 + h * 256 + dv) = o; } }
        }
    }
    __syncthreads();
#undef GC_FETCH
}
constexpr int SW_K = 0, SW_V = 256 * 144, SW_P = SW_V + 288 * 144, SW_END = SW_P + 8 * 16 * 336;
static_assert(SW_END <= RING_BYTES, "SWA LDS map");
__device__ __forceinline__ void swa_phase(Frame& F, int l) {
    LAS unsigned char* lds = F.lds;
    LAS bf16* Kl = (LAS bf16*)(lds + SW_K); LAS unsigned char* Vl = lds + SW_V;
    const int tid = F.tid, lane = F.lane, w = F.wave, fr = lane & 15, fq = lane >> 4;
    LAS bf16* Pl = (LAS bf16*)(lds + SW_P + w * (16 * 336));
    const bf16* Z = (const bf16*)(F.ws + WS_Z); unsigned char* AB8 = F.ws + WS_AB;
    for (int i = tid; i < 32 * 144 / 4; i += NWAVES * 64) ((LAS unsigned*)(Vl + 256 * 144))[i] = 0u;
    const int NITEM = BATCH * 32 * 8;
    f32x4 pen0, pen8;
#pragma unroll
    for (int e = 0; e < 4; ++e) { pen0[e] = (4 * fq + e <= fr) ? -1e30f : 0.f; pen8[e] = (4 * fq + e > fr) ? -1e30f : 0.f; }
    v4u kreg[4], vreg[4];
#define SW_FETCH(item_) do { const int g_ = (item_) & 7, qb_ = ((item_) >> 3) & 31, b_ = (item_) >> 8, q0_ = b_ * SEQ + qb_ * 128; \
        _Pragma("unroll") for (int i = 0; i < 4; ++i) { const int c = tid + 512 * i, kr = c >> 3, d0 = (c & 7) * 8; int tok = q0_ - 128 + kr; if (tok < b_ * SEQ) tok = b_ * SEQ; \
            const size_t zr = (size_t)tok * LDZ + g_ * 64 + d0; kreg[i] = *(const GAS v4u*)(Z + zr + OFF_SK); vreg[i] = *(const GAS v4u*)(Z + zr + OFF_SV); } } while (0)
    SW_FETCH((int)blockIdx.x < NITEM ? (int)blockIdx.x : NITEM - 1);
    for (int item = blockIdx.x; item < NITEM; item += F.G) {
        const int g = item & 7, qb = (item >> 3) & 31, b = item >> 8, q0 = b * SEQ + qb * 128;
#pragma unroll
        for (int i = 0; i < 4; ++i) { const int c = tid + 512 * i, kr = c >> 3, d0 = (c & 7) * 8; *(LAS v4u*)(Kl + kr * 72 + d0) = kreg[i]; *(LAS v4u*)(Vl + kr * 144 + d0 * 2) = vreg[i]; }
        const int r = w >> 1, hq = g * 4 + r; const float sink = F.sinks[l * 32 + hq];
        bf16x8 Yc[2]; v2u gc[4];
        { const size_t qrow = (size_t)(q0 + 64 * (w & 1) + fr);
#pragma unroll
          for (int ks = 0; ks < 2; ++ks) Yc[ks] = *(const GAS bf16x8*)(Z + qrow * LDZ + OFF_SQ + hq * 64 + ks * 32 + 8 * fq);
#pragma unroll
          for (int c = 0; c < 4; ++c) gc[c] = *(const GAS v2u*)(Z + qrow * LDZ + OFF_SG + hq * 64 + c * 16 + 4 * fq); }
        __syncthreads();
        if (item + F.G < NITEM) SW_FETCH(item + F.G);
#pragma unroll 1
        for (int qt = 0; qt < 4; ++qt) {
            const int ql0 = 64 * (w & 1) + 16 * qt; const size_t qrow = (size_t)(q0 + ql0 + fr);
            bf16x8 Yn[2]; v2u gn[4];
            { const size_t qn = (size_t)(q0 + 64 * (w & 1) + 16 * ((qt + 1) & 3) + fr);
#pragma unroll
              for (int ks = 0; ks < 2; ++ks) Yn[ks] = *(const GAS bf16x8*)(Z + qn * LDZ + OFF_SQ + hq * 64 + ks * 32 + 8 * fq);
#pragma unroll
              for (int c = 0; c < 4; ++c) gn[c] = *(const GAS v2u*)(Z + qn * LDZ + OFF_SG + hq * 64 + c * 16 + 4 * fq); }
            f32x4 S[9];
#pragma unroll
            for (int kt = 0; kt < 9; ++kt) { f32x4 a = (f32x4){0.f, 0.f, 0.f, 0.f};
#pragma unroll
                for (int ks = 0; ks < 2; ++ks) { const bf16x8 X = *(LAS bf16x8*)(Kl + (ql0 + 16 * kt + fr) * 72 + ks * 32 + 8 * fq); a = MFMA16(X, Yc[ks], a); }
                S[kt] = a; }
            const int qpos = qb * 128 + ql0 + fr; const float CS = 0.125f * 1.4426950408889634f, sink2 = sink * 1.4426950408889634f;
            S[0] += pen0; S[8] += pen8;
            if (qb == 0) {
#pragma unroll
                for (int kt = 0; kt < 8; ++kt)
#pragma unroll
                    for (int e = 0; e < 4; ++e) if (qpos - 128 + 16 * kt + 4 * fq + e - fr < 0) S[kt][e] = -1e30f; }
            float mr = S[0][0];
#pragma unroll
            for (int kt = 0; kt < 9; ++kt) mr = fmaxf(fmaxf(mr, fmaxf(S[kt][0], S[kt][1])), fmaxf(S[kt][2], S[kt][3]));
            mr = fmaxf(mr, pg8::shx(mr, lane, 16)); mr = fmaxf(mr, pg8::shx(mr, lane, 32));
            const float m2 = fmaxf(mr * CS, sink2);
            float sum = 0.f;
#pragma unroll
            for (int kt = 0; kt < 9; ++kt) { f32x4 p;
#pragma unroll
                for (int e = 0; e < 4; ++e) { p[e] = __builtin_amdgcn_exp2f(S[kt][e] * CS - m2); sum += p[e]; }
                v2u o; o.x = pk2(p[0], p[1]); o.y = pk2(p[2], p[3]); *(LAS v2u*)(Pl + fr * 168 + 16 * kt + 4 * fq) = o; }
            { unsigned z0 = 0u; asm volatile("" : "+v"(z0)); v2u o; o.x = z0; o.y = z0; *(LAS v2u*)(Pl + fr * 168 + 144 + 4 * fq) = o; }
            sum += pg8::shx(sum, lane, 16); sum += pg8::shx(sum, lane, 32);
            const float iv = __builtin_amdgcn_rcpf(sum + __builtin_amdgcn_exp2f(sink2 - m2)) * AB8_SCALE;
            LDS_WAIT(); asm volatile("" ::: "memory");
            f32x4 O[4];
#pragma unroll
            for (int c = 0; c < 4; ++c) O[c] = (f32x4){0.f, 0.f, 0.f, 0.f};
#pragma unroll
            for (int k5 = 0; k5 < 5; ++k5) { const bf16x8 Y = *(LAS bf16x8*)(Pl + fr * 168 + k5 * 32 + 8 * fq);
#pragma unroll
                for (int c = 0; c < 4; ++c) { const bf16x8 X = tr_frag(Vl, 144, ql0 + 32 * k5, c * 16, lane); O[c] = MFMA16(X, Y, O[c]); } }
#pragma unroll
            for (int c = 0; c < 4; ++c) { const int dd = hq * 64 + c * 16 + 4 * fq; const v2u gv = gc[c];
                const float g0 = bflo(gv.x), g1 = bfhi(gv.x), g2 = bflo(gv.y), g3 = bfhi(gv.y);
                const float o0 = O[c][0] * iv * g0 * __builtin_amdgcn_rcpf(1.0f + __expf(-g0)), o1 = O[c][1] * iv * g1 * __builtin_amdgcn_rcpf(1.0f + __expf(-g1));
                const float o2 = O[c][2] * iv * g2 * __builtin_amdgcn_rcpf(1.0f + __expf(-g2)), o3 = O[c][3] * iv * g3 * __builtin_amdgcn_rcpf(1.0f + __expf(-g3));
                int q = __builtin_amdgcn_cvt_pk_fp8_f32(o0, o1, 0, false); q = __builtin_amdgcn_cvt_pk_fp8_f32(o2, o3, q, true); *(GAS unsigned*)(AB8 + qrow * 2048 + dd) = (unsigned)q; }
            asm volatile("" ::: "memory");
#pragma unroll
            for (int ks = 0; ks < 2; ++ks) Yc[ks] = Yn[ks];
#pragma unroll
            for (int c = 0; c < 4; ++c) gc[c] = gn[c];
        }
        __syncthreads();
    }
#undef SW_FETCH
}
#ifndef GEMM_BAL
#define GEMM_BAL true
#endif
#ifndef REP_PRO
#define REP_PRO 1
#endif
#ifndef REP_P1
#define REP_P1 1
#endif
#ifndef REP_GA
#define REP_GA 1
#endif
#ifndef REP_SWA
#define REP_SWA 1
#endif
#ifndef REP_SCAN
#define REP_SCAN 1
#endif
#ifndef REP_GC
#define REP_GC 1
#endif
#ifndef REP_P3
#define REP_P3 1
#endif
#ifndef REP_BAR
#define REP_BAR 1
#endif
#ifndef REP_P4
#define REP_P4 1
#endif
struct Args { const float* in[12]; float* out; unsigned char* ws; int ph_lo, ph_hi; };
static_assert(sizeof(Args) == 14 * 8 + 8, "Args has no holes");
__global__ void __launch_bounds__(NWAVES * 64, 2) hybrid_fwd(Args args) {
    extern __shared__ __attribute__((aligned(16))) unsigned char lds[];
    Frame F;
    F.lds = (LAS unsigned char*)lds; F.MISC = (volatile LAS unsigned*)(F.lds + MISC_OFF);
    F.tid = threadIdx.x; F.lane = F.tid & 63; F.wave = __builtin_amdgcn_readfirstlane(F.tid >> 6); F.G = gridDim.x;
    F.ws = args.ws; F.ctl = (gu32*)(args.ws + WS_CTL);
    F.x = args.in[0]; F.norm_g = args.in[1]; F.w_in = args.in[2]; F.b_gates = args.in[3]; F.w_up = args.in[4]; F.b_dec = args.in[5]; F.gla_g = args.in[6]; F.sinks = args.in[7];
    F.w_gla = args.in[8]; F.w_swa = args.in[9]; F.w_out = args.in[10]; F.fin_g = args.in[11]; F.out = args.out;
    for (int u = F.tid; u < (LDS_BYTES - LDSCTL_OFF) / 4; u += NWAVES * 64) ((LAS unsigned*)(F.lds + LDSCTL_OFF))[u] = 0u;
    __syncthreads();
    XcdBarrier bar; bar.bar = (unsigned*)(F.ctl + CW_BAR); bar.x = 0; bar.st = nullptr;
    if (!MK_PER_PHASE) bar = xcd_barrier_post((unsigned*)(F.ctl + CW_BAR), F.MISC + 8);
    const int wv0 = __builtin_amdgcn_readfirstlane(threadIdx.x >> 6);
    const int lo = args.ph_lo, hi = args.ph_hi;
#if MK_PER_PHASE
#define IN(k) (lo <= (k) && (k) < hi)
#else
#define IN(k) true
#endif
#define PHASE_BEGIN() do { unsigned m_ = ~0u; asm volatile("" : "+s"(m_)); int t_ = wv0 * 64 + (int)__builtin_amdgcn_mbcnt_hi(m_, __builtin_amdgcn_mbcnt_lo(m_, 0u)); asm volatile("" : "+v"(t_)); F.tid = t_; F.lane = t_ & 63; F.wave = __builtin_amdgcn_readfirstlane(t_ >> 6); unsigned long long z_ = 0ull; asm volatile("" : "+s"(z_)); unsigned char* w_ = args.ws + z_; F.ws = w_; F.ctl = (gu32*)(w_ + WS_CTL); } while (0)
#define SEAM(k) do { if (IN(k) && IN((k) + 1)) { unsigned long long z_ = 0ull; asm volatile("" : "+s"(z_)); bar.bar = (unsigned*)(args.ws + WS_CTL + z_) + CW_BAR; for (int rb_ = 0; rb_ < REP_BAR; ++rb_) xcd_barrier(bar); } } while (0)
    if (IN(0)) for (int rep = 0; rep < REP_PRO; ++rep) { PHASE_BEGIN(); p0_prologue(F); }
    SEAM(0);
    for (int l = 0; l < DEPTH; ++l) {
        const int p = 1 + 6 * l;
        if (IN(p)) for (int rep = 0; rep < REP_P1; ++rep) {
            PHASE_BEGIN(); const bf16* XBp = (const bf16*)(F.ws + WS_XB); bf16* Zp = (bf16*)(F.ws + WS_Z);
            gdec_phase(F, l);
            pg8::StaticOrder S; S.init(M, NZ_BF, F.G, (int)blockIdx.x);
            pg8::EpiZ E; E.Z = Zp; E.P = (const float*)(F.ws + WS_SSQP); E.rsl = (const LAS float*)(F.lds + RS_OFF); E.mul = 1.0f;
            const float* SXc = (const float*)(F.ws + WS_SX) + (size_t)(l & 1) * M; float* SXn = (float*)(F.ws + WS_SX) + (size_t)((l + 1) & 1) * M; const float iwq = 1.0f / ((const float*)(F.ws + WS_SX))[2 * M + l];
            { pg8::Unit u0; const bool has = S.next(0, u0); E.pm0 = has ? u0.pm : -1;
              if (has && F.tid < 256) { const int row = u0.pm * 256 + F.tid; const float rstd = pg8::row_rstd(E.P, row); ((LAS float*)(F.lds + RS_OFF))[F.tid] = rstd;
                  ((LAS float*)(F.lds + RS2_OFF))[F.tid] = rstd * iwq * __builtin_amdgcn_rcpf(SXc[row]); SXn[row] = (127.0f / QC_XP) * rstd; ((LAS float*)(F.lds + RS3_OFF))[F.tid] = (127.0f / QC_XP) * rstd; }
              __syncthreads(); }
            { pg8::Gemm g{XBp, (const bf16*)(F.ws + WS_WIN) + (size_t)l * NZ * D, M, NZ_BF, D};
              pg8::gemm_phase<pg8::EpiZ, pg8::StaticOrder, true, true, false, GEMM_BAL>(F.lds, g, S, E, F.tid); }
            { pg8::StaticOrder S8; S8.init(M, NZ_F8, F.G, (int)blockIdx.x); pg8::Unit u0; const bool has = S8.next(0, u0);
              pg8::EpiZ8 E8{Zp + NZ_BF, E.P, SXc, iwq, (!has || u0.pm != E.pm0) ? -1 : E.pm0, (const LAS float*)(F.lds + RS2_OFF), F.ws + WS_GT, (OFF_GA - NZ_BF) / 256};
              pg8::Gemm g{(const bf16*)(F.ws + WS_X8), (const bf16*)(F.ws + WS_WIN8 + (size_t)l * NZ_F8 * D), M, NZ_F8, D / 2};
              pg8::gemm_phase<pg8::EpiZ8, pg8::StaticOrder, true, true, false, GEMM_BAL, true>(F.lds, g, S8, E8, F.tid); }
        }
        SEAM(p);
        if (IN(p + 1)) { for (int rep = 0; rep < REP_GA; ++rep) { PHASE_BEGIN(); gla_a_phase(F, l); } for (int rep = 0; rep < REP_SWA; ++rep) { PHASE_BEGIN(); swa_phase(F, l); } }
        SEAM(p + 1);
        if (IN(p + 2)) for (int rep = 0; rep < REP_SCAN; ++rep) { PHASE_BEGIN(); gla_scan_phase(F); }
        SEAM(p + 2);
        if (IN(p + 3)) for (int rep = 0; rep < REP_GC; ++rep) { PHASE_BEGIN(); gla_c_phase(F, l); }
        SEAM(p + 3);
        if (IN(p + 4)) for (int rep = 0; rep < REP_P3; ++rep) {
            { PHASE_BEGIN(); bf16* Zp = (bf16*)(F.ws + WS_Z); pg8::Gemm g{(const bf16*)(F.ws + WS_AA), (const bf16*)(F.ws + WS_WGLA) + (size_t)l * D * 2048, M, D, 2048}; pg8::StaticOrder S; S.init(M, D, F.G, (int)blockIdx.x);
              LAS float* mred = (LAS float*)(F.lds + MQ_OFF + 16); if (F.tid < 8) mred[F.tid] = 0.f; __syncthreads();
              int nu = ((M / 256) * (D / 256) - (int)blockIdx.x + F.G - 1) / F.G; asm volatile("" : "+s"(nu));
              pg8::EpiGateA E{F.ws + WS_GT, F.b_gates + (size_t)(l * 2 + 0) * D, F.ws + WS_TMP, (LAS float*)mred};
              pg8::gemm_phase<pg8::EpiGateA, pg8::StaticOrder, false, true, false, GEMM_BAL>(F.lds, g, S, E, F.tid);
              __syncthreads();
              if (F.tid == 0) { float t = 0.f;
#pragma unroll
                  for (int w_ = 0; w_ < 8; ++w_) t += mred[w_];
                  *(LAS float*)(F.lds + MQ_OFF) = (127.0f / QC_M) * __builtin_amdgcn_rsqf(t / (65536.0f * (float)(nu > 0 ? nu : 1)) + 1e-30f); }
              __syncthreads(); }
            { PHASE_BEGIN(); bf16* Zp = (bf16*)(F.ws + WS_Z); pg8::Gemm g{(const bf16*)(F.ws + WS_AB), (const bf16*)(F.ws + WS_WSWA + (size_t)l * D * 2048), M, D, 1024}; pg8::StaticOrder S; S.init(M, D, F.G, (int)blockIdx.x);
              pg8::EpiGateB8 E{F.ws + WS_GT + (size_t)1024 * 131072, F.b_gates + (size_t)(l * 2 + 1) * D, F.ws + WS_TMP, F.ws + WS_MERGED, 1.0f / (W8_SCALE * AB8_SCALE), *(const LAS float*)(F.lds + MQ_OFF) * 0.35355339f};
              pg8::gemm_phase<pg8::EpiGateB8, pg8::StaticOrder, false, true, true, GEMM_BAL>(F.lds, g, S, E, F.tid); }
        }
        SEAM(p + 4);
        if (IN(p + 5)) for (int rep = 0; rep < REP_P4; ++rep) {
            PHASE_BEGIN(); pg8::Gemm g{(const bf16*)(F.ws + WS_MERGED), (const bf16*)(F.ws + WS_WOUT + (size_t)l * D * D), M, D, D / 2};
            pg8::EpiRes E{(bf16*)(F.ws + (rep ? WS_TMP : WS_XB)), (float*)(F.ws + (rep ? WS_TMP + 192 * MiB : WS_SSQP)), F.ws + (rep ? WS_TMP + 128 * MiB : WS_X8), (const float*)(F.ws + WS_SX) + (size_t)((l + 1) & 1) * M, (const LAS float*)(F.lds + RS3_OFF), -1, 1.0f / (*(const LAS float*)(F.lds + MQ_OFF) * ((const float*)(F.ws + WS_SX))[2 * M + DEPTH + l])};
            { pg8::StaticOrder S0; S0.init(M, D, F.G, (int)blockIdx.x); pg8::Unit u0; if (S0.next(0, u0)) E.pm0 = u0.pm; }
#if defined(PROBE_P4_HOT)
            if (rep) { pg8::HotOrder S; S.init(M, D, F.G, (int)blockIdx.x); pg8::gemm_phase<pg8::EpiRes, pg8::HotOrder, false, true, false, GEMM_BAL, true>(F.lds, g, S, E, F.tid); } else
#endif
            { pg8::StaticOrder S; S.init(M, D, F.G, (int)blockIdx.x); pg8::gemm_phase<pg8::EpiRes, pg8::StaticOrder, false, true, false, GEMM_BAL, true>(F.lds, g, S, E, F.tid); }
        }
        SEAM(p + 5);

    }
    if (IN(N_PHASES - 1)) { PHASE_BEGIN(); final_norm(F); }
#undef IN
#undef SEAM
}

extern "C" void kernel_launch(void* const* d_in, const int* in_sizes, int n_in, void* d_out, int out_size, void* d_ws, size_t ws_size, hipStream_t stream) {
    static int grid = 0;
    if (grid == 0) {
        if (n_in != 12 || in_sizes[0] != M * D || out_size != M * D || ws_size < WS_END) { fprintf(stderr, "kernel_launch: unexpected shapes (n_in %d, in0 %d, out %d, ws %zu < %zu); nothing launched\n", n_in, n_in > 0 ? in_sizes[0] : -1, out_size, ws_size, (size_t)WS_END); grid = -1; return; }
        int dev = 0, cus = 0, per_cu = 0;
        if (hipGetDevice(&dev) != hipSuccess || hipDeviceGetAttribute(&cus, hipDeviceAttributeMultiprocessorCount, dev) != hipSuccess) { grid = -1; return; }
        if (hipFuncSetAttribute((const void*)hybrid_fwd, hipFuncAttributeMaxDynamicSharedMemorySize, LDS_BYTES) != hipSuccess) { fprintf(stderr, "kernel_launch: hipFuncSetAttribute failed\n"); grid = -1; return; }
        if (hipOccupancyMaxActiveBlocksPerMultiprocessor(&per_cu, (const void*)hybrid_fwd, NWAVES * 64, LDS_BYTES) != hipSuccess || per_cu < 1) { fprintf(stderr, "kernel_launch: occupancy query reports %d blocks per CU\n", per_cu); }
        (void)hipGetLastError();
        grid = cus;
    }
    if (grid < 0) return;
    if (hipMemsetAsync((char*)d_ws + WS_CTL, 0, CTL_ZERO_BYTES, stream) != hipSuccess) return;
    Args a{};
    for (int i = 0; i < 12; ++i) a.in[i] = (const float*)d_in[i];
    a.out = (float*)d_out; a.ws = (unsigned char*)d_ws;
#if MK_PER_PHASE
    for (int ph = 0; ph < N_PHASES; ++ph) { a.ph_lo = ph; a.ph_hi = ph + 1; hipLaunchKernelGGL(hybrid_fwd, dim3(grid), dim3(NWAVES * 64), LDS_BYTES, stream, a); }
#else
    a.ph_lo = 0; a.ph_hi = N_PHASES; hipLaunchKernelGGL(hybrid_fwd, dim3(grid), dim3(NWAVES * 64), LDS_BYTES, stream, a);
#endif
    const hipError_t le = hipPeekAtLastError();
    if (le != hipSuccess) fprintf(stderr, "kernel_launch: launch failed: %s\n", hipGetErrorName(le));
}
```

```cpp
#include <hip/hip_runtime.h>
#include <cstdio>
#include <cstdint>
namespace pg8 {
#define PG8_LAS __attribute__((address_space(3)))
typedef unsigned short bf16_t;
typedef short bf16x8 __attribute__((ext_vector_type(8)));
typedef float f32x4 __attribute__((ext_vector_type(4)));
typedef unsigned u32x4 __attribute__((ext_vector_type(4)));
typedef int i32x4 __attribute__((ext_vector_type(4)));
typedef int i32x8 __attribute__((ext_vector_type(8)));
constexpr int BM = 256, BK = 64, HALF = 128, HTB = HALF * BK * 2  , STAGE_BYTES = 8 * HTB, NXCD = 8, WGM = 8;

__host__ __device__ __forceinline__ int lds_byte(int r, int c) { const int st = (r >> 4) * 2 + (c >> 5), rr = r & 15, cc = c & 31, ob = rr * 64 + cc * 2; return st * 1024 + (ob ^ (((ob >> 9) & 1) << 5)); }
__host__ __device__ __forceinline__ void stage_rc(int b, int& R, int& C) { const int st = b / 1024, sb = b % 1024, swz = sb ^ (((sb >> 9) & 1) << 5); R = (st >> 1) * 16 + swz / 64; C = (st & 1) * 32 + (swz % 64) / 2; }
__host__ __device__ __forceinline__ int perm32(int rho) { const int n = rho >> 4, i = rho & 15; return 8 * (i >> 2) + 4 * n + (i & 3); }

struct Unit { int pm, pn; };
struct Gemm { const bf16_t* A; const bf16_t* Bt; int M, N, K; };

struct StaticOrder {
    int nM, nN, nwg, G, c;
    __host__ __device__ void init(int M, int N, int G_, int c_) { nM = M / BM; nN = N / BM; nwg = nM * nN; G = G_; c = c_; }
    __host__ __device__ bool next(int i, Unit& u) const {
        const long L = (long)i * G + c; if (L >= nwg) return false;
        int wgid = (int)L; { const int q = nwg / NXCD, r = nwg % NXCD, xcd = wgid % NXCD, off = wgid / NXCD; wgid = (xcd < r ? xcd * (q + 1) : r * (q + 1) + (xcd - r) * q) + off; }
        const int nig = WGM * nN, gid = wgid / nig, fm = gid * WGM, gsz = (nM - fm) < WGM ? (nM - fm) : WGM;
        u.pm = fm + ((wgid % nig) % gsz); u.pn = (wgid % nig) / gsz; return true;
    }
    __device__ __forceinline__ void a_ready(const Unit&) const {}
    __device__ __forceinline__ void done(const Unit&) const {}
};
typedef unsigned u32x2 __attribute__((ext_vector_type(2)));
typedef float f32x2c __attribute__((ext_vector_type(2))); typedef __bf16 bf16x2c __attribute__((ext_vector_type(2)));
__device__ __forceinline__ unsigned cvt_pk_bf16(float lo, float hi) { const f32x2c v = {lo, hi}; return __builtin_bit_cast(unsigned, __builtin_convertvector(v, bf16x2c)); }
typedef float f32x2 __attribute__((ext_vector_type(2)));
struct RevOrder : StaticOrder { __host__ __device__ bool next(int i, Unit& u) const { const bool r = StaticOrder::next(i, u); u.pn = nN - 1 - u.pn; return r; } };
struct HotOrder : StaticOrder { __host__ __device__ bool next(int i, Unit& u) const { const bool r = StaticOrder::next(i, u); u.pm = c & 7; u.pn = 0; return r; } };
constexpr int LDZ = 19456;
__device__ __forceinline__ float bf_lo(unsigned w) { return __uint_as_float(w << 16); }
__device__ __forceinline__ float bf_hi(unsigned w) { return __uint_as_float(w & 0xffff0000u); }
__device__ __forceinline__ float sigmoidf_(float x) { return __builtin_amdgcn_rcpf(1.0f + __expf(-x)); }
__host__ __device__ __forceinline__ int kperm8(int k) { return (k & ~63) | ((k & 0x18) << 1) | ((k >> 2) & 8) | (k & 7); }
__device__ __forceinline__ unsigned q8x4(float a, float b, float c, float d, float q) {
    const float MG = 12582912.0f, LO = MG - 127.0f, HI = MG + 127.0f;
    const unsigned i0 = __float_as_uint(__builtin_amdgcn_fmed3f(__builtin_fmaf(a, q, MG), LO, HI)), i1 = __float_as_uint(__builtin_amdgcn_fmed3f(__builtin_fmaf(b, q, MG), LO, HI));
    const unsigned i2 = __float_as_uint(__builtin_amdgcn_fmed3f(__builtin_fmaf(c, q, MG), LO, HI)), i3 = __float_as_uint(__builtin_amdgcn_fmed3f(__builtin_fmaf(d, q, MG), LO, HI));
    return __builtin_amdgcn_perm(i1, i0, 0x0c0c0400u) | __builtin_amdgcn_perm(i3, i2, 0x04000c0cu);
}
__device__ __forceinline__ float shx(float v, int lane, int mask) { return __int_as_float(__builtin_amdgcn_ds_bpermute((lane ^ mask) << 2, __float_as_int(v))); }
__device__ __forceinline__ float row_ssq(const float* P, int row) {
    const f32x4* p = (const f32x4*)(P + (size_t)row * 64); float s = 0.f;
#pragma unroll
    for (int j = 0; j < 16; ++j) { const f32x4 v = p[j]; s += (v[0] + v[1]) + (v[2] + v[3]); }
    return s;
}
__device__ __forceinline__ float row_rstd(const float* P, int row) { return __builtin_amdgcn_rsqf(row_ssq(P, row) * (1.0f / 4096.0f) + 1e-6f); }
__device__ __forceinline__ float row_rstd_slow(const float* P, int row) {
    const f32x4* p = (const f32x4*)(P + (size_t)row * 64); float s = 0.f;
#pragma unroll 1
    for (int j = 0; j < 16; ++j) { const f32x4 v = p[j]; s += (v[0] + v[1]) + (v[2] + v[3]); }
    return __builtin_amdgcn_rsqf(s * (1.0f / 4096.0f) + 1e-6f);
}
struct EpiZ {
    static constexpr bool PERM = true, AFTER_DRAIN = false, IDEMP = true;
    bf16_t* Z; const float* P; int pm0; const PG8_LAS float* rsl; float mul;
    __device__ __forceinline__ void operator()(const f32x4 (&acc)[2][2][4][2], const Unit& u, int wr, int wc, int fr_in, int fq_in) const {
        int fr = fr_in, fq = fq_in; asm volatile("" : "+v"(fr), "+v"(fq));
        const int row0 = u.pm * BM + wr * 64 + fr, col0 = u.pn * BM + wc * 64 + 8 * fq;
#pragma unroll
        for (int ai = 0; ai < 2; ++ai)
#pragma unroll
            for (int m = 0; m < 4; ++m) { const int row = row0 + ai * HALF + m * 16; const float r = ((u.pm == pm0) ? rsl[ai * HALF + wr * 64 + m * 16 + fr] : row_rstd_slow(P, row)) * mul;
                bf16_t* rowp = Z + (size_t)row * LDZ + col0;
#pragma unroll
                for (int bj = 0; bj < 2; ++bj) { const f32x4 v0 = acc[ai][bj][m][0] * r, v1 = acc[ai][bj][m][1] * r;
                    u32x4 w; w.x = cvt_pk_bf16(v0[0], v0[1]); w.y = cvt_pk_bf16(v0[2], v0[3]); w.z = cvt_pk_bf16(v1[0], v1[1]); w.w = cvt_pk_bf16(v1[2], v1[3]);
                    *(u32x4*)(rowp + bj * 32) = w; } }
    }
};
struct EpiZ8 {
    static constexpr bool PERM = true, AFTER_DRAIN = false, IDEMP = true;
    bf16_t* Z; const float* P; const float* SX; float iwq; int pm0; const PG8_LAS float* rsl; unsigned char* GT; int gpn0;
    __device__ __forceinline__ void operator()(const f32x4 (&acc)[2][2][4][2], const Unit& u, int wr, int wc, int fr_in, int fq_in) const {
        int fr = fr_in, fq = fq_in; asm volatile("" : "+v"(fr), "+v"(fq));
        const int row0 = u.pm * BM + wr * 64 + fr, col0 = u.pn * BM + wc * 64 + 8 * fq;
#pragma unroll
        for (int ai = 0; ai < 2; ++ai)
#pragma unroll
            for (int m = 0; m < 4; ++m) { const int row = row0 + ai * HALF + m * 16; const float r = (u.pm == pm0) ? rsl[ai * HALF + wr * 64 + m * 16 + fr] : row_rstd_slow(P, row) * iwq * __builtin_amdgcn_rcpf(SX[row]);
                const bool gate = u.pn >= gpn0; const int gi = u.pn - gpn0;
                unsigned char* dst = gate ? GT + (((size_t)((gi >> 4) * 1024 + u.pm * 16 + (gi & 15)) * 8 + (wr * 4 + wc)) * 16 + (ai * 4 + m) * 2) * 1024 + (fr + 16 * fq) * 16 : (unsigned char*)(Z + (size_t)row * LDZ + col0);
                const int bstep = gate ? 1024 : 64;
#pragma unroll
                for (int bj = 0; bj < 2; ++bj) { const i32x4 i0 = __builtin_bit_cast(i32x4, acc[ai][bj][m][0]), i1 = __builtin_bit_cast(i32x4, acc[ai][bj][m][1]);
                    const f32x4 v0 = (f32x4){(float)i0[0], (float)i0[1], (float)i0[2], (float)i0[3]} * r, v1 = (f32x4){(float)i1[0], (float)i1[1], (float)i1[2], (float)i1[3]} * r;
                    u32x4 w; w.x = cvt_pk_bf16(v0[0], v0[1]); w.y = cvt_pk_bf16(v0[2], v0[3]); w.z = cvt_pk_bf16(v1[0], v1[1]); w.w = cvt_pk_bf16(v1[2], v1[3]);
                    *(u32x4*)(dst + bj * bstep) = w; } }
    }
};
#define PG8_SIG8(s0, s1, g, b0, b1) do { s0[0] = sigmoidf_(bf_lo(g.x) + b0[0]); s0[1] = sigmoidf_(bf_hi(g.x) + b0[1]); s0[2] = sigmoidf_(bf_lo(g.y) + b0[2]); s0[3] = sigmoidf_(bf_hi(g.y) + b0[3]); \
    s1[0] = sigmoidf_(bf_lo(g.z) + b1[0]); s1[1] = sigmoidf_(bf_hi(g.z) + b1[1]); s1[2] = sigmoidf_(bf_lo(g.w) + b1[2]); s1[3] = sigmoidf_(bf_hi(g.w) + b1[3]); } while (0)
struct EpiGateA {
    static constexpr bool PERM = true, AFTER_DRAIN = false, IDEMP = true;
    const unsigned char* G; const float* bias; unsigned char* T; PG8_LAS float* SS;
    __device__ __forceinline__ void operator()(const f32x4 (&acc)[2][2][4][2], const Unit& u, int wr, int wc, int fr_in, int fq_in) const {
        int fr = fr_in, fq = fq_in; asm volatile("" : "+v"(fr), "+v"(fq));
        const int row0 = u.pm * BM + wr * 64 + fr, col0 = u.pn * BM + wc * 64 + 8 * fq;
        f32x4 bv[2][2]; u32x4 gl[8][2], w[8][2]; float ss = 0.f;
        const size_t tofs = ((size_t)(u.pm * 16 + u.pn) * 8 + (wr * 4 + wc)) * 16384 + (fr + 16 * fq) * 16;
#pragma unroll
        for (int g = 0; g < 8; ++g) { const unsigned char* gp = G + tofs + g * 2048; gl[g][0] = *(const u32x4*)gp; gl[g][1] = *(const u32x4*)(gp + 1024); }
#pragma unroll
        for (int bj = 0; bj < 2; ++bj)
#pragma unroll
            for (int n = 0; n < 2; ++n) bv[bj][n] = *(const f32x4*)(bias + col0 + bj * 32 + 4 * n);
#pragma unroll
        for (int g = 0; g < 8; ++g) { const int ai = g >> 2, m = g & 3;
#pragma unroll
            for (int bj = 0; bj < 2; ++bj) { const u32x4 gg = gl[g][bj]; f32x4 s0, s1; PG8_SIG8(s0, s1, gg, bv[bj][0], bv[bj][1]); const f32x4 v0 = s0 * acc[ai][bj][m][0], v1 = s1 * acc[ai][bj][m][1];
                ss += ((v0[0] * v0[0] + v0[1] * v0[1]) + (v0[2] * v0[2] + v0[3] * v0[3])) + ((v1[0] * v1[0] + v1[1] * v1[1]) + (v1[2] * v1[2] + v1[3] * v1[3]));
                w[g][bj].x = cvt_pk_bf16(v0[0], v0[1]); w[g][bj].y = cvt_pk_bf16(v0[2], v0[3]); w[g][bj].z = cvt_pk_bf16(v1[0], v1[1]); w[g][bj].w = cvt_pk_bf16(v1[2], v1[3]); }
            asm volatile("" : "+v"(w[g][0]), "+v"(w[g][1])); }
        asm volatile("" ::: "memory");
#pragma unroll
        for (int g = 0; g < 8; ++g) { unsigned char* tp = T + tofs + g * 2048; *(u32x4*)tp = w[g][0]; *(u32x4*)(tp + 1024) = w[g][1]; }
        { const int ln = fr + 16 * fq;
#pragma unroll
          for (int o = 1; o < 64; o <<= 1) ss += shx(ss, ln, o);
          if (ln == 0) { PG8_LAS float* sp = SS + wr * 4 + wc; *sp = *sp + ss; } }
    }
};
struct EpiGateB {
    static constexpr bool PERM = true, AFTER_DRAIN = false, IDEMP = true;
    const bf16_t* G; const float* bias; const bf16_t* T; bf16_t* O; float mul;
    __device__ __forceinline__ void operator()(const f32x4 (&acc)[2][2][4][2], const Unit& u, int wr, int wc, int fr_in, int fq_in) const {
        int fr = fr_in, fq = fq_in; asm volatile("" : "+v"(fr), "+v"(fq));
        const int row0 = u.pm * BM + wr * 64 + fr, col0 = u.pn * BM + wc * 64 + 8 * fq;
        f32x4 bv[2][2]; u32x4 w[8][2];
#pragma unroll
        for (int bj = 0; bj < 2; ++bj)
#pragma unroll
            for (int n = 0; n < 2; ++n) bv[bj][n] = *(const f32x4*)(bias + col0 + bj * 32 + 4 * n);
#pragma unroll
        for (int ai = 0; ai < 2; ++ai) { u32x4 gl[4][2], tl[4][2];
#pragma unroll
            for (int m = 0; m < 4; ++m) { const int r = row0 + ai * HALF + m * 16; const bf16_t* gp = G + (size_t)r * LDZ + col0; const bf16_t* tp = T + (size_t)r * 4096 + col0;
                gl[m][0] = *(const u32x4*)gp; gl[m][1] = *(const u32x4*)(gp + 32); tl[m][0] = *(const u32x4*)tp; tl[m][1] = *(const u32x4*)(tp + 32); }
#pragma unroll
            for (int m = 0; m < 4; ++m) { const int g = ai * 4 + m;
#pragma unroll
                for (int bj = 0; bj < 2; ++bj) { const u32x4 gg = gl[m][bj], tt = tl[m][bj]; f32x4 s0, s1; PG8_SIG8(s0, s1, gg, bv[bj][0], bv[bj][1]);
                    f32x4 v0 = s0 * (acc[ai][bj][m][0] * mul), v1 = s1 * (acc[ai][bj][m][1] * mul);
                    v0[0] += bf_lo(tt.x); v0[1] += bf_hi(tt.x); v0[2] += bf_lo(tt.y); v0[3] += bf_hi(tt.y); v1[0] += bf_lo(tt.z); v1[1] += bf_hi(tt.z); v1[2] += bf_lo(tt.w); v1[3] += bf_hi(tt.w);
                    w[g][bj].x = cvt_pk_bf16(v0[0], v0[1]); w[g][bj].y = cvt_pk_bf16(v0[2], v0[3]); w[g][bj].z = cvt_pk_bf16(v1[0], v1[1]); w[g][bj].w = cvt_pk_bf16(v1[2], v1[3]); }
                asm volatile("" : "+v"(w[g][0]), "+v"(w[g][1])); } }
        asm volatile("" ::: "memory");
#pragma unroll
        for (int g = 0; g < 8; ++g) { bf16_t* op = O + (size_t)(row0 + (g >> 2) * HALF + (g & 3) * 16) * 4096 + col0; *(u32x4*)op = w[g][0]; *(u32x4*)(op + 32) = w[g][1]; }
    }
};
struct EpiGateB8 {
    static constexpr bool PERM = true, AFTER_DRAIN = false, IDEMP = true;
    const unsigned char* G; const float* bias; const unsigned char* T; unsigned char* O; float mul, qm;
    __device__ __forceinline__ void operator()(const f32x4 (&acc)[2][2][4][2], const Unit& u, int wr, int wc, int fr_in, int fq_in) const {
        int fr = fr_in, fq = fq_in; asm volatile("" : "+v"(fr), "+v"(fq));
        const int row0 = u.pm * BM + wr * 64 + fr, col0 = u.pn * BM + wc * 64 + 8 * fq;
        f32x4 bv[2][2]; u32x2 w[8][2];
#pragma unroll
        for (int bj = 0; bj < 2; ++bj)
#pragma unroll
            for (int n = 0; n < 2; ++n) bv[bj][n] = *(const f32x4*)(bias + col0 + bj * 32 + 4 * n);
#pragma unroll
        for (int ai = 0; ai < 2; ++ai) { u32x4 gl[4][2], tl[4][2];
#pragma unroll
            for (int m = 0; m < 4; ++m) { const size_t o_ = ((size_t)(u.pm * 16 + u.pn) * 8 + (wr * 4 + wc)) * 16384 + (fr + 16 * fq) * 16 + (ai * 4 + m) * 2048; const unsigned char* gp = G + o_; const unsigned char* tp = T + o_;
                gl[m][0] = *(const u32x4*)gp; gl[m][1] = *(const u32x4*)(gp + 1024); tl[m][0] = *(const u32x4*)tp; tl[m][1] = *(const u32x4*)(tp + 1024); }
#pragma unroll
            for (int m = 0; m < 4; ++m) { const int g = ai * 4 + m;
#pragma unroll
                for (int bj = 0; bj < 2; ++bj) { const u32x4 gg = gl[m][bj], tt = tl[m][bj]; f32x4 s0, s1; PG8_SIG8(s0, s1, gg, bv[bj][0], bv[bj][1]);
                    f32x4 v0 = s0 * (acc[ai][bj][m][0] * mul), v1 = s1 * (acc[ai][bj][m][1] * mul);
                    v0[0] += bf_lo(tt.x); v0[1] += bf_hi(tt.x); v0[2] += bf_lo(tt.y); v0[3] += bf_hi(tt.y); v1[0] += bf_lo(tt.z); v1[1] += bf_hi(tt.z); v1[2] += bf_lo(tt.w); v1[3] += bf_hi(tt.w);
                    { f32x4 p0 = (f32x4){v0[0] + v0[1], v0[0] - v0[1], v0[2] + v0[3], v0[2] - v0[3]}, p1 = (f32x4){v1[0] + v1[1], v1[0] - v1[1], v1[2] + v1[3], v1[2] - v1[3]};
                      f32x4 r0 = (f32x4){p0[0] + p0[2], p0[1] + p0[3], p0[0] - p0[2], p0[1] - p0[3]}, r1 = (f32x4){p1[0] + p1[2], p1[1] + p1[3], p1[0] - p1[2], p1[1] - p1[3]};
                      v0 = r0 + r1; v1 = r0 - r1; }
                    w[g][bj].x = q8x4(v0[0], v0[1], v0[2], v0[3], qm); w[g][bj].y = q8x4(v1[0], v1[1], v1[2], v1[3], qm); }
                asm volatile("" : "+v"(w[g][0]), "+v"(w[g][1])); } }
        asm volatile("" ::: "memory");
#pragma unroll
        for (int g = 0; g < 8; ++g) { unsigned char* op = O + (size_t)(row0 + (g >> 2) * HALF + (g & 3) * 16) * 4096 + u.pn * BM + wc * 64 + 16 * fq; *(u32x4*)op = (u32x4){w[g][0].x, w[g][0].y, w[g][1].x, w[g][1].y}; }
    }
};
struct EpiRes {
    static constexpr bool PERM = true, AFTER_DRAIN = false, IDEMP = false;
    bf16_t* XB; float* P; unsigned char* X8; const float* SXN; const PG8_LAS float* rq; int pm0; float dsc;
    __device__ __forceinline__ void operator()(const f32x4 (&acc)[2][2][4][2], const Unit& u, int wr, int wc, int fr_in, int fq_in) const {
        int fr = fr_in, fq = fq_in; asm volatile("" : "+v"(fr), "+v"(fq));
        const int row0 = u.pm * BM + wr * 64 + fr, col0 = u.pn * BM + wc * 64 + 8 * fq;
        u32x4 xl[8][2], w[8][2]; u32x2 w8[8][2]; float ssv[8];
#pragma unroll
        for (int g = 0; g < 8; ++g) { const bf16_t* xp = XB + (size_t)(row0 + (g >> 2) * HALF + (g & 3) * 16) * 4096 + col0; xl[g][0] = *(const u32x4*)xp; xl[g][1] = *(const u32x4*)(xp + 32); }
#pragma unroll
        for (int g = 0; g < 8; ++g) { const int ai = g >> 2, m = g & 3; float ss = 0.f; const float qg = (u.pm == pm0) ? rq[ai * HALF + wr * 64 + m * 16 + fr] : SXN[row0 + ai * HALF + m * 16];
#pragma unroll
            for (int bj = 0; bj < 2; ++bj) { const u32x4 xx = xl[g][bj]; const i32x4 ia = __builtin_bit_cast(i32x4, acc[ai][bj][m][0]), ib = __builtin_bit_cast(i32x4, acc[ai][bj][m][1]);
                const f32x4 a = (f32x4){(float)ia[0], (float)ia[1], (float)ia[2], (float)ia[3]} * dsc, b = (f32x4){(float)ib[0], (float)ib[1], (float)ib[2], (float)ib[3]} * dsc;
                u32x4 o; o.x = cvt_pk_bf16(bf_lo(xx.x) + a[0], bf_hi(xx.x) + a[1]); o.y = cvt_pk_bf16(bf_lo(xx.y) + a[2], bf_hi(xx.y) + a[3]); o.z = cvt_pk_bf16(bf_lo(xx.z) + b[0], bf_hi(xx.z) + b[1]); o.w = cvt_pk_bf16(bf_lo(xx.w) + b[2], bf_hi(xx.w) + b[3]);
                w[g][bj] = o;
                const float r0 = bf_lo(o.x), r1 = bf_hi(o.x), r2 = bf_lo(o.y), r3 = bf_hi(o.y), r4 = bf_lo(o.z), r5 = bf_hi(o.z), r6 = bf_lo(o.w), r7 = bf_hi(o.w);
                w8[g][bj].x = q8x4(r0, r1, r2, r3, qg); w8[g][bj].y = q8x4(r4, r5, r6, r7, qg);
                ss += ((r0 * r0 + r1 * r1) + (r2 * r2 + r3 * r3)) + ((r4 * r4 + r5 * r5) + (r6 * r6 + r7 * r7)); }
            ss += shx(ss, fr + 16 * fq, 16); ss += shx(ss, fr + 16 * fq, 32); ssv[g] = ss;
            asm volatile("" : "+v"(w[g][0]), "+v"(w[g][1]), "+v"(ssv[g]), "+v"(w8[g][0]), "+v"(w8[g][1])); }
        asm volatile("" ::: "memory");
#pragma unroll
        for (int g = 0; g < 8; ++g) { const int row = row0 + (g >> 2) * HALF + (g & 3) * 16; bf16_t* xp = XB + (size_t)row * 4096 + col0; *(u32x4*)xp = w[g][0]; *(u32x4*)(xp + 32) = w[g][1];
            unsigned char* x8 = X8 + (size_t)row * 4096 + u.pn * BM + wc * 64 + 16 * fq; *(u32x4*)x8 = (u32x4){w8[g][0].x, w8[g][0].y, w8[g][1].x, w8[g][1].y};
            if (fq == 0) P[(size_t)row * 64 + u.pn * 4 + wc] = ssv[g]; }
    }
};

__device__ __forceinline__ f32x4 zero4() { f32x4 z; asm volatile("v_mov_b32 %0, 0\n\tv_mov_b32 %1, 0\n\tv_mov_b32 %2, 0\n\tv_mov_b32 %3, 0" : "=v"(z[0]), "=v"(z[1]), "=v"(z[2]), "=v"(z[3])); return z; }
template <class Epi, class Sched, bool ALIGN_EPI = false, bool SP2 = false, bool F8 = false, bool BAL = false, bool I8 = false>
__device__ __forceinline__ void gemm_phase(PG8_LAS unsigned char* lds, const Gemm g, const Sched& S, const Epi& E, const int tid_in) {
    const int tid = tid_in, wid = __builtin_amdgcn_readfirstlane(tid >> 6), lane = tid & 63, wr = wid >> 2, wc = wid & 3, fr = lane & 15, fq = lane >> 4;
    const int K = g.K, nt = K / BK;
    unsigned voffA[2], voffB[2];
#pragma unroll
    for (int i = 0; i < 2; ++i) { int R, C; stage_rc(tid * 16 + i * 8192, R, C); const int Rb = (R >> 5) * 64 + (Epi::PERM ? perm32(R & 31) : (R & 31));
        voffA[i] = (unsigned)(R * K + C) * 2u; voffB[i] = (unsigned)(Rb * K + C) * 2u; }
    const unsigned kstep = (unsigned)(BK * 2);
    const unsigned hstep = (unsigned)HALF * (unsigned)K * 2u;
    const unsigned hstepB = 32u * (unsigned)K * 2u;
    const unsigned tstep = 2u * hstep;
    const unsigned ldsw = (unsigned)wid * 1024u;
    const int aoff = lds_byte(wr * 64 + fr, fq * 8), boff = lds_byte(wc * 32 + fr, fq * 8);
#define PG8_SA(b, h) (((b) * 2 + (h)) * HTB)
#define PG8_SB(b, h) ((4 + (b) * 2 + (h)) * HTB)
#define PG8_STAGE(bufoff, rs, gbase, voff) do { _Pragma("unroll") for (int _i = 0; _i < 2; ++_i) \
        __builtin_amdgcn_raw_ptr_buffer_load_lds(rs, (PG8_LAS void*)(lds + (bufoff) + ldsw + _i * 8192), 16, (int)(voff)[_i], (int)(gbase), 0, 0); } while (0)
#define PG8_STAGE_A(bufoff, gbase, voff) PG8_STAGE(bufoff, rsA, gbase, voff)
#define PG8_STAGE_B(bufoff, gbase, voff) PG8_STAGE(bufoff, rsB, gbase, voff)
#define PG8_LDA(dst, b, h) do { _Pragma("unroll") for (int m = 0; m < 4; ++m) _Pragma("unroll") for (int k = 0; k < 2; ++k) dst[m][k] = *(const PG8_LAS bf16x8*)(lds + PG8_SA(b, h) + aoff + m * 2048 + k * 1024); } while (0)
#define PG8_LDB(dst, b, h) do { _Pragma("unroll") for (int n = 0; n < 2; ++n) _Pragma("unroll") for (int k = 0; k < 2; ++k) dst[n][k] = *(const PG8_LAS bf16x8*)(lds + PG8_SB(b, h) + boff + n * 2048 + k * 1024); } while (0)
#define PG8_MMA(ai, bj, At, Bt) do { __builtin_amdgcn_s_setprio(1); if constexpr (I8) { \
          \
        _Pragma("unroll") for (int m = 0; m < 4; ++m) _Pragma("unroll") for (int n = 0; n < 2; ++n) _Pragma("unroll") for (int k = 0; k < 2; ++k) { \
            const i32x4 b_ = __builtin_bit_cast(i32x4, Bt[n][k]), a_ = __builtin_bit_cast(i32x4, At[m][k]); \
            asm volatile("v_mfma_i32_16x16x64_i8 %0, %1, %2, %0" : "+v"(acc[ai][bj][m][n]) : "v"(b_), "v"(a_)); } } else if constexpr (!F8) { _Pragma("unroll") for (int m = 0; m < 4; ++m) _Pragma("unroll") for (int n = 0; n < 2; ++n) _Pragma("unroll") for (int k = 0; k < 2; ++k) \
        acc[ai][bj][m][n] = __builtin_amdgcn_mfma_f32_16x16x32_bf16(Bt[n][k], At[m][k], acc[ai][bj][m][n], 0, 0, 0); } else { \
          \
          \
        _Pragma("unroll") for (int m = 0; m < 4; ++m) _Pragma("unroll") for (int n = 0; n < 2; ++n) { \
            const i32x4 b0_ = __builtin_bit_cast(i32x4, Bt[n][0]), b1_ = __builtin_bit_cast(i32x4, Bt[n][1]), a0_ = __builtin_bit_cast(i32x4, At[m][0]), a1_ = __builtin_bit_cast(i32x4, At[m][1]); \
            const i32x8 bb_ = __builtin_shufflevector(b0_, b1_, 0, 1, 2, 3, 4, 5, 6, 7), aa_ = __builtin_shufflevector(a0_, a1_, 0, 1, 2, 3, 4, 5, 6, 7); \
            asm volatile("v_mfma_f32_16x16x128_f8f6f4 %0, %1, %2, %0" : "+v"(acc[ai][bj][m][n]) : "v"(bb_), "v"(aa_)); } } \
        __builtin_amdgcn_s_setprio(0); } while (0)
#define PG8_WAIT_V(n) asm volatile("s_waitcnt vmcnt(" #n ")" ::: "memory")
#define PG8_WAIT_L(n) asm volatile("s_waitcnt lgkmcnt(" #n ")" ::: "memory")
#define PG8_BAR __builtin_amdgcn_s_barrier()
#define PG8_SCHED __builtin_amdgcn_sched_barrier(0)
    Unit cur, nxt; int ui = 0;
    if (!S.next(0, cur)) return;
    f32x4 acc[2][2][4][2];
#pragma unroll
    for (int a = 0; a < 2; ++a)
#pragma unroll
        for (int b = 0; b < 2; ++b)
#pragma unroll
            for (int m = 0; m < 4; ++m)
#pragma unroll
                for (int n = 0; n < 2; ++n) acc[a][b][m][n] = zero4();
    bf16x8 At[4][2], B0[2][2], B1[2][2];
    unsigned cA = (unsigned)cur.pm * tstep, cB = (unsigned)cur.pn * tstep;
    const __amdgpu_buffer_rsrc_t rsA = __builtin_amdgcn_make_buffer_rsrc((void*)g.A, 0, (int)((unsigned)g.M * (unsigned)K * 2u), 0x00020000), rsB = __builtin_amdgcn_make_buffer_rsrc((void*)g.Bt, 0, (int)((unsigned)g.N * (unsigned)K * 2u), 0x00020000);
    S.a_ready(cur);
    if constexpr (SP2) {
        PG8_STAGE_B(PG8_SB(0, 0), cB, voffB); PG8_STAGE_B(PG8_SB(0, 1), cB + hstepB, voffB); PG8_STAGE_A(PG8_SA(0, 0), cA, voffA); PG8_STAGE_A(PG8_SA(0, 1), cA + hstep, voffA);
        if (wr == 1) PG8_BAR;
        PG8_WAIT_V(2); PG8_BAR;
        if constexpr (BAL) { PG8_STAGE_B(PG8_SB(1, 0), cB + kstep, voffB); PG8_STAGE_B(PG8_SB(1, 1), cB + hstepB + kstep, voffB); PG8_WAIT_V(4); PG8_BAR; }
        else {
        PG8_STAGE_B(PG8_SB(1, 0), cB + kstep, voffB); PG8_STAGE_A(PG8_SA(1, 0), cA + kstep, voffA); PG8_STAGE_B(PG8_SB(1, 1), cB + hstepB + kstep, voffB);
        PG8_WAIT_V(6); PG8_BAR;
        }
    } else {
        PG8_STAGE_B(PG8_SB(0, 0), cB, voffB); PG8_STAGE_A(PG8_SA(0, 0), cA, voffA); PG8_STAGE_B(PG8_SB(0, 1), cB + hstepB, voffB); PG8_STAGE_A(PG8_SA(0, 1), cA + hstep, voffA);
        if (wr == 1) PG8_BAR;
        PG8_WAIT_V(4); PG8_BAR;
        PG8_STAGE_B(PG8_SB(1, 0), cB + kstep, voffB); PG8_STAGE_A(PG8_SA(1, 0), cA + kstep, voffA); PG8_STAGE_B(PG8_SB(1, 1), cB + hstepB + kstep, voffB);
        PG8_WAIT_V(6); PG8_BAR;
    }
    for (;;) {
        const bool has_next = S.next(ui + 1, nxt);
        const unsigned nA = has_next ? (unsigned)nxt.pm * tstep : cA, nB = has_next ? (unsigned)nxt.pn * tstep : cB;
        for (int t = 0; t < nt; t += 2) {
            const bool last = (t == nt - 2);
            const unsigned a1 = cA + (unsigned)(t + 1) * kstep;
            const unsigned a2 = last ? nA : cA + (unsigned)(t + 2) * kstep, b2 = last ? nB : cB + (unsigned)(t + 2) * kstep;
            const unsigned a3 = a2 + kstep, b3 = b2 + kstep;
            if (last && has_next) S.a_ready(nxt);
            if constexpr (SP2 && BAL) {
            PG8_LDB(B0, 0, 0); PG8_LDB(B1, 0, 1); PG8_SCHED; PG8_LDA(At, 0, 0); PG8_STAGE_A(PG8_SA(1, 0), a1, voffA); PG8_STAGE_A(PG8_SA(1, 1), a1 + hstep, voffA);
            PG8_WAIT_V(8); PG8_WAIT_L(0); PG8_BAR; PG8_MMA(0, 0, At, B0); PG8_MMA(0, 1, At, B1); PG8_BAR; PG8_SCHED;
            PG8_LDA(At, 0, 1); PG8_STAGE_B(PG8_SB(0, 0), b2, voffB); PG8_STAGE_B(PG8_SB(0, 1), b2 + hstepB, voffB);
            PG8_WAIT_V(6); PG8_WAIT_L(0); PG8_BAR; PG8_MMA(1, 0, At, B0); PG8_MMA(1, 1, At, B1); PG8_BAR; PG8_SCHED;
            PG8_LDB(B0, 1, 0); PG8_LDB(B1, 1, 1); PG8_SCHED; PG8_LDA(At, 1, 0); PG8_STAGE_A(PG8_SA(0, 0), a2, voffA); PG8_STAGE_A(PG8_SA(0, 1), a2 + hstep, voffA);
            PG8_WAIT_V(8); PG8_WAIT_L(0); PG8_BAR; PG8_MMA(0, 0, At, B0); PG8_MMA(0, 1, At, B1); PG8_BAR; PG8_SCHED;
            PG8_LDA(At, 1, 1); PG8_STAGE_B(PG8_SB(1, 0), b3, voffB); PG8_STAGE_B(PG8_SB(1, 1), b3 + hstepB, voffB);
            PG8_WAIT_V(6); PG8_WAIT_L(0); PG8_BAR; PG8_MMA(1, 0, At, B0); PG8_MMA(1, 1, At, B1); PG8_BAR; PG8_SCHED;
            } else if constexpr (SP2) {
            PG8_LDB(B0, 0, 0); PG8_LDB(B1, 0, 1); PG8_SCHED; PG8_LDA(At, 0, 0); PG8_STAGE_A(PG8_SA(1, 1), a1 + hstep, voffA);
            PG8_WAIT_V(8); PG8_WAIT_L(0); PG8_BAR; PG8_MMA(0, 0, At, B0); PG8_MMA(0, 1, At, B1); PG8_BAR; PG8_SCHED;
            PG8_LDA(At, 0, 1); PG8_STAGE_B(PG8_SB(0, 0), b2, voffB); PG8_STAGE_B(PG8_SB(0, 1), b2 + hstepB, voffB); PG8_STAGE_A(PG8_SA(0, 0), a2, voffA);
            PG8_WAIT_V(8); PG8_WAIT_L(0); PG8_BAR; PG8_MMA(1, 0, At, B0); PG8_MMA(1, 1, At, B1); PG8_BAR; PG8_SCHED;
            PG8_LDB(B0, 1, 0); PG8_LDB(B1, 1, 1); PG8_SCHED; PG8_LDA(At, 1, 0); PG8_STAGE_A(PG8_SA(0, 1), a2 + hstep, voffA);
            PG8_WAIT_V(8); PG8_WAIT_L(0); PG8_BAR; PG8_MMA(0, 0, At, B0); PG8_MMA(0, 1, At, B1); PG8_BAR; PG8_SCHED;
            PG8_LDA(At, 1, 1); PG8_STAGE_B(PG8_SB(1, 0), b3, voffB); PG8_STAGE_B(PG8_SB(1, 1), b3 + hstepB, voffB); PG8_STAGE_A(PG8_SA(1, 0), a3, voffA);
            PG8_WAIT_V(8); PG8_WAIT_L(0); PG8_BAR; PG8_MMA(1, 0, At, B0); PG8_MMA(1, 1, At, B1); PG8_BAR; PG8_SCHED;
            } else {
            PG8_LDB(B0, 0, 0); PG8_SCHED; PG8_LDA(At, 0, 0); PG8_STAGE_A(PG8_SA(1, 1), a1 + hstep, voffA);
            PG8_WAIT_L(8); PG8_BAR; PG8_WAIT_L(0); PG8_MMA(0, 0, At, B0); PG8_BAR; PG8_SCHED;
            PG8_LDB(B1, 0, 1); PG8_STAGE_B(PG8_SB(0, 0), b2, voffB);
            PG8_BAR; PG8_WAIT_L(0); PG8_MMA(0, 1, At, B1); PG8_BAR;
            PG8_LDA(At, 0, 1); PG8_STAGE_A(PG8_SA(0, 0), a2, voffA);
            PG8_BAR; PG8_WAIT_L(0); PG8_MMA(1, 0, At, B0); PG8_BAR; PG8_SCHED;
            PG8_STAGE_B(PG8_SB(0, 1), b2 + hstepB, voffB);
            PG8_WAIT_V(6); PG8_BAR; PG8_MMA(1, 1, At, B1); PG8_BAR;
            PG8_LDB(B0, 1, 0); PG8_SCHED; PG8_LDA(At, 1, 0); PG8_STAGE_A(PG8_SA(0, 1), a2 + hstep, voffA);
            PG8_WAIT_L(8); PG8_BAR; PG8_WAIT_L(0); PG8_MMA(0, 0, At, B0); PG8_BAR; PG8_SCHED;
            PG8_LDB(B1, 1, 1); PG8_STAGE_B(PG8_SB(1, 0), b3, voffB);
            PG8_BAR; PG8_WAIT_L(0); PG8_MMA(0, 1, At, B1); PG8_BAR;
            PG8_LDA(At, 1, 1); PG8_STAGE_A(PG8_SA(1, 0), a3, voffA);
            PG8_BAR; PG8_WAIT_L(0); PG8_MMA(1, 0, At, B0); PG8_BAR; PG8_SCHED;
            PG8_STAGE_B(PG8_SB(1, 1), b3 + hstepB, voffB);
            PG8_WAIT_V(6); PG8_BAR; PG8_MMA(1, 1, At, B1); PG8_BAR;
            }
        }
        if constexpr (F8 || I8) asm volatile("s_nop 15\n\ts_nop 15" ::: "memory");
        if constexpr (ALIGN_EPI) { if (wr == 0) PG8_BAR; }
        if constexpr (!Epi::AFTER_DRAIN) { int tl_ = tid; asm volatile("" : "+v"(tl_)); E(acc, cur, wr, wc, tl_ & 15, (tl_ >> 4) & 3); S.done(cur); }
        if (!has_next) break;
#pragma unroll
        for (int a = 0; a < 2; ++a)
#pragma unroll
            for (int b = 0; b < 2; ++b)
#pragma unroll
                for (int m = 0; m < 4; ++m)
#pragma unroll
                    for (int n = 0; n < 2; ++n) acc[a][b][m][n] = zero4();
        cur = nxt; cA = nA; cB = nB; ++ui;
        if constexpr (ALIGN_EPI) { if (wr == 1) PG8_BAR; }
    }
    PG8_WAIT_V(0);
    if constexpr (!ALIGN_EPI) { if (wr == 0) PG8_BAR; }
    PG8_BAR;
    if constexpr (Epi::AFTER_DRAIN) { E.fused(acc, cur, wr, wc, fr, fq, lds, wid, lane); S.done(cur); }
#undef PG8_SA
#undef PG8_SB
#undef PG8_STAGE
#undef PG8_STAGE_A
#undef PG8_STAGE_B
#undef PG8_LDA
#undef PG8_LDB
#undef PG8_MMA
#undef PG8_WAIT_V
#undef PG8_WAIT_L
#undef PG8_BAR
#undef PG8_SCHED
}
}
constexpr int NWAVES = 8;
#ifndef MK_PER_PHASE
#define MK_PER_PHASE 0
#endif
constexpr int D = 4096, BATCH = 4, SEQ = 4096, M = BATCH * SEQ, DEPTH = 4, IN_W = 19472, NZ = 19456;
constexpr int OFF_GQ = 0, OFF_GK = 1024, OFF_GV = 2048, OFF_GG = 4096, OFF_SQ = 6144, OFF_SK = 8192, OFF_SV = 8704, OFF_SG = 9216, OFF_GA = 11264, OFF_GB = 15360;
constexpr int LDZ = NZ;
#ifndef NZ_BF_COLS
#define NZ_BF_COLS 3072
#endif
constexpr int NZ_BF = NZ_BF_COLS, NZ_F8 = NZ - NZ_BF;
constexpr float QC_W = 4.0f, QC_X0 = 4.25f, QC_XP = 4.5f, QC_M = 4.3f;
constexpr float W8_SCALE = 64.0f, AB8_SCALE = 8.0f;
constexpr float RMS_EPS = 1e-6f;
constexpr int N_PHASES = 2 + 6 * DEPTH;
constexpr size_t MiB = 1u << 20;
constexpr size_t WS_CTL = 0, CTL_ZERO_BYTES = 1 * MiB;
constexpr size_t WS_WIN = 1 * MiB, WS_WDEC = 609 * MiB, WS_WGLA = 610 * MiB, WS_WSWA = 674 * MiB, WS_WOUT = 738 * MiB;
constexpr size_t WS_XRES = 866 * MiB, WS_XB = 1122 * MiB, WS_Z = 1250 * MiB, WS_GDEC = 1858 * MiB;
constexpr size_t WS_QT = 1859 * MiB, WS_KT = 1891 * MiB, WS_QI = 1923 * MiB, WS_U = 1955 * MiB, WS_SP = 2083 * MiB, WS_DECAY = 2211 * MiB;
constexpr size_t WS_AA = 2212 * MiB, WS_AB = 2276 * MiB, WS_TMP = 2340 * MiB, WS_MERGED = 2596 * MiB, WS_SSQP = 2724 * MiB, WS_X8 = 2936 * MiB, WS_SX = 3000 * MiB, WS_WIN8 = 3001 * MiB, WS_GT = 3321 * MiB, WS_END = 3577 * MiB;
static_assert(WS_WIN8 + (size_t)DEPTH * NZ_F8 * D <= WS_GT && WS_SSQP + 4 * MiB <= WS_X8, "int8 weight copies");
static_assert(WS_WIN + (size_t)DEPTH * NZ * D * 2 <= WS_WDEC && WS_Z + (size_t)M * NZ * 2 <= WS_GDEC && WS_XRES + (size_t)M * D * 4 <= WS_XB, "ws map");
constexpr int CW_TMO = 0, CW_BAR = 4096, CW_TS = 8192;
static_assert(CW_BAR + 3456 <= CW_TS && (size_t)(CW_TS + DEPTH * 256 * 8) * 4 <= CTL_ZERO_BYTES, "CTL map");
constexpr int RING_BYTES = 131072, LDSCTL_OFF = RING_BYTES, MISC_OFF = LDSCTL_OFF + 320, RS_OFF = LDSCTL_OFF + 1024, RS2_OFF = LDSCTL_OFF + 2048, WQ_OFF = LDSCTL_OFF + 3072, RS3_OFF = LDSCTL_OFF + 4096, MQ_OFF = LDSCTL_OFF + 3072 + 512, LDS_BYTES = 147456;

#define GAS __attribute__((address_space(1)))
#define LAS __attribute__((address_space(3)))
typedef unsigned short bf16;
typedef unsigned v4u __attribute__((ext_vector_type(4)));
typedef unsigned v2u __attribute__((ext_vector_type(2)));
typedef float f32x4 __attribute__((ext_vector_type(4)));
typedef short bf16x8 __attribute__((ext_vector_type(8)));
typedef short s16x4 __attribute__((ext_vector_type(4)));
typedef GAS unsigned gu32;
#define RLX_AGENT __ATOMIC_RELAXED, __HIP_MEMORY_SCOPE_AGENT
#define LDS_WAIT() asm volatile("s_waitcnt lgkmcnt(0)" ::: "memory")
__device__ __forceinline__ unsigned f2bf(float f) { unsigned u = __builtin_bit_cast(unsigned, f); return (u + 0x7fffu + ((u >> 16) & 1u)) >> 16; }
__device__ __forceinline__ unsigned pk2(float lo, float hi) { return pg8::cvt_pk_bf16(lo, hi); }
__device__ __forceinline__ float bf2f(unsigned short b) { return __uint_as_float(((unsigned)b) << 16); }
__device__ __forceinline__ float bflo(unsigned w) { return __uint_as_float(w << 16); }
__device__ __forceinline__ float bfhi(unsigned w) { return __uint_as_float(w & 0xffff0000u); }
#define MFMA16(a, b, c) __builtin_amdgcn_mfma_f32_16x16x32_bf16((a), (b), (c), 0, 0, 0)
__device__ __forceinline__ bf16x8 tr_frag(LAS unsigned char* base, int rs, int k0, int n0, int lane) {
    const int g = lane >> 4, q = (lane & 15) >> 2, p = lane & 3;
    LAS unsigned char* a = base + (k0 + 8 * g + q) * rs + (n0 + 4 * p) * 2;
    const s16x4 lo = __builtin_amdgcn_ds_read_tr16_b64_v4i16((LAS s16x4*)a);
    const s16x4 hi = __builtin_amdgcn_ds_read_tr16_b64_v4i16((LAS s16x4*)(a + 4 * rs));
    return (bf16x8){lo[0], lo[1], lo[2], lo[3], hi[0], hi[1], hi[2], hi[3]};
}
#define XB_TMO      128
#define XB_XCNT(j)  (256  + 64 * (j))
#define XB_XSUB(j)  (1280 + 64 * (j))
#define XB_XGEN(j)  (2304 + 64 * (j))
#define XB_TOP      3328
#define XB_TOPGEN   3392
#define XCD_BAR_WORDS 3456
#define XB_SPIN_CAP (1u << 18)

__device__ __forceinline__ unsigned xb_ld(unsigned* p)              { return __hip_atomic_load(p, __ATOMIC_RELAXED, __HIP_MEMORY_SCOPE_AGENT); }
__device__ __forceinline__ unsigned xb_add(unsigned* p, unsigned v) { return __hip_atomic_fetch_add(p, v, __ATOMIC_RELAXED, __HIP_MEMORY_SCOPE_AGENT); }
__device__ __forceinline__ unsigned xb_xcc_id() { return (unsigned)__builtin_amdgcn_s_getreg((3 << 11) | 20) & 0xFu; }
#define XB_SPIN(cond, bar) do { unsigned _sp = 0; while (cond) { __builtin_amdgcn_s_sleep(1); \
    if ((++_sp & 255u) == 0u) { if (xb_ld(&(bar)[XB_TMO])) break; if (_sp > XB_SPIN_CAP) { atomicAdd(&(bar)[XB_TMO], 1u); break; } } } } while (0)

struct XcdBarrier {
    unsigned* bar; unsigned x;
    volatile LAS unsigned* st;
};

__device__ __forceinline__ XcdBarrier xcd_barrier_post(unsigned* bar, volatile LAS unsigned* st) {
    XcdBarrier b; b.bar = bar; b.x = xb_xcc_id(); b.st = st;
    if (threadIdx.x == 0) (void)xb_add(&bar[XB_XCNT(b.x)], 1u);
    return b;
}
__device__ __forceinline__ void xcd_barrier_complete(unsigned* bar, unsigned x, unsigned& nloc, unsigned& nx) {
    const unsigned G = gridDim.x * gridDim.y * gridDim.z;
    unsigned sum, cnt, mine, sp = 0u;
    for (;;) {
        sum = 0u; cnt = 0u; mine = 0u;
#pragma unroll
        for (unsigned j = 0; j < 16; ++j) { const unsigned c = xb_ld(&bar[XB_XCNT(j)]); sum += c; cnt += (c > 0u) ? 1u : 0u; mine = (j == x) ? c : mine; }
        if (sum == G) break;
        __builtin_amdgcn_s_sleep(1);
        if ((++sp & 255u) == 0u) { if (xb_ld(&bar[XB_TMO])) break; if (sp > XB_SPIN_CAP) { atomicAdd(&bar[XB_TMO], 1u); break; } }
    }
    nloc = mine > 0u ? mine : 1u; nx = cnt > 0u ? cnt : 1u;
}

__device__ __forceinline__ void xcd_barrier(const XcdBarrier& b) {
    asm volatile("s_waitcnt vmcnt(0)" ::: "memory");
    __syncthreads();
    if (threadIdx.x == 0) {
        unsigned* bar = b.bar;
        __builtin_amdgcn_s_waitcnt(0);
        unsigned nloc = b.st[0], nx = b.st[1];
        if (nloc == 0u) { xcd_barrier_complete(bar, b.x, nloc, nx); b.st[0] = nloc; b.st[1] = nx; }
        const unsigned old = xb_add(&bar[XB_XSUB(b.x)], 1u);
        const unsigned gen = old / nloc;
        if (old + 1u == (gen + 1u) * nloc) {
            __builtin_amdgcn_fence(__ATOMIC_RELEASE, "agent");
            asm volatile("s_waitcnt vmcnt(0)" ::: "memory");
            const unsigned og = xb_add(&bar[XB_TOP], 1u);
            const unsigned tg = og / nx;
            if (og + 1u == (tg + 1u) * nx) xb_add(&bar[XB_TOPGEN], 1u);
            else XB_SPIN(xb_ld(&bar[XB_TOPGEN]) == tg, bar);
            __builtin_amdgcn_fence(__ATOMIC_ACQUIRE, "agent");
            xb_add(&bar[XB_XGEN(b.x)], 1u);
            asm volatile("s_waitcnt vmcnt(0)" ::: "memory");
        } else {
            XB_SPIN(xb_ld(&bar[XB_XGEN(b.x)]) == gen, bar);
            __builtin_amdgcn_fence(__ATOMIC_ACQUIRE, "agent");
            asm volatile("s_waitcnt vmcnt(0)" ::: "memory");
        }
    }
    __syncthreads();
}
struct Frame {
    LAS unsigned char* lds; volatile LAS unsigned* MISC; gu32* ctl; unsigned char* ws;
    int tid, lane, wave, G;
    const float *x, *norm_g, *w_in, *b_gates, *w_up, *b_dec, *gla_g, *sinks, *w_gla, *w_swa, *w_out, *fin_g; float* out;
};
__device__ __forceinline__ float wave_sum(float v, int lane_) {
#pragma unroll
    for (int o = 1; o < 64; o <<= 1) v += pg8::shx(v, lane_, o);
    return v;
}

__device__ __forceinline__ void p0_transpose_item(const float* W, size_t ldw, int scol, int K, bf16* WT, int drow, const float* gain, float scale, int mode  , LAS unsigned char* scr, int kb, int lane) {
    const bool f8 = mode != 0, had = mode == 3; if (mode == 3) mode = 2;
    const int k0 = 64 * kb, lr = lane >> 4, lc = lane & 15;
    f32x4 v[16];
#pragma unroll
    for (int i = 0; i < 16; ++i) v[i] = *(const GAS f32x4*)(W + (size_t)(k0 + 4 * i + lr) * ldw + scol + 4 * lc);
    if (had) {
#pragma unroll
        for (int i = 0; i < 16; ++i) {
#pragma unroll
            for (int e = 0; e < 4; ++e) { const float o = pg8::shx(v[i][e], lane, 16); v[i][e] = (lane & 16) ? o - v[i][e] : v[i][e] + o; }
#pragma unroll
            for (int e = 0; e < 4; ++e) { const float o = pg8::shx(v[i][e], lane, 32); v[i][e] = (lane & 32) ? o - v[i][e] : v[i][e] + o; } }
#pragma unroll
        for (int i = 0; i < 16; i += 2) { const f32x4 a = v[i] + v[i + 1], b = v[i] - v[i + 1]; v[i] = a; v[i + 1] = b; }
    }
#pragma unroll
    for (int i = 0; i < 16; ++i) { const float gk = gain ? gain[k0 + 4 * i + lr] * scale : scale; f32x4 a = v[i] * gk;
        v2u o;
        if (mode == 2) { unsigned u[4];
            _Pragma("unroll") for (int e = 0; e < 4; ++e) u[e] = __float_as_uint(__builtin_amdgcn_fmed3f(__builtin_fmaf(v[i][e], gk, 12582912.0f), 12582912.0f - 127.0f, 12582912.0f + 127.0f));
            o.x = __builtin_amdgcn_perm(u[1], u[0], 0x05040100u); o.y = __builtin_amdgcn_perm(u[3], u[2], 0x05040100u); }
        else { o.x = pk2(a[0], a[1]); o.y = pk2(a[2], a[3]); }
        *(LAS v2u*)(scr + (4 * i + lr) * 144 + 8 * lc) = o; }
    LDS_WAIT(); asm volatile("" ::: "memory");
#pragma unroll
    for (int kh = 0; kh < 2; ++kh)
#pragma unroll
        for (int nq = 0; nq < 4; ++nq) { const bf16x8 t = tr_frag(scr, 144, 32 * kh, 16 * nq, lane);
            if (!f8) *(GAS bf16x8*)(WT + (size_t)(drow + 16 * nq + lc) * K + k0 + 32 * kh + 8 * lr) = t;
            else if (mode == 2) { const v4u tt = __builtin_bit_cast(v4u, t); v2u o; o.x = __builtin_amdgcn_perm(tt.y, tt.x, 0x06040200u); o.y = __builtin_amdgcn_perm(tt.w, tt.z, 0x06040200u);
                   *(GAS v2u*)((unsigned char*)WT + (size_t)(drow + 16 * nq + lc) * K + pg8::kperm8(k0 + 32 * kh + 8 * lr)) = o; }
            else { int q0 = __builtin_amdgcn_cvt_pk_fp8_f32(bf2f((unsigned short)t[0]), bf2f((unsigned short)t[1]), 0, false); q0 = __builtin_amdgcn_cvt_pk_fp8_f32(bf2f((unsigned short)t[2]), bf2f((unsigned short)t[3]), q0, true);
                   int q1 = __builtin_amdgcn_cvt_pk_fp8_f32(bf2f((unsigned short)t[4]), bf2f((unsigned short)t[5]), 0, false); q1 = __builtin_amdgcn_cvt_pk_fp8_f32(bf2f((unsigned short)t[6]), bf2f((unsigned short)t[7]), q1, true);
                   v2u o; o.x = (unsigned)q0; o.y = (unsigned)q1; *(GAS v2u*)((unsigned char*)WT + (size_t)(drow + 16 * nq + lc) * K + k0 + 32 * kh + 8 * lr) = o; } }
    LDS_WAIT(); asm volatile("" ::: "memory");
}
__device__ __forceinline__ void p0_prologue(Frame& F) {
    LAS unsigned char* scr = F.lds + F.wave * 16384;
    const int gw = blockIdx.x * NWAVES + F.wave, NGW = F.G * NWAVES;
    LAS float* wq = (LAS float*)(F.lds + WQ_OFF); LAS float* wred = (LAS float*)(F.lds + WQ_OFF + 64);
    for (int l = 0; l < DEPTH; ++l) { float s = 0.f;
#pragma unroll 4
        for (int j = 0; j < 16; ++j) { const int k = 256 * j; const float gk = F.norm_g[l * D + k]; const float a = F.w_in[((size_t)l * D + k) * IN_W + 8192 + 2 * F.tid] * gk, b = F.w_in[((size_t)l * D + k) * IN_W + 8192 + 2 * F.tid + 1] * gk; s += a * a + b * b; }
        s = wave_sum(s, F.lane); if (F.lane == 0) wred[l * 8 + F.wave] = s;
        float s2 = 0.f;
#pragma unroll 4
        for (int j = 0; j < 16; ++j) { const float a = F.w_out[((size_t)l * D + 256 * j) * D + 2 * F.tid], b = F.w_out[((size_t)l * D + 256 * j) * D + 2 * F.tid + 1]; s2 += a * a + b * b; }
        s2 = wave_sum(s2, F.lane); if (F.lane == 0) wred[(DEPTH + l) * 8 + F.wave] = s2; }
    __syncthreads();
    if (F.tid < 2 * DEPTH) { float s = 0.f;
#pragma unroll
        for (int w_ = 0; w_ < 8; ++w_) s += wred[F.tid * 8 + w_];
        const float q = 127.0f / QC_W * __builtin_amdgcn_rsqf(s * (1.0f / 16384.0f) + 1e-30f); wq[F.tid] = q; ((float*)(F.ws + WS_SX))[2 * M + F.tid] = q; }
    __syncthreads();
    constexpr int I_IN = 64 * 304, I_GLA = 32 * 64, I_OUT = 64 * 64, I_L = I_IN + 2 * I_GLA + I_OUT;
    for (int it = gw; it < DEPTH * I_L; it += NGW) {
        const int l = it / I_L; int r = it - l * I_L;
        if (r < I_IN) { const int kb = r / 304, nb = r - kb * 304; const int scol = nb < 96 ? nb * 64 : nb * 64 + 16;
            if (nb < NZ_BF / 64) p0_transpose_item(F.w_in + (size_t)l * D * IN_W, IN_W, scol, D, (bf16*)(F.ws + WS_WIN) + (size_t)l * NZ * D, nb * 64, F.norm_g + l * D, 1.0f, 0, scr, kb, F.lane);
            else p0_transpose_item(F.w_in + (size_t)l * D * IN_W, IN_W, scol, D, (bf16*)(F.ws + WS_WIN8 + (size_t)l * NZ_F8 * D), nb * 64 - NZ_BF, F.norm_g + l * D, wq[l], 2, scr, kb, F.lane);
            continue; }
        r -= I_IN;
        if (r < I_GLA) { const int kb = r >> 6, nb = r & 63; p0_transpose_item(F.w_gla + (size_t)l * 2048 * D, D, nb * 64, 2048, (bf16*)(F.ws + WS_WGLA) + (size_t)l * D * 2048, nb * 64, nullptr, 1.0f, 0, scr, kb, F.lane); continue; }
        r -= I_GLA;
        if (r < I_GLA) { const int kb = r >> 6, nb = r & 63; p0_transpose_item(F.w_swa + (size_t)l * 2048 * D, D, nb * 64, 2048, (bf16*)(F.ws + WS_WSWA + (size_t)l * D * 2048), nb * 64, nullptr, W8_SCALE, 1, scr, kb, F.lane); continue; }
        r -= I_GLA;
        { const int kb = r >> 6, nb = r & 63; p0_transpose_item(F.w_out + (size_t)l * D * D, D, nb * 64, D, (bf16*)(F.ws + WS_WOUT + (size_t)l * D * D), nb * 64, nullptr, wq[DEPTH + l] * 0.35355339f, 3, scr, kb, F.lane); }
    }
    for (int idx = blockIdx.x * (NWAVES * 64) + F.tid; idx < DEPTH * 16 * D; idx += F.G * NWAVES * 64) {
        const int l = idx >> 16, j = (idx >> 12) & 15, k = idx & 4095;
        ((bf16*)(F.ws + WS_WDEC))[idx] = (bf16)f2bf(F.norm_g[l * D + k] * F.w_in[((size_t)l * D + k) * IN_W + 6144 + j]);
    }
    float* ssqp = (float*)(F.ws + WS_SSQP); float* sx0 = (float*)(F.ws + WS_SX);
    for (int m = gw; m < M; m += NGW) {
        const GAS f32x4* xr = (const GAS f32x4*)(F.x + (size_t)m * D) + F.lane; GAS v2u* o8 = (GAS v2u*)((bf16*)(F.ws + WS_XB) + (size_t)m * D) + F.lane; GAS unsigned* q8 = (GAS unsigned*)(F.ws + WS_X8 + (size_t)m * D) + F.lane; float s = 0.f;
        v2u w[16];
#pragma unroll
        for (int j = 0; j < 16; ++j) { const f32x4 v = xr[64 * j]; w[j].x = pk2(v.x, v.y); w[j].y = pk2(v.z, v.w); o8[64 * j] = w[j];
            const float r0 = bflo(w[j].x), r1 = bfhi(w[j].x), r2 = bflo(w[j].y), r3 = bfhi(w[j].y); s += (r0 * r0 + r1 * r1) + (r2 * r2 + r3 * r3); }
        s = wave_sum(s, F.lane); ssqp[(size_t)m * 64 + F.lane] = (F.lane == 0) ? s : 0.f;
        const float q = 127.0f / QC_X0 * __builtin_amdgcn_rsqf(s * (1.0f / D) + RMS_EPS);
        if (F.lane == 0) sx0[m] = q;
#pragma unroll
        for (int j = 0; j < 16; ++j) { const int c = 4 * F.lane + 256 * j; *(GAS unsigned*)(F.ws + WS_X8 + (size_t)m * D + pg8::kperm8(c & ~7) + (c & 7)) = pg8::q8x4(bflo(w[j].x), bfhi(w[j].x), bflo(w[j].y), bfhi(w[j].y), q); }
    }
}
__device__ __forceinline__ void final_norm(Frame& F) {
    const int gw = blockIdx.x * NWAVES + F.wave, NGW = F.G * NWAVES;
    const bf16* X = (const bf16*)(F.ws + WS_XB);
    for (int m = gw; m < M; m += NGW) {
        const GAS v4u* xr = (const GAS v4u*)(X + (size_t)m * D) + F.lane; const GAS f32x4* gr = (const GAS f32x4*)F.fin_g + 2 * F.lane; GAS f32x4* orow = (GAS f32x4*)(F.out + (size_t)m * D) + 2 * F.lane;
        v4u v[8]; float s = 0.f;
#pragma unroll
        for (int j = 0; j < 8; ++j) { v[j] = xr[64 * j]; const float r0 = bflo(v[j].x), r1 = bfhi(v[j].x), r2 = bflo(v[j].y), r3 = bfhi(v[j].y), r4 = bflo(v[j].z), r5 = bfhi(v[j].z), r6 = bflo(v[j].w), r7 = bfhi(v[j].w);
            s += ((r0 * r0 + r1 * r1) + (r2 * r2 + r3 * r3)) + ((r4 * r4 + r5 * r5) + (r6 * r6 + r7 * r7)); }
        const float rs = __builtin_amdgcn_rsqf(wave_sum(s, F.lane) * (1.0f / D) + RMS_EPS);
#pragma unroll
        for (int j = 0; j < 8; ++j) { const f32x4 g0 = gr[128 * j], g1 = gr[128 * j + 1];
            orow[128 * j] = (f32x4){bflo(v[j].x) * rs * g0[0], bfhi(v[j].x) * rs * g0[1], bflo(v[j].y) * rs * g0[2], bfhi(v[j].y) * rs * g0[3]};
            orow[128 * j + 1] = (f32x4){bflo(v[j].z) * rs * g1[0], bfhi(v[j].z) * rs * g1[1], bflo(v[j].w) * rs * g1[2], bfhi(v[j].w) * rs * g1[3]}; }
    }
}
__device__ __forceinline__ void gdec_phase(Frame& F, int l) {
    LAS float* red = (LAS float*)F.lds;
    const bf16* Wd = (const bf16*)(F.ws + WS_WDEC) + (size_t)l * 16 * D; const bf16* XBp = (const bf16*)(F.ws + WS_XB); const float* ssqp = (const float*)(F.ws + WS_SSQP); float* GD = (float*)(F.ws + WS_GDEC);
    const int lane = F.lane, fr = lane & 15, fq = lane >> 4;
    for (int rb = blockIdx.x; rb < M / 64; rb += F.G) {
        const int r0 = (F.G == 256) ? ((8 * (rb & 7) + ((rb >> 3) & 7)) * 256 + (rb >> 6) * 64) : rb * 64, k0 = F.wave * 512;
        f32x4 acc[4];
#pragma unroll
        for (int rt = 0; rt < 4; ++rt) acc[rt] = (f32x4){0.f, 0.f, 0.f, 0.f};
#pragma unroll 4
        for (int ks = 0; ks < 16; ++ks) { const int k = k0 + ks * 32 + 8 * fq;
            const bf16x8 X = *(const GAS bf16x8*)(Wd + (size_t)fr * D + k);
#pragma unroll
            for (int rt = 0; rt < 4; ++rt) { const bf16x8 Y = *(const GAS bf16x8*)(XBp + (size_t)(r0 + rt * 16 + fr) * D + k); acc[rt] = MFMA16(X, Y, acc[rt]); } }
#pragma unroll
        for (int rt = 0; rt < 4; ++rt) *(LAS f32x4*)(red + ((F.wave * 4 + rt) * 64 + lane) * 4) = acc[rt];
        __syncthreads();
        if (F.tid < 256) { const int rt = F.tid >> 6, ln = F.tid & 63; f32x4 s = (f32x4){0.f, 0.f, 0.f, 0.f};
#pragma unroll
            for (int w = 0; w < 8; ++w) s += *(LAS f32x4*)(red + ((w * 4 + rt) * 64 + ln) * 4);
            const int row = r0 + rt * 16 + (ln & 15); const float rs = pg8::row_rstd(ssqp, row);
            *(GAS f32x4*)(GD + (size_t)row * 16 + 4 * (ln >> 4)) = s * rs; }
        __syncthreads();
    }
}
constexpr int NGROUP = BATCH * 8 * 8;
constexpr int GA_GD = 0, GA_BL = 4096, GA_KS = GA_BL + 64 * 528, GA_V = GA_KS + 64 * 272, GA_SEG = GA_V + 64 * 528, GA_BRL = GA_SEG + 2048, GA_EB = GA_BRL + 1024, GA_EL = GA_EB + 512, GA_END = GA_EL + 512;
static_assert(GA_END <= RING_BYTES, "GLA-a LDS map");
__device__ __forceinline__ void gla_a_phase(Frame& F, int l) {
    LAS unsigned char* lds = F.lds;
    LAS float* gd = (LAS float*)(lds + GA_GD); LAS float* bL = (LAS float*)(lds + GA_BL); LAS unsigned char* ksL = lds + GA_KS; LAS unsigned char* Vl = lds + GA_V; LAS float* seg = (LAS float*)(lds + GA_SEG); LAS float* brl = (LAS float*)(lds + GA_BRL); LAS float* ebL = (LAS float*)(lds + GA_EB); LAS float* elL = (LAS float*)(lds + GA_EL);
    const int tid = F.tid, lane = F.lane, w = F.wave, d = tid & 127, tq = tid >> 7, fr = lane & 15, fq = lane >> 4;
    const bf16* Z = (const bf16*)(F.ws + WS_Z); const float* GD = (const float*)(F.ws + WS_GDEC);
    bf16* QT = (bf16*)(F.ws + WS_QT); bf16* KT = (bf16*)(F.ws + WS_KT); bf16* SLOC = (bf16*)(F.ws + WS_U);
    float* EBREF = (float*)(F.ws + WS_QI); float* ELR = EBREF + (size_t)BATCH * 8 * 64 * 128; float* DG = ELR + (size_t)BATCH * 8 * 64 * 128;
    const float SC = 0.08838834764831845f;
    f32x4 pgd; v4u pv[4], pq[2], pk[2];
#define GA_FETCH(item_) do { const int n_ = (item_) & 63, h_ = ((item_) >> 6) & 7, b_ = (item_) >> 9, t0_ = b_ * SEQ + n_ * 64; \
        pgd = *(const GAS f32x4*)(GD + (size_t)t0_ * 16 + (tid & 255) * 4); \
        _Pragma("unroll") for (int i = 0; i < 4; ++i) { const int c = tid + 512 * i, t = c >> 5, dv0 = (c & 31) * 8; pv[i] = *(const GAS v4u*)(Z + (size_t)(t0_ + t) * LDZ + OFF_GV + h_ * 256 + dv0); } \
        _Pragma("unroll") for (int i = 0; i < 2; ++i) { const int id = tid + 512 * i, t = id >> 4, d0 = (id & 15) * 8; const size_t zr = (size_t)(t0_ + t) * LDZ + h_ * 128 + d0; pq[i] = *(const GAS v4u*)(Z + zr + OFF_GQ); pk[i] = *(const GAS v4u*)(Z + zr + OFF_GK); } } while (0)
    { const int g0_ = (int)blockIdx.x < NGROUP ? (int)blockIdx.x : NGROUP - 1; GA_FETCH((g0_ >> 3) * 64 + (g0_ & 7) * 8); }
    for (int gi = blockIdx.x; gi < NGROUP; gi += F.G) {
        const int bh = gi >> 3, g = gi & 7, h = bh & 7, b = bh >> 3;
        float wu[16];
#pragma unroll
        for (int r = 0; r < 16; ++r) wu[r] = F.w_up[(size_t)(l * 16 + r) * 1024 + h * 128 + d];
        const float bias = F.b_dec[l * 1024 + h * 128 + d];
        f32x4 acc[8][2];
#pragma unroll
        for (int i = 0; i < 8; ++i) { acc[i][0] = (f32x4){0.f, 0.f, 0.f, 0.f}; acc[i][1] = (f32x4){0.f, 0.f, 0.f, 0.f}; }
        float sumbl = 0.f;
#pragma unroll 1
        for (int j = 0; j < 8; ++j) {
            const int n = 8 * g + j, item = bh * 64 + n, t0 = b * SEQ + n * 64;
            if (tid < 256) *(LAS f32x4*)(gd + tid * 4) = pgd;
#pragma unroll
            for (int i = 0; i < 4; ++i) { const int c = tid + 512 * i, t = c >> 5, dv0 = (c & 31) * 8; *(LAS v4u*)(Vl + t * 528 + dv0 * 2) = pv[i]; }
            v4u q8[2], k8[2];
#pragma unroll
            for (int i = 0; i < 2; ++i) { q8[i] = pq[i]; k8[i] = pk[i]; }
            __syncthreads();
            { const int nx = (j < 7) ? item + 1 : ((gi + F.G) >> 3) * 64 + ((gi + F.G) & 7) * 8; if (j < 7 || gi + F.G < NGROUP) GA_FETCH(nx); }
            float c[16]; float run = 0.f;
#pragma unroll
            for (int i = 0; i < 16; ++i) { const int t = 16 * tq + i; float lg = bias; const f32x4 g0 = *(LAS f32x4*)(gd + t * 16), g1 = *(LAS f32x4*)(gd + t * 16 + 4), g2 = *(LAS f32x4*)(gd + t * 16 + 8), g3 = *(LAS f32x4*)(gd + t * 16 + 12);
                lg += g0[0] * wu[0] + g0[1] * wu[1] + g0[2] * wu[2] + g0[3] * wu[3]; lg += g1[0] * wu[4] + g1[1] * wu[5] + g1[2] * wu[6] + g1[3] * wu[7];
                lg += g2[0] * wu[8] + g2[1] * wu[9] + g2[2] * wu[10] + g2[3] * wu[11]; lg += g3[0] * wu[12] + g3[1] * wu[13] + g3[2] * wu[14] + g3[3] * wu[15];
                const float ls = fminf(lg, 0.f) - __logf(1.0f + __expf(-fabsf(lg))); const float la = fmaxf(ls * (1.0f / 16.0f), -1.0f); run += la; c[i] = run; }
            seg[tq * 128 + d] = run;
            __syncthreads();
            float pre = 0.f;
            if (tq > 0) pre += seg[d]; if (tq > 1) pre += seg[128 + d]; if (tq > 2) pre += seg[256 + d];
#pragma unroll
            for (int i = 0; i < 16; ++i) bL[(16 * tq + i) * 132 + d] = c[i] + pre;
            if (tq == 2) brl[d] = c[0] + pre;
            if (tq == 3) brl[128 + d] = c[15] + pre;
            __syncthreads();
            if (tid < 128) { const float bref = brl[tid], blast = brl[128 + tid], eb = __expf(bref), el = __expf(blast - bref); ebL[tid] = eb; elL[tid] = el; sumbl += blast;
                EBREF[(size_t)item * 128 + tid] = eb; ELR[(size_t)item * 128 + tid] = el; }
#pragma unroll
            for (int i = 0; i < 2; ++i) { const int id = tid + 512 * i, t = id >> 4, d0 = (id & 15) * 8;
                const f32x4 b0 = *(LAS f32x4*)(bL + t * 132 + d0), b1 = *(LAS f32x4*)(bL + t * 132 + d0 + 4), r0 = *(LAS f32x4*)(brl + d0), r1 = *(LAS f32x4*)(brl + d0 + 4);
                const float bb[8] = {b0[0], b0[1], b0[2], b0[3], b1[0], b1[1], b1[2], b1[3]}, rr[8] = {r0[0], r0[1], r0[2], r0[3], r1[0], r1[1], r1[2], r1[3]};
                const unsigned qw[4] = {q8[i].x, q8[i].y, q8[i].z, q8[i].w}, kw[4] = {k8[i].x, k8[i].y, k8[i].z, k8[i].w};
                float oq[8], ok[8];
#pragma unroll
                for (int jj = 0; jj < 8; ++jj) { const float q = ((jj & 1) ? bfhi(qw[jj >> 1]) : bflo(qw[jj >> 1])) * SC, k = (jj & 1) ? bfhi(kw[jj >> 1]) : bflo(kw[jj >> 1]);
                    const float e1 = __expf(bb[jj] - rr[jj]), e2 = __builtin_amdgcn_rcpf(e1);
                    oq[jj] = q * e1; ok[jj] = k * e2; }
                const size_t o = (size_t)(t0 + t) * 1024 + h * 128 + d0;
                v4u w4; w4.x = pk2(oq[0], oq[1]); w4.y = pk2(oq[2], oq[3]); w4.z = pk2(oq[4], oq[5]); w4.w = pk2(oq[6], oq[7]); *(GAS v4u*)(QT + o) = w4;
                w4.x = pk2(ok[0], ok[1]); w4.y = pk2(ok[2], ok[3]); w4.z = pk2(ok[4], ok[5]); w4.w = pk2(ok[6], ok[7]); *(GAS v4u*)(KT + o) = w4; *(LAS v4u*)(ksL + t * 272 + d0 * 2) = w4; }
            __syncthreads();
#pragma unroll
            for (int dkt = 0; dkt < 8; ++dkt) { const f32x4 e4 = *(LAS f32x4*)(ebL + dkt * 16 + 4 * fq); acc[dkt][0] *= e4; acc[dkt][1] *= e4; }
#pragma unroll
            for (int ks = 0; ks < 2; ++ks) { bf16x8 Y[2];
#pragma unroll
                for (int jv = 0; jv < 2; ++jv) Y[jv] = tr_frag(Vl, 528, ks * 32, (2 * w + jv) * 16, lane);
#pragma unroll
                for (int dkt = 0; dkt < 8; ++dkt) { const bf16x8 X = tr_frag(ksL, 272, ks * 32, dkt * 16, lane);
                    acc[dkt][0] = MFMA16(X, Y[0], acc[dkt][0]); acc[dkt][1] = MFMA16(X, Y[1], acc[dkt][1]); } }
#pragma unroll
            for (int dkt = 0; dkt < 8; ++dkt) { const f32x4 e4 = *(LAS f32x4*)(elL + dkt * 16 + 4 * fq); acc[dkt][0] *= e4; acc[dkt][1] *= e4; }
            __syncthreads();
        }
#pragma unroll
        for (int dkt = 0; dkt < 8; ++dkt)
#pragma unroll
            for (int jv = 0; jv < 2; ++jv) { const int dv = (2 * w + jv) * 16 + fr, dk = dkt * 16 + 4 * fq; const f32x4 a = acc[dkt][jv];
                v2u o; o.x = pk2(a[0], a[1]); o.y = pk2(a[2], a[3]); *(GAS v2u*)(SLOC + ((size_t)gi * 256 + dv) * 128 + dk) = o; }
        if (tid < 128) DG[(size_t)gi * 128 + tid] = __expf(sumbl);
    }
#undef GA_FETCH
}
__device__ __forceinline__ void gla_scan_phase(Frame& F) {
    const bf16* SLOC = (const bf16*)(F.ws + WS_U); bf16* SST = (bf16*)(F.ws + WS_SP); const float* DG = (const float*)(F.ws + WS_QI) + (size_t)2 * BATCH * 8 * 64 * 128;
    for (int idx = blockIdx.x * (NWAVES * 64) + F.tid; idx < BATCH * 8 * 256 * 16; idx += F.G * NWAVES * 64) {
        const int bh = idx >> 12, dv = (idx >> 4) & 255, dk0 = (idx & 15) * 8;
        float S[8]; float z0_; asm volatile("v_mov_b32 %0, 0" : "=v"(z0_));
#pragma unroll
        for (int j = 0; j < 8; ++j) S[j] = z0_;
#pragma unroll
        for (int g = 0; g < 8; ++g) { const size_t gi = (size_t)bh * 8 + g, off = (gi * 256 + dv) * 128 + dk0;
            const v4u u = *(const GAS v4u*)(SLOC + off); const f32x4 d0 = *(const GAS f32x4*)(DG + gi * 128 + dk0), d1 = *(const GAS f32x4*)(DG + gi * 128 + dk0 + 4);
            v4u o; o.x = pk2(S[0], S[1]); o.y = pk2(S[2], S[3]); o.z = pk2(S[4], S[5]); o.w = pk2(S[6], S[7]); *(GAS v4u*)(SST + off) = o;
            S[0] = d0[0] * S[0] + bflo(u.x); S[1] = d0[1] * S[1] + bfhi(u.x); S[2] = d0[2] * S[2] + bflo(u.y); S[3] = d0[3] * S[3] + bfhi(u.y);
            S[4] = d1[0] * S[4] + bflo(u.z); S[5] = d1[1] * S[5] + bfhi(u.z); S[6] = d1[2] * S[6] + bflo(u.w); S[7] = d1[3] * S[7] + bfhi(u.w); }
    }
}
constexpr int GC_QT = 0, GC_KT = 17408, GC_V = 34816, GC_AL = GC_V + 64 * 528, GC_PART = GC_AL + 64 * 144, GC_EB = GC_PART + 2048, GC_EL = GC_EB + 512, GC_END = GC_EL + 512;
static_assert(GC_END <= RING_BYTES, "GLA-c LDS map");
__device__ __forceinline__ void gla_c_phase(Frame& F, int l) {
    LAS unsigned char* lds = F.lds;
    LAS bf16* qT = (LAS bf16*)(lds + GC_QT); LAS bf16* kT = (LAS bf16*)(lds + GC_KT); LAS unsigned char* Vl = lds + GC_V; LAS bf16* Al = (LAS bf16*)(lds + GC_AL);
    LAS float* part = (LAS float*)(lds + GC_PART); LAS float* ebL = (LAS float*)(lds + GC_EB); LAS float* elL = (LAS float*)(lds + GC_EL);
    const int tid = F.tid, lane = F.lane, w = F.wave, fr = lane & 15, fq = lane >> 4;
    const bf16* Z = (const bf16*)(F.ws + WS_Z); const bf16* QT = (const bf16*)(F.ws + WS_QT); const bf16* KT = (const bf16*)(F.ws + WS_KT); const bf16* SST = (const bf16*)(F.ws + WS_SP);
    const float* EBREF = (const float*)(F.ws + WS_QI); const float* ELR = EBREF + (size_t)BATCH * 8 * 64 * 128;
    bf16* AA = (bf16*)(F.ws + WS_AA);
    v4u rq[2], rk[2], rv[4]; float reb, rel;
#define GC_FETCH(item_) do { const int n_ = (item_) & 63, h_ = ((item_) >> 6) & 7, b_ = (item_) >> 9, t0_ = b_ * SEQ + n_ * 64; \
        _Pragma("unroll") for (int i = 0; i < 2; ++i) { const int c = tid + 512 * i, t = c >> 4, d0 = (c & 15) * 8; const size_t g_ = (size_t)(t0_ + t) * 1024 + h_ * 128 + d0; rq[i] = *(const GAS v4u*)(QT + g_); rk[i] = *(const GAS v4u*)(KT + g_); } \
        _Pragma("unroll") for (int i = 0; i < 4; ++i) { const int c = tid + 512 * i, t = c >> 5, dv0 = (c & 31) * 8; rv[i] = *(const GAS v4u*)(Z + (size_t)(t0_ + t) * LDZ + OFF_GV + h_ * 256 + dv0); } \
        reb = EBREF[(size_t)(item_) * 128 + (tid & 127)]; rel = ELR[(size_t)(item_) * 128 + (tid & 127)]; } while (0)
    { const int g0_ = (int)blockIdx.x < NGROUP ? (int)blockIdx.x : NGROUP - 1; GC_FETCH((g0_ >> 3) * 64 + (g0_ & 7) * 8); }
    for (int gi = blockIdx.x; gi < NGROUP; gi += F.G) {
        const int bh = gi >> 3, g = gi & 7, h = bh & 7, b = bh >> 3;
        f32x4 Sa[8][2];
#pragma unroll
        for (int dkt = 0; dkt < 8; ++dkt)
#pragma unroll
            for (int jv = 0; jv < 2; ++jv) { const v2u s = *(const GAS v2u*)(SST + ((size_t)gi * 256 + (2 * w + jv) * 16 + fr) * 128 + dkt * 16 + 4 * fq); Sa[dkt][jv] = (f32x4){bflo(s.x), bfhi(s.x), bflo(s.y), bfhi(s.y)}; }
#pragma unroll 1
        for (int j = 0; j < 8; ++j) {
            const int n = 8 * g + j, item = bh * 64 + n, t0 = b * SEQ + n * 64;
#pragma unroll
            for (int i = 0; i < 2; ++i) { const int c = tid + 512 * i, t = c >> 4, d0 = (c & 15) * 8; *(LAS v4u*)(qT + t * 136 + d0) = rq[i]; *(LAS v4u*)(kT + t * 136 + d0) = rk[i]; }
#pragma unroll
            for (int i = 0; i < 4; ++i) { const int c = tid + 512 * i, t = c >> 5, dv0 = (c & 31) * 8; *(LAS v4u*)(Vl + t * 528 + dv0 * 2) = rv[i]; }
            if (tid < 128) { ebL[tid] = reb; elL[tid] = rel; }
            __syncthreads();
            { const int nx = (j < 7) ? item + 1 : ((gi + F.G) >> 3) * 64 + ((gi + F.G) & 7) * 8; if (j < 7 || gi + F.G < NGROUP) GC_FETCH(nx); }
            { const int it = w >> 1;
#pragma unroll
              for (int jj = 0; jj < 2; ++jj) { const int jt = 2 * (w & 1) + jj; f32x4 a = (f32x4){0.f, 0.f, 0.f, 0.f};
                  if (jt <= it) {
#pragma unroll
                      for (int ks = 0; ks < 4; ++ks) { const bf16x8 X = *(LAS bf16x8*)(kT + (jt * 16 + fr) * 136 + ks * 32 + 8 * fq); const bf16x8 Y = *(LAS bf16x8*)(qT + (it * 16 + fr) * 136 + ks * 32 + 8 * fq); a = MFMA16(X, Y, a); }
                      const int ii = it * 16 + fr, j0 = jt * 16 + 4 * fq;
#pragma unroll
                      for (int e = 0; e < 4; ++e) if (j0 + e > ii) a[e] = 0.f;
                  }
                  v2u o; o.x = pk2(a[0], a[1]); o.y = pk2(a[2], a[3]); *(LAS v2u*)(Al + (it * 16 + fr) * 72 + jt * 16 + 4 * fq) = o; } }
#pragma unroll
            for (int dkt = 0; dkt < 8; ++dkt) { const f32x4 e4 = *(LAS f32x4*)(ebL + dkt * 16 + 4 * fq); Sa[dkt][0] *= e4; Sa[dkt][1] *= e4; }
            __syncthreads();
            f32x4 acc[2][4];
#pragma unroll
            for (int jv = 0; jv < 2; ++jv)
#pragma unroll
                for (int tt = 0; tt < 4; ++tt) acc[jv][tt] = (f32x4){0.f, 0.f, 0.f, 0.f};
#pragma unroll
            for (int ks = 0; ks < 4; ++ks) { bf16x8 X[2];
#pragma unroll
                for (int jv = 0; jv < 2; ++jv) { const f32x4 s0 = Sa[2 * ks][jv], s1 = Sa[2 * ks + 1][jv]; v4u p; p.x = pk2(s0[0], s0[1]); p.y = pk2(s0[2], s0[3]); p.z = pk2(s1[0], s1[1]); p.w = pk2(s1[2], s1[3]); X[jv] = __builtin_bit_cast(bf16x8, p); }
#pragma unroll
                for (int tt = 0; tt < 4; ++tt) { const v2u y0 = *(LAS v2u*)(qT + (tt * 16 + fr) * 136 + ks * 32 + 4 * fq), y1 = *(LAS v2u*)(qT + (tt * 16 + fr) * 136 + ks * 32 + 16 + 4 * fq);
                    v4u yy; yy.x = y0.x; yy.y = y0.y; yy.z = y1.x; yy.w = y1.y; const bf16x8 Y = __builtin_bit_cast(bf16x8, yy);
                    acc[0][tt] = MFMA16(X[0], Y, acc[0][tt]); acc[1][tt] = MFMA16(X[1], Y, acc[1][tt]); } }
#pragma unroll
            for (int ks = 0; ks < 2; ++ks) { bf16x8 X[2];
#pragma unroll
                for (int jv = 0; jv < 2; ++jv) X[jv] = tr_frag(Vl, 528, ks * 32, (2 * w + jv) * 16, lane);
#pragma unroll
                for (int tt = 0; tt < 4; ++tt) { if (ks == 1 && tt < 2) continue; const bf16x8 Y = *(LAS bf16x8*)(Al + (tt * 16 + fr) * 72 + ks * 32 + 8 * fq); acc[0][tt] = MFMA16(X[0], Y, acc[0][tt]); acc[1][tt] = MFMA16(X[1], Y, acc[1][tt]); }
#pragma unroll
                for (int dkt = 0; dkt < 8; ++dkt) { const bf16x8 K = tr_frag((LAS unsigned char*)kT, 272, ks * 32, dkt * 16, lane);
                    Sa[dkt][0] = MFMA16(K, X[0], Sa[dkt][0]); Sa[dkt][1] = MFMA16(K, X[1], Sa[dkt][1]); } }
#pragma unroll
            for (int dkt = 0; dkt < 8; ++dkt) { const f32x4 e4 = *(LAS f32x4*)(elL + dkt * 16 + 4 * fq); Sa[dkt][0] *= e4; Sa[dkt][1] *= e4; }
            v2u gg[4][2];
#pragma unroll
            for (int jv = 0; jv < 2; ++jv)
#pragma unroll
                for (int tt = 0; tt < 4; ++tt) gg[tt][jv] = *(const GAS v2u*)(Z + (size_t)(t0 + tt * 16 + fr) * LDZ + OFF_GG + h * 256 + (2 * w + jv) * 16 + 4 * fq);
#pragma unroll
            for (int tt = 0; tt < 4; ++tt) { float s = 0.f;
#pragma unroll
                for (int jv = 0; jv < 2; ++jv) { const f32x4 a = acc[jv][tt]; s += (a[0] * a[0] + a[1] * a[1]) + (a[2] * a[2] + a[3] * a[3]); }
                s += pg8::shx(s, lane, 16); s += pg8::shx(s, lane, 32);
                if (fq == 0) part[(tt * 16 + fr) * 8 + w] = s; }
            __syncthreads();
#pragma unroll
            for (int tt = 0; tt < 4; ++tt) { const int t = tt * 16 + fr; const f32x4 p0 = *(LAS f32x4*)(part + t * 8), p1 = *(LAS f32x4*)(part + t * 8 + 4);
                const float rs = __builtin_amdgcn_rsqf(((p0[0] + p0[1]) + (p0[2] + p0[3]) + (p1[0] + p1[1]) + (p1[2] + p1[3])) * (1.0f / 256.0f) + RMS_EPS);
#pragma unroll
                for (int jv = 0; jv < 2; ++jv) { const int dv = (2 * w + jv) * 16 + 4 * fq; const v2u gv = gg[tt][jv]; const f32x4 a = acc[jv][tt]; const f32x4 gn = *(const GAS f32x4*)(F.gla_g + l * 256 + dv);
                    const float g0 = bflo(gv.x), g1 = bfhi(gv.x), g2 = bflo(gv.y), g3 = bfhi(gv.y);
                    const float o0 = a[0] * rs * gn[0] * g0 * __builtin_amdgcn_rcpf(1.0f + __expf(-g0)), o1 = a[1] * rs * gn[1] * g1 * __builtin_amdgcn_rcpf(1.0f + __expf(-g1));
                    const float o2 = a[2] * rs * gn[2] * g2 * __builtin_amdgcn_rcpf(1.0f + __expf(-g2)), o3 = a[3] * rs * gn[3] * g3 * __builtin_amdgcn_rcpf(1.0f + __expf(-g3));
                    v2u o; o.x = pk2(o0, o1); o.y = pk2(o2, o3); *(GAS v2u*)(AA + (size_t)(t0 + t) * 2048 + h * 256 + dv) = o; } }
        }
    }
    __syncthreads();
#undef GC_FETCH
}
constexpr int SW_K = 0, SW_V = 256 * 144, SW_P = SW_V + 288 * 144, SW_END = SW_P + 8 * 16 * 336;
static_assert(SW_END <= RING_BYTES, "SWA LDS map");
__device__ __forceinline__ void swa_phase(Frame& F, int l) {
    LAS unsigned char* lds = F.lds;
    LAS bf16* Kl = (LAS bf16*)(lds + SW_K); LAS unsigned char* Vl = lds + SW_V;
    const int tid = F.tid, lane = F.lane, w = F.wave, fr = lane & 15, fq = lane >> 4;
    LAS bf16* Pl = (LAS bf16*)(lds + SW_P + w * (16 * 336));
    const bf16* Z = (const bf16*)(F.ws + WS_Z); unsigned char* AB8 = F.ws + WS_AB;
    for (int i = tid; i < 32 * 144 / 4; i += NWAVES * 64) ((LAS unsigned*)(Vl + 256 * 144))[i] = 0u;
    const int NITEM = BATCH * 32 * 8;
    f32x4 pen0, pen8;
#pragma unroll
    for (int e = 0; e < 4; ++e) { pen0[e] = (4 * fq + e <= fr) ? -1e30f : 0.f; pen8[e] = (4 * fq + e > fr) ? -1e30f : 0.f; }
    v4u kreg[4], vreg[4];
#define SW_FETCH(item_) do { const int g_ = (item_) & 7, qb_ = ((item_) >> 3) & 31, b_ = (item_) >> 8, q0_ = b_ * SEQ + qb_ * 128; \
        _Pragma("unroll") for (int i = 0; i < 4; ++i) { const int c = tid + 512 * i, kr = c >> 3, d0 = (c & 7) * 8; int tok = q0_ - 128 + kr; if (tok < b_ * SEQ) tok = b_ * SEQ; \
            const size_t zr = (size_t)tok * LDZ + g_ * 64 + d0; kreg[i] = *(const GAS v4u*)(Z + zr + OFF_SK); vreg[i] = *(const GAS v4u*)(Z + zr + OFF_SV); } } while (0)
    SW_FETCH((int)blockIdx.x < NITEM ? (int)blockIdx.x : NITEM - 1);
    for (int item = blockIdx.x; item < NITEM; item += F.G) {
        const int g = item & 7, qb = (item >> 3) & 31, b = item >> 8, q0 = b * SEQ + qb * 128;
#pragma unroll
        for (int i = 0; i < 4; ++i) { const int c = tid + 512 * i, kr = c >> 3, d0 = (c & 7) * 8; *(LAS v4u*)(Kl + kr * 72 + d0) = kreg[i]; *(LAS v4u*)(Vl + kr * 144 + d0 * 2) = vreg[i]; }
        const int r = w >> 1, hq = g * 4 + r; const float sink = F.sinks[l * 32 + hq];
        bf16x8 Yc[2]; v2u gc[4];
        { const size_t qrow = (size_t)(q0 + 64 * (w & 1) + fr);
#pragma unroll
          for (int ks = 0; ks < 2; ++ks) Yc[ks] = *(const GAS bf16x8*)(Z + qrow * LDZ + OFF_SQ + hq * 64 + ks * 32 + 8 * fq);
#pragma unroll
          for (int c = 0; c < 4; ++c) gc[c] = *(const GAS v2u*)(Z + qrow * LDZ + OFF_SG + hq * 64 + c * 16 + 4 * fq); }
        __syncthreads();
        if (item + F.G < NITEM) SW_FETCH(item + F.G);
#pragma unroll 1
        for (int qt = 0; qt < 4; ++qt) {
            const int ql0 = 64 * (w & 1) + 16 * qt; const size_t qrow = (size_t)(q0 + ql0 + fr);
            bf16x8 Yn[2]; v2u gn[4];
            { const size_t qn = (size_t)(q0 + 64 * (w & 1) + 16 * ((qt + 1) & 3) + fr);
#pragma unroll
              for (int ks = 0; ks < 2; ++ks) Yn[ks] = *(const GAS bf16x8*)(Z + qn * LDZ + OFF_SQ + hq * 64 + ks * 32 + 8 * fq);
#pragma unroll
              for (int c = 0; c < 4; ++c) gn[c] = *(const GAS v2u*)(Z + qn * LDZ + OFF_SG + hq * 64 + c * 16 + 4 * fq); }
            f32x4 S[9];
#pragma unroll
            for (int kt = 0; kt < 9; ++kt) { f32x4 a = (f32x4){0.f, 0.f, 0.f, 0.f};
#pragma unroll
                for (int ks = 0; ks < 2; ++ks) { const bf16x8 X = *(LAS bf16x8*)(Kl + (ql0 + 16 * kt + fr) * 72 + ks * 32 + 8 * fq); a = MFMA16(X, Yc[ks], a); }
                S[kt] = a; }
            const int qpos = qb * 128 + ql0 + fr; const float CS = 0.125f * 1.4426950408889634f, sink2 = sink * 1.4426950408889634f;
            S[0] += pen0; S[8] += pen8;
            if (qb == 0) {
#pragma unroll
                for (int kt = 0; kt < 8; ++kt)
#pragma unroll
                    for (int e = 0; e < 4; ++e) if (qpos - 128 + 16 * kt + 4 * fq + e - fr < 0) S[kt][e] = -1e30f; }
            float mr = S[0][0];
#pragma unroll
            for (int kt = 0; kt < 9; ++kt) mr = fmaxf(fmaxf(mr, fmaxf(S[kt][0], S[kt][1])), fmaxf(S[kt][2], S[kt][3]));
            mr = fmaxf(mr, pg8::shx(mr, lane, 16)); mr = fmaxf(mr, pg8::shx(mr, lane, 32));
            const float m2 = fmaxf(mr * CS, sink2);
            float sum = 0.f;
#pragma unroll
            for (int kt = 0; kt < 9; ++kt) { f32x4 p;
#pragma unroll
                for (int e = 0; e < 4; ++e) { p[e] = __builtin_amdgcn_exp2f(S[kt][e] * CS - m2); sum += p[e]; }
                v2u o; o.x = pk2(p[0], p[1]); o.y = pk2(p[2], p[3]); *(LAS v2u*)(Pl + fr * 168 + 16 * kt + 4 * fq) = o; }
            { unsigned z0 = 0u; asm volatile("" : "+v"(z0)); v2u o; o.x = z0; o.y = z0; *(LAS v2u*)(Pl + fr * 168 + 144 + 4 * fq) = o; }
            sum += pg8::shx(sum, lane, 16); sum += pg8::shx(sum, lane, 32);
            const float iv = __builtin_amdgcn_rcpf(sum + __builtin_amdgcn_exp2f(sink2 - m2)) * AB8_SCALE;
            LDS_WAIT(); asm volatile("" ::: "memory");
            f32x4 O[4];
#pragma unroll
            for (int c = 0; c < 4; ++c) O[c] = (f32x4){0.f, 0.f, 0.f, 0.f};
#pragma unroll
            for (int k5 = 0; k5 < 5; ++k5) { const bf16x8 Y = *(LAS bf16x8*)(Pl + fr * 168 + k5 * 32 + 8 * fq);
#pragma unroll
                for (int c = 0; c < 4; ++c) { const bf16x8 X = tr_frag(Vl, 144, ql0 + 32 * k5, c * 16, lane); O[c] = MFMA16(X, Y, O[c]); } }
#pragma unroll
            for (int c = 0; c < 4; ++c) { const int dd = hq * 64 + c * 16 + 4 * fq; const v2u gv = gc[c];
                const float g0 = bflo(gv.x), g1 = bfhi(gv.x), g2 = bflo(gv.y), g3 = bfhi(gv.y);
                const float o0 = O[c][0] * iv * g0 * __builtin_amdgcn_rcpf(1.0f + __expf(-g0)), o1 = O[c][1] * iv * g1 * __builtin_amdgcn_rcpf(1.0f + __expf(-g1));
                const float o2 = O[c][2] * iv * g2 * __builtin_amdgcn_rcpf(1.0f + __expf(-g2)), o3 = O[c][3] * iv * g3 * __builtin_amdgcn_rcpf(1.0f + __expf(-g3));
                int q = __builtin_amdgcn_cvt_pk_fp8_f32(o0, o1, 0, false); q = __builtin_amdgcn_cvt_pk_fp8_f32(o2, o3, q, true); *(GAS unsigned*)(AB8 + qrow * 2048 + dd) = (unsigned)q; }
            asm volatile("" ::: "memory");
#pragma unroll
            for (int ks = 0; ks < 2; ++ks) Yc[ks] = Yn[ks];
#pragma unroll
            for (int c = 0; c < 4; ++c) gc[c] = gn[c];
        }
        __syncthreads();
    }
#undef SW_FETCH
}
#ifndef GEMM_BAL
#define GEMM_BAL true
#endif
#ifndef REP_PRO
#define REP_PRO 1
#endif
#ifndef REP_P1
#define REP_P1 1
#endif
#ifndef REP_GA
#define REP_GA 1
#endif
#ifndef REP_SWA
#define REP_SWA 1
#endif
#ifndef REP_SCAN
#define REP_SCAN 1
#endif
#ifndef REP_GC
#define REP_GC 1
#endif
#ifndef REP_P3
#define REP_P3 1
#endif
#ifndef REP_BAR
#define REP_BAR 1
#endif
#ifndef REP_P4
#define REP_P4 1
#endif
struct Args { const float* in[12]; float* out; unsigned char* ws; int ph_lo, ph_hi; };
static_assert(sizeof(Args) == 14 * 8 + 8, "Args has no holes");
__global__ void __launch_bounds__(NWAVES * 64, 2) hybrid_fwd(Args args) {
    extern __shared__ __attribute__((aligned(16))) unsigned char lds[];
    Frame F;
    F.lds = (LAS unsigned char*)lds; F.MISC = (volatile LAS unsigned*)(F.lds + MISC_OFF);
    F.tid = threadIdx.x; F.lane = F.tid & 63; F.wave = __builtin_amdgcn_readfirstlane(F.tid >> 6); F.G = gridDim.x;
    F.ws = args.ws; F.ctl = (gu32*)(args.ws + WS_CTL);
    F.x = args.in[0]; F.norm_g = args.in[1]; F.w_in = args.in[2]; F.b_gates = args.in[3]; F.w_up = args.in[4]; F.b_dec = args.in[5]; F.gla_g = args.in[6]; F.sinks = args.in[7];
    F.w_gla = args.in[8]; F.w_swa = args.in[9]; F.w_out = args.in[10]; F.fin_g = args.in[11]; F.out = args.out;
    for (int u = F.tid; u < (LDS_BYTES - LDSCTL_OFF) / 4; u += NWAVES * 64) ((LAS unsigned*)(F.lds + LDSCTL_OFF))[u] = 0u;
    __syncthreads();
    XcdBarrier bar; bar.bar = (unsigned*)(F.ctl + CW_BAR); bar.x = 0; bar.st = nullptr;
    if (!MK_PER_PHASE) bar = xcd_barrier_post((unsigned*)(F.ctl + CW_BAR), F.MISC + 8);
    const int wv0 = __builtin_amdgcn_readfirstlane(threadIdx.x >> 6);
    const int lo = args.ph_lo, hi = args.ph_hi;
#if MK_PER_PHASE
#define IN(k) (lo <= (k) && (k) < hi)
#else
#define IN(k) true
#endif
#define PHASE_BEGIN() do { unsigned m_ = ~0u; asm volatile("" : "+s"(m_)); int t_ = wv0 * 64 + (int)__builtin_amdgcn_mbcnt_hi(m_, __builtin_amdgcn_mbcnt_lo(m_, 0u)); asm volatile("" : "+v"(t_)); F.tid = t_; F.lane = t_ & 63; F.wave = __builtin_amdgcn_readfirstlane(t_ >> 6); unsigned long long z_ = 0ull; asm volatile("" : "+s"(z_)); unsigned char* w_ = args.ws + z_; F.ws = w_; F.ctl = (gu32*)(w_ + WS_CTL); } while (0)
#define SEAM(k) do { if (IN(k) && IN((k) + 1)) { unsigned long long z_ = 0ull; asm volatile("" : "+s"(z_)); bar.bar = (unsigned*)(args.ws + WS_CTL + z_) + CW_BAR; for (int rb_ = 0; rb_ < REP_BAR; ++rb_) xcd_barrier(bar); } } while (0)
    if (IN(0)) for (int rep = 0; rep < REP_PRO; ++rep) { PHASE_BEGIN(); p0_prologue(F); }
    SEAM(0);
    for (int l = 0; l < DEPTH; ++l) {
        const int p = 1 + 6 * l;
        if (IN(p)) for (int rep = 0; rep < REP_P1; ++rep) {
            PHASE_BEGIN(); const bf16* XBp = (const bf16*)(F.ws + WS_XB); bf16* Zp = (bf16*)(F.ws + WS_Z);
            gdec_phase(F, l);
            pg8::StaticOrder S; S.init(M, NZ_BF, F.G, (int)blockIdx.x);
            pg8::EpiZ E; E.Z = Zp; E.P = (const float*)(F.ws + WS_SSQP); E.rsl = (const LAS float*)(F.lds + RS_OFF); E.mul = 1.0f;
            const float* SXc = (const float*)(F.ws + WS_SX) + (size_t)(l & 1) * M; float* SXn = (float*)(F.ws + WS_SX) + (size_t)((l + 1) & 1) * M; const float iwq = 1.0f / ((const float*)(F.ws + WS_SX))[2 * M + l];
            { pg8::Unit u0; const bool has = S.next(0, u0); E.pm0 = has ? u0.pm : -1;
              if (has && F.tid < 256) { const int row = u0.pm * 256 + F.tid; const float rstd = pg8::row_rstd(E.P, row); ((LAS float*)(F.lds + RS_OFF))[F.tid] = rstd;
                  ((LAS float*)(F.lds + RS2_OFF))[F.tid] = rstd * iwq * __builtin_amdgcn_rcpf(SXc[row]); SXn[row] = (127.0f / QC_XP) * rstd; ((LAS float*)(F.lds + RS3_OFF))[F.tid] = (127.0f / QC_XP) * rstd; }
              __syncthreads(); }
            { pg8::RevOrder S8; S8.init(M, NZ_F8, F.G, (int)blockIdx.x); pg8::Unit u0; const bool has = S8.next(0, u0);
              pg8::EpiZ8 E8{Zp + NZ_BF, E.P, SXc, iwq, (!has || u0.pm != E.pm0) ? -1 : E.pm0, (const LAS float*)(F.lds + RS2_OFF), F.ws + WS_GT, (OFF_GA - NZ_BF) / 256};
              pg8::Gemm g{(const bf16*)(F.ws + WS_X8), (const bf16*)(F.ws + WS_WIN8 + (size_t)l * NZ_F8 * D), M, NZ_F8, D / 2};
              pg8::gemm_phase<pg8::EpiZ8, pg8::RevOrder, true, true, false, GEMM_BAL, true>(F.lds, g, S8, E8, F.tid); }
            { pg8::Gemm g{XBp, (const bf16*)(F.ws + WS_WIN) + (size_t)l * NZ * D, M, NZ_BF, D};
              pg8::gemm_phase<pg8::EpiZ, pg8::StaticOrder, true, true, false, GEMM_BAL>(F.lds, g, S, E, F.tid); }
        }
        SEAM(p);
        if (IN(p + 1)) { for (int rep = 0; rep < REP_GA; ++rep) { PHASE_BEGIN(); gla_a_phase(F, l); } for (int rep = 0; rep < REP_SWA; ++rep) { PHASE_BEGIN(); swa_phase(F, l); } }
        SEAM(p + 1);
        if (IN(p + 2)) for (int rep = 0; rep < REP_SCAN; ++rep) { PHASE_BEGIN(); gla_scan_phase(F); }
        SEAM(p + 2);
        if (IN(p + 3)) for (int rep = 0; rep < REP_GC; ++rep) { PHASE_BEGIN(); gla_c_phase(F, l); }
        SEAM(p + 3);
        if (IN(p + 4)) for (int rep = 0; rep < REP_P3; ++rep) {
            { PHASE_BEGIN(); bf16* Zp = (bf16*)(F.ws + WS_Z); pg8::Gemm g{(const bf16*)(F.ws + WS_AA), (const bf16*)(F.ws + WS_WGLA) + (size_t)l * D * 2048, M, D, 2048}; pg8::StaticOrder S; S.init(M, D, F.G, (int)blockIdx.x);
              LAS float* mred = (LAS float*)(F.lds + MQ_OFF + 16); if (F.tid < 8) mred[F.tid] = 0.f; __syncthreads();
              int nu = ((M / 256) * (D / 256) - (int)blockIdx.x + F.G - 1) / F.G; asm volatile("" : "+s"(nu));
              pg8::EpiGateA E{F.ws + WS_GT, F.b_gates + (size_t)(l * 2 + 0) * D, F.ws + WS_TMP, (LAS float*)mred};
              pg8::gemm_phase<pg8::EpiGateA, pg8::StaticOrder, false, true, false, GEMM_BAL>(F.lds, g, S, E, F.tid);
              __syncthreads();
              if (F.tid == 0) { float t = 0.f;
#pragma unroll
                  for (int w_ = 0; w_ < 8; ++w_) t += mred[w_];
                  *(LAS float*)(F.lds + MQ_OFF) = (127.0f / QC_M) * __builtin_amdgcn_rsqf(t / (65536.0f * (float)(nu > 0 ? nu : 1)) + 1e-30f); }
              __syncthreads(); }
            { PHASE_BEGIN(); bf16* Zp = (bf16*)(F.ws + WS_Z); pg8::Gemm g{(const bf16*)(F.ws + WS_AB), (const bf16*)(F.ws + WS_WSWA + (size_t)l * D * 2048), M, D, 1024}; pg8::StaticOrder S; S.init(M, D, F.G, (int)blockIdx.x);
              pg8::EpiGateB8 E{F.ws + WS_GT + (size_t)1024 * 131072, F.b_gates + (size_t)(l * 2 + 1) * D, F.ws + WS_TMP, F.ws + WS_MERGED, 1.0f / (W8_SCALE * AB8_SCALE), *(const LAS float*)(F.lds + MQ_OFF) * 0.35355339f};
              pg8::gemm_phase<pg8::EpiGateB8, pg8::StaticOrder, false, true, true, GEMM_BAL>(F.lds, g, S, E, F.tid); }
        }
        SEAM(p + 4);
        if (IN(p + 5)) for (int rep = 0; rep < REP_P4; ++rep) {
            PHASE_BEGIN(); pg8::Gemm g{(const bf16*)(F.ws + WS_MERGED), (const bf16*)(F.ws + WS_WOUT + (size_t)l * D * D), M, D, D / 2};
            pg8::EpiRes E{(bf16*)(F.ws + (rep ? WS_TMP : WS_XB)), (float*)(F.ws + (rep ? WS_TMP + 192 * MiB : WS_SSQP)), F.ws + (rep ? WS_TMP + 128 * MiB : WS_X8), (const float*)(F.ws + WS_SX) + (size_t)((l + 1) & 1) * M, (const LAS float*)(F.lds + RS3_OFF), -1, 1.0f / (*(const LAS float*)(F.lds + MQ_OFF) * ((const float*)(F.ws + WS_SX))[2 * M + DEPTH + l])};
            { pg8::StaticOrder S0; S0.init(M, D, F.G, (int)blockIdx.x); pg8::Unit u0; if (S0.next(0, u0)) E.pm0 = u0.pm; }
#if defined(PROBE_P4_HOT)
            if (rep) { pg8::HotOrder S; S.init(M, D, F.G, (int)blockIdx.x); pg8::gemm_phase<pg8::EpiRes, pg8::HotOrder, false, true, false, GEMM_BAL, true>(F.lds, g, S, E, F.tid); } else
#endif
            { pg8::StaticOrder S; S.init(M, D, F.G, (int)blockIdx.x); pg8::gemm_phase<pg8::EpiRes, pg8::StaticOrder, false, true, false, GEMM_BAL, true>(F.lds, g, S, E, F.tid); }
        }
        SEAM(p + 5);

    }
    if (IN(N_PHASES - 1)) { PHASE_BEGIN(); final_norm(F); }
#undef IN
#undef SEAM
}

extern "C" void kernel_launch(void* const* d_in, const int* in_sizes, int n_in, void* d_out, int out_size, void* d_ws, size_t ws_size, hipStream_t stream) {
    static int grid = 0;
    if (grid == 0) {
        if (n_in != 12 || in_sizes[0] != M * D || out_size != M * D || ws_size < WS_END) { fprintf(stderr, "kernel_launch: unexpected shapes (n_in %d, in0 %d, out %d, ws %zu < %zu); nothing launched\n", n_in, n_in > 0 ? in_sizes[0] : -1, out_size, ws_size, (size_t)WS_END); grid = -1; return; }
        int dev = 0, cus = 0, per_cu = 0;
        if (hipGetDevice(&dev) != hipSuccess || hipDeviceGetAttribute(&cus, hipDeviceAttributeMultiprocessorCount, dev) != hipSuccess) { grid = -1; return; }
        if (hipFuncSetAttribute((const void*)hybrid_fwd, hipFuncAttributeMaxDynamicSharedMemorySize, LDS_BYTES) != hipSuccess) { fprintf(stderr, "kernel_launch: hipFuncSetAttribute failed\n"); grid = -1; return; }
        if (hipOccupancyMaxActiveBlocksPerMultiprocessor(&per_cu, (const void*)hybrid_fwd, NWAVES * 64, LDS_BYTES) != hipSuccess || per_cu < 1) { fprintf(stderr, "kernel_launch: occupancy query reports %d blocks per CU\n", per_cu); }
        (void)hipGetLastError();
        grid = cus;
    }
    if (grid < 0) return;
    if (hipMemsetAsync((char*)d_ws + WS_CTL, 0, CTL_ZERO_BYTES, stream) != hipSuccess) return;
    Args a{};
    for (int i = 0; i < 12; ++i) a.in[i] = (const float*)d_in[i];
    a.out = (float*)d_out; a.ws = (unsigned char*)d_ws;
#if MK_PER_PHASE
    for (int ph = 0; ph < N_PHASES; ++ph) { a.ph_lo = ph; a.ph_hi = ph + 1; hipLaunchKernelGGL(hybrid_fwd, dim3(grid), dim3(NWAVES * 64), LDS_BYTES, stream, a); }
#else
    a.ph_lo = 0; a.ph_hi = N_PHASES; hipLaunchKernelGGL(hybrid_fwd, dim3(grid), dim3(NWAVES * 64), LDS_BYTES, stream, a);
#endif
    const hipError_t le = hipPeekAtLastError();
    if (le != hipSuccess) fprintf(stderr, "kernel_launch: launch failed: %s\n", hipGetErrorName(le));
}
```

```cpp
#include <hip/hip_runtime.h>
#include <cstdio>
#include <cstdint>
namespace pg8 {
#define PG8_LAS __attribute__((address_space(3)))
typedef unsigned short bf16_t;
typedef short bf16x8 __attribute__((ext_vector_type(8)));
typedef float f32x4 __attribute__((ext_vector_type(4)));
typedef unsigned u32x4 __attribute__((ext_vector_type(4)));
typedef int i32x4 __attribute__((ext_vector_type(4)));
typedef int i32x8 __attribute__((ext_vector_type(8)));
constexpr int BM = 256, BK = 64, HALF = 128, HTB = HALF * BK * 2  , STAGE_BYTES = 8 * HTB, NXCD = 8, WGM = 8;

__host__ __device__ __forceinline__ int lds_byte(int r, int c) { const int st = (r >> 4) * 2 + (c >> 5), rr = r & 15, cc = c & 31, ob = rr * 64 + cc * 2; return st * 1024 + (ob ^ (((ob >> 9) & 1) << 5)); }
__host__ __device__ __forceinline__ void stage_rc(int b, int& R, int& C) { const int st = b / 1024, sb = b % 1024, swz = sb ^ (((sb >> 9) & 1) << 5); R = (st >> 1) * 16 + swz / 64; C = (st & 1) * 32 + (swz % 64) / 2; }
__host__ __device__ __forceinline__ int perm32(int rho) { const int n = rho >> 4, i = rho & 15; return 8 * (i >> 2) + 4 * n + (i & 3); }

struct Unit { int pm, pn; };
struct Gemm { const bf16_t* A; const bf16_t* Bt; int M, N, K; };

struct StaticOrder {
    int nM, nN, nwg, G, c;
    __host__ __device__ void init(int M, int N, int G_, int c_) { nM = M / BM; nN = N / BM; nwg = nM * nN; G = G_; c = c_; }
    __host__ __device__ bool next(int i, Unit& u) const {
        const long L = (long)i * G + c; if (L >= nwg) return false;
        int wgid = (int)L; { const int q = nwg / NXCD, r = nwg % NXCD, xcd = wgid % NXCD, off = wgid / NXCD; wgid = (xcd < r ? xcd * (q + 1) : r * (q + 1) + (xcd - r) * q) + off; }
        const int nig = WGM * nN, gid = wgid / nig, fm = gid * WGM, gsz = (nM - fm) < WGM ? (nM - fm) : WGM;
        u.pm = fm + ((wgid % nig) % gsz); u.pn = (wgid % nig) / gsz; return true;
    }
    __device__ __forceinline__ void a_ready(const Unit&) const {}
    __device__ __forceinline__ void done(const Unit&) const {}
};
typedef unsigned u32x2 __attribute__((ext_vector_type(2)));
typedef float f32x2c __attribute__((ext_vector_type(2))); typedef __bf16 bf16x2c __attribute__((ext_vector_type(2)));
__device__ __forceinline__ unsigned cvt_pk_bf16(float lo, float hi) { const f32x2c v = {lo, hi}; return __builtin_bit_cast(unsigned, __builtin_convertvector(v, bf16x2c)); }
typedef float f32x2 __attribute__((ext_vector_type(2)));
struct HotOrder : StaticOrder { __host__ __device__ bool next(int i, Unit& u) const { const bool r = StaticOrder::next(i, u); u.pm = c & 7; u.pn = 0; return r; } };
constexpr int LDZ = 19456;
__device__ __forceinline__ float bf_lo(unsigned w) { return __uint_as_float(w << 16); }
__device__ __forceinline__ float bf_hi(unsigned w) { return __uint_as_float(w & 0xffff0000u); }
__device__ __forceinline__ float sigmoidf_(float x) { return __builtin_amdgcn_rcpf(1.0f + __expf(-x)); }
__host__ __device__ __forceinline__ int kperm8(int k) { return (k & ~63) | ((k & 0x18) << 1) | ((k >> 2) & 8) | (k & 7); }
__device__ __forceinline__ unsigned q8x4(float a, float b, float c, float d, float q) {
    const float MG = 12582912.0f, LO = MG - 127.0f, HI = MG + 127.0f;
    const unsigned i0 = __float_as_uint(__builtin_amdgcn_fmed3f(__builtin_fmaf(a, q, MG), LO, HI)), i1 = __float_as_uint(__builtin_amdgcn_fmed3f(__builtin_fmaf(b, q, MG), LO, HI));
    const unsigned i2 = __float_as_uint(__builtin_amdgcn_fmed3f(__builtin_fmaf(c, q, MG), LO, HI)), i3 = __float_as_uint(__builtin_amdgcn_fmed3f(__builtin_fmaf(d, q, MG), LO, HI));
    return __builtin_amdgcn_perm(i1, i0, 0x0c0c0400u) | __builtin_amdgcn_perm(i3, i2, 0x04000c0cu);
}
__device__ __forceinline__ float shx(float v, int lane, int mask) { return __int_as_float(__builtin_amdgcn_ds_bpermute((lane ^ mask) << 2, __float_as_int(v))); }
__device__ __forceinline__ float row_ssq(const float* P, int row) {
    const f32x4* p = (const f32x4*)(P + (size_t)row * 64); float s = 0.f;
#pragma unroll
    for (int j = 0; j < 16; ++j) { const f32x4 v = p[j]; s += (v[0] + v[1]) + (v[2] + v[3]); }
    return s;
}
__device__ __forceinline__ float row_rstd(const float* P, int row) { return __builtin_amdgcn_rsqf(row_ssq(P, row) * (1.0f / 4096.0f) + 1e-6f); }
__device__ __forceinline__ float row_rstd_slow(const float* P, int row) {
    const f32x4* p = (const f32x4*)(P + (size_t)row * 64); float s = 0.f;
#pragma unroll 1
    for (int j = 0; j < 16; ++j) { const f32x4 v = p[j]; s += (v[0] + v[1]) + (v[2] + v[3]); }
    return __builtin_amdgcn_rsqf(s * (1.0f / 4096.0f) + 1e-6f);
}
struct EpiZ {
    static constexpr bool PERM = true, AFTER_DRAIN = false, IDEMP = true;
    bf16_t* Z; const float* P; int pm0; const PG8_LAS float* rsl; float mul;
    __device__ __forceinline__ void operator()(const f32x4 (&acc)[2][2][4][2], const Unit& u, int wr, int wc, int fr_in, int fq_in) const {
        int fr = fr_in, fq = fq_in; asm volatile("" : "+v"(fr), "+v"(fq));
        const int row0 = u.pm * BM + wr * 64 + fr, col0 = u.pn * BM + wc * 64 + 8 * fq;
#pragma unroll
        for (int ai = 0; ai < 2; ++ai)
#pragma unroll
            for (int m = 0; m < 4; ++m) { const int row = row0 + ai * HALF + m * 16; const float r = ((u.pm == pm0) ? rsl[ai * HALF + wr * 64 + m * 16 + fr] : row_rstd_slow(P, row)) * mul;
                bf16_t* rowp = Z + (size_t)row * LDZ + col0;
#pragma unroll
                for (int bj = 0; bj < 2; ++bj) { const f32x4 v0 = acc[ai][bj][m][0] * r, v1 = acc[ai][bj][m][1] * r;
                    u32x4 w; w.x = cvt_pk_bf16(v0[0], v0[1]); w.y = cvt_pk_bf16(v0[2], v0[3]); w.z = cvt_pk_bf16(v1[0], v1[1]); w.w = cvt_pk_bf16(v1[2], v1[3]);
                    *(u32x4*)(rowp + bj * 32) = w; } }
    }
};
struct EpiZ8 {
    static constexpr bool PERM = true, AFTER_DRAIN = false, IDEMP = true;
    bf16_t* Z; const float* P; const float* SX; float iwq; int pm0; const PG8_LAS float* rsl; unsigned char* GT; int gpn0;
    __device__ __forceinline__ void operator()(const f32x4 (&acc)[2][2][4][2], const Unit& u, int wr, int wc, int fr_in, int fq_in) const {
        int fr = fr_in, fq = fq_in; asm volatile("" : "+v"(fr), "+v"(fq));
        const int row0 = u.pm * BM + wr * 64 + fr, col0 = u.pn * BM + wc * 64 + 8 * fq;
#pragma unroll
        for (int ai = 0; ai < 2; ++ai)
#pragma unroll
            for (int m = 0; m < 4; ++m) { const int row = row0 + ai * HALF + m * 16; const float r = (u.pm == pm0) ? rsl[ai * HALF + wr * 64 + m * 16 + fr] : row_rstd_slow(P, row) * iwq * __builtin_amdgcn_rcpf(SX[row]);
                const bool gate = u.pn >= gpn0; const int gi = u.pn - gpn0;
                unsigned char* dst = gate ? GT + (((size_t)((gi >> 4) * 1024 + u.pm * 16 + (gi & 15)) * 8 + (wr * 4 + wc)) * 16 + (ai * 4 + m) * 2) * 1024 + (fr + 16 * fq) * 16 : (unsigned char*)(Z + (size_t)row * LDZ + col0);
                const int bstep = gate ? 1024 : 64;
#pragma unroll
                for (int bj = 0; bj < 2; ++bj) { const i32x4 i0 = __builtin_bit_cast(i32x4, acc[ai][bj][m][0]), i1 = __builtin_bit_cast(i32x4, acc[ai][bj][m][1]);
                    const f32x4 v0 = (f32x4){(float)i0[0], (float)i0[1], (float)i0[2], (float)i0[3]} * r, v1 = (f32x4){(float)i1[0], (float)i1[1], (float)i1[2], (float)i1[3]} * r;
                    u32x4 w; w.x = cvt_pk_bf16(v0[0], v0[1]); w.y = cvt_pk_bf16(v0[2], v0[3]); w.z = cvt_pk_bf16(v1[0], v1[1]); w.w = cvt_pk_bf16(v1[2], v1[3]);
                    *(u32x4*)(dst + bj * bstep) = w; } }
    }
};
#define PG8_SIG8(s0, s1, g, b0, b1) do { s0[0] = sigmoidf_(bf_lo(g.x) + b0[0]); s0[1] = sigmoidf_(bf_hi(g.x) + b0[1]); s0[2] = sigmoidf_(bf_lo(g.y) + b0[2]); s0[3] = sigmoidf_(bf_hi(g.y) + b0[3]); \
    s1[0] = sigmoidf_(bf_lo(g.z) + b1[0]); s1[1] = sigmoidf_(bf_hi(g.z) + b1[1]); s1[2] = sigmoidf_(bf_lo(g.w) + b1[2]); s1[3] = sigmoidf_(bf_hi(g.w) + b1[3]); } while (0)
struct EpiGateA {
    static constexpr bool PERM = true, AFTER_DRAIN = false, IDEMP = true;
    const unsigned char* G; const float* bias; unsigned char* T; PG8_LAS float* SS;
    __device__ __forceinline__ void operator()(const f32x4 (&acc)[2][2][4][2], const Unit& u, int wr, int wc, int fr_in, int fq_in) const {
        int fr = fr_in, fq = fq_in; asm volatile("" : "+v"(fr), "+v"(fq));
        const int row0 = u.pm * BM + wr * 64 + fr, col0 = u.pn * BM + wc * 64 + 8 * fq;
        f32x4 bv[2][2]; u32x4 gl[8][2], w[8][2]; float ss = 0.f;
        const size_t tofs = ((size_t)(u.pm * 16 + u.pn) * 8 + (wr * 4 + wc)) * 16384 + (fr + 16 * fq) * 16;
#pragma unroll
        for (int g = 0; g < 8; ++g) { const unsigned char* gp = G + tofs + g * 2048; gl[g][0] = *(const u32x4*)gp; gl[g][1] = *(const u32x4*)(gp + 1024); }
#pragma unroll
        for (int bj = 0; bj < 2; ++bj)
#pragma unroll
            for (int n = 0; n < 2; ++n) bv[bj][n] = *(const f32x4*)(bias + col0 + bj * 32 + 4 * n);
#pragma unroll
        for (int g = 0; g < 8; ++g) { const int ai = g >> 2, m = g & 3;
#pragma unroll
            for (int bj = 0; bj < 2; ++bj) { const u32x4 gg = gl[g][bj]; f32x4 s0, s1; PG8_SIG8(s0, s1, gg, bv[bj][0], bv[bj][1]); const f32x4 v0 = s0 * acc[ai][bj][m][0], v1 = s1 * acc[ai][bj][m][1];
                ss += ((v0[0] * v0[0] + v0[1] * v0[1]) + (v0[2] * v0[2] + v0[3] * v0[3])) + ((v1[0] * v1[0] + v1[1] * v1[1]) + (v1[2] * v1[2] + v1[3] * v1[3]));
                w[g][bj].x = cvt_pk_bf16(v0[0], v0[1]); w[g][bj].y = cvt_pk_bf16(v0[2], v0[3]); w[g][bj].z = cvt_pk_bf16(v1[0], v1[1]); w[g][bj].w = cvt_pk_bf16(v1[2], v1[3]); }
            asm volatile("" : "+v"(w[g][0]), "+v"(w[g][1])); }
        asm volatile("" ::: "memory");
#pragma unroll
        for (int g = 0; g < 8; ++g) { unsigned char* tp = T + tofs + g * 2048; *(u32x4*)tp = w[g][0]; *(u32x4*)(tp + 1024) = w[g][1]; }
        { const int ln = fr + 16 * fq;
#pragma unroll
          for (int o = 1; o < 64; o <<= 1) ss += shx(ss, ln, o);
          if (ln == 0) { PG8_LAS float* sp = SS + wr * 4 + wc; *sp = *sp + ss; } }
    }
};
struct EpiGateB {
    static constexpr bool PERM = true, AFTER_DRAIN = false, IDEMP = true;
    const bf16_t* G; const float* bias; const bf16_t* T; bf16_t* O; float mul;
    __device__ __forceinline__ void operator()(const f32x4 (&acc)[2][2][4][2], const Unit& u, int wr, int wc, int fr_in, int fq_in) const {
        int fr = fr_in, fq = fq_in; asm volatile("" : "+v"(fr), "+v"(fq));
        const int row0 = u.pm * BM + wr * 64 + fr, col0 = u.pn * BM + wc * 64 + 8 * fq;
        f32x4 bv[2][2]; u32x4 w[8][2];
#pragma unroll
        for (int bj = 0; bj < 2; ++bj)
#pragma unroll
            for (int n = 0; n < 2; ++n) bv[bj][n] = *(const f32x4*)(bias + col0 + bj * 32 + 4 * n);
#pragma unroll
        for (int ai = 0; ai < 2; ++ai) { u32x4 gl[4][2], tl[4][2];
#pragma unroll
            for (int m = 0; m < 4; ++m) { const int r = row0 + ai * HALF + m * 16; const bf16_t* gp = G + (size_t)r * LDZ + col0; const bf16_t* tp = T + (size_t)r * 4096 + col0;
                gl[m][0] = *(const u32x4*)gp; gl[m][1] = *(const u32x4*)(gp + 32); tl[m][0] = *(const u32x4*)tp; tl[m][1] = *(const u32x4*)(tp + 32); }
#pragma unroll
            for (int m = 0; m < 4; ++m) { const int g = ai * 4 + m;
#pragma unroll
                for (int bj = 0; bj < 2; ++bj) { const u32x4 gg = gl[m][bj], tt = tl[m][bj]; f32x4 s0, s1; PG8_SIG8(s0, s1, gg, bv[bj][0], bv[bj][1]);
                    f32x4 v0 = s0 * (acc[ai][bj][m][0] * mul), v1 = s1 * (acc[ai][bj][m][1] * mul);
                    v0[0] += bf_lo(tt.x); v0[1] += bf_hi(tt.x); v0[2] += bf_lo(tt.y); v0[3] += bf_hi(tt.y); v1[0] += bf_lo(tt.z); v1[1] += bf_hi(tt.z); v1[2] += bf_lo(tt.w); v1[3] += bf_hi(tt.w);
                    w[g][bj].x = cvt_pk_bf16(v0[0], v0[1]); w[g][bj].y = cvt_pk_bf16(v0[2], v0[3]); w[g][bj].z = cvt_pk_bf16(v1[0], v1[1]); w[g][bj].w = cvt_pk_bf16(v1[2], v1[3]); }
                asm volatile("" : "+v"(w[g][0]), "+v"(w[g][1])); } }
        asm volatile("" ::: "memory");
#pragma unroll
        for (int g = 0; g < 8; ++g) { bf16_t* op = O + (size_t)(row0 + (g >> 2) * HALF + (g & 3) * 16) * 4096 + col0; *(u32x4*)op = w[g][0]; *(u32x4*)(op + 32) = w[g][1]; }
    }
};
struct EpiGateB8 {
    static constexpr bool PERM = true, AFTER_DRAIN = false, IDEMP = true;
    const unsigned char* G; const float* bias; const unsigned char* T; unsigned char* O; float mul, qm;
    __device__ __forceinline__ void operator()(const f32x4 (&acc)[2][2][4][2], const Unit& u, int wr, int wc, int fr_in, int fq_in) const {
        int fr = fr_in, fq = fq_in; asm volatile("" : "+v"(fr), "+v"(fq));
        const int row0 = u.pm * BM + wr * 64 + fr, col0 = u.pn * BM + wc * 64 + 8 * fq;
        f32x4 bv[2][2]; u32x2 w[8][2];
#pragma unroll
        for (int bj = 0; bj < 2; ++bj)
#pragma unroll
            for (int n = 0; n < 2; ++n) bv[bj][n] = *(const f32x4*)(bias + col0 + bj * 32 + 4 * n);
#pragma unroll
        for (int ai = 0; ai < 2; ++ai) { u32x4 gl[4][2], tl[4][2];
#pragma unroll
            for (int m = 0; m < 4; ++m) { const size_t o_ = ((size_t)(u.pm * 16 + u.pn) * 8 + (wr * 4 + wc)) * 16384 + (fr + 16 * fq) * 16 + (ai * 4 + m) * 2048; const unsigned char* gp = G + o_; const unsigned char* tp = T + o_;
                gl[m][0] = *(const u32x4*)gp; gl[m][1] = *(const u32x4*)(gp + 1024); tl[m][0] = *(const u32x4*)tp; tl[m][1] = *(const u32x4*)(tp + 1024); }
#pragma unroll
            for (int m = 0; m < 4; ++m) { const int g = ai * 4 + m;
#pragma unroll
                for (int bj = 0; bj < 2; ++bj) { const u32x4 gg = gl[m][bj], tt = tl[m][bj]; f32x4 s0, s1; PG8_SIG8(s0, s1, gg, bv[bj][0], bv[bj][1]);
                    f32x4 v0 = s0 * (acc[ai][bj][m][0] * mul), v1 = s1 * (acc[ai][bj][m][1] * mul);
                    v0[0] += bf_lo(tt.x); v0[1] += bf_hi(tt.x); v0[2] += bf_lo(tt.y); v0[3] += bf_hi(tt.y); v1[0] += bf_lo(tt.z); v1[1] += bf_hi(tt.z); v1[2] += bf_lo(tt.w); v1[3] += bf_hi(tt.w);
                    { f32x4 p0 = (f32x4){v0[0] + v0[1], v0[0] - v0[1], v0[2] + v0[3], v0[2] - v0[3]}, p1 = (f32x4){v1[0] + v1[1], v1[0] - v1[1], v1[2] + v1[3], v1[2] - v1[3]};
                      f32x4 r0 = (f32x4){p0[0] + p0[2], p0[1] + p0[3], p0[0] - p0[2], p0[1] - p0[3]}, r1 = (f32x4){p1[0] + p1[2], p1[1] + p1[3], p1[0] - p1[2], p1[1] - p1[3]};
                      v0 = r0 + r1; v1 = r0 - r1; }
                    w[g][bj].x = q8x4(v0[0], v0[1], v0[2], v0[3], qm); w[g][bj].y = q8x4(v1[0], v1[1], v1[2], v1[3], qm); }
                asm volatile("" : "+v"(w[g][0]), "+v"(w[g][1])); } }
        asm volatile("" ::: "memory");
#pragma unroll
        for (int g = 0; g < 8; ++g) { unsigned char* op = O + (size_t)(row0 + (g >> 2) * HALF + (g & 3) * 16) * 4096 + u.pn * BM + wc * 64 + 16 * fq; *(u32x4*)op = (u32x4){w[g][0].x, w[g][0].y, w[g][1].x, w[g][1].y}; }
    }
};
struct EpiRes {
    static constexpr bool PERM = true, AFTER_DRAIN = false, IDEMP = false;
    bf16_t* XB; float* P; unsigned char* X8; const float* SXN; const PG8_LAS float* rq; int pm0; float dsc;
    __device__ __forceinline__ void operator()(const f32x4 (&acc)[2][2][4][2], const Unit& u, int wr, int wc, int fr_in, int fq_in) const {
        int fr = fr_in, fq = fq_in; asm volatile("" : "+v"(fr), "+v"(fq));
        const int row0 = u.pm * BM + wr * 64 + fr, col0 = u.pn * BM + wc * 64 + 8 * fq;
        u32x4 xl[8][2], w[8][2]; u32x2 w8[8][2]; float ssv[8];
#pragma unroll
        for (int g = 0; g < 8; ++g) { const bf16_t* xp = XB + (size_t)(row0 + (g >> 2) * HALF + (g & 3) * 16) * 4096 + col0; xl[g][0] = *(const u32x4*)xp; xl[g][1] = *(const u32x4*)(xp + 32); }
#pragma unroll
        for (int g = 0; g < 8; ++g) { const int ai = g >> 2, m = g & 3; float ss = 0.f; const float qg = (u.pm == pm0) ? rq[ai * HALF + wr * 64 + m * 16 + fr] : SXN[row0 + ai * HALF + m * 16];
#pragma unroll
            for (int bj = 0; bj < 2; ++bj) { const u32x4 xx = xl[g][bj]; const i32x4 ia = __builtin_bit_cast(i32x4, acc[ai][bj][m][0]), ib = __builtin_bit_cast(i32x4, acc[ai][bj][m][1]);
                const f32x4 a = (f32x4){(float)ia[0], (float)ia[1], (float)ia[2], (float)ia[3]} * dsc, b = (f32x4){(float)ib[0], (float)ib[1], (float)ib[2], (float)ib[3]} * dsc;
                u32x4 o; o.x = cvt_pk_bf16(bf_lo(xx.x) + a[0], bf_hi(xx.x) + a[1]); o.y = cvt_pk_bf16(bf_lo(xx.y) + a[2], bf_hi(xx.y) + a[3]); o.z = cvt_pk_bf16(bf_lo(xx.z) + b[0], bf_hi(xx.z) + b[1]); o.w = cvt_pk_bf16(bf_lo(xx.w) + b[2], bf_hi(xx.w) + b[3]);
                w[g][bj] = o;
                const float r0 = bf_lo(o.x), r1 = bf_hi(o.x), r2 = bf_lo(o.y), r3 = bf_hi(o.y), r4 = bf_lo(o.z), r5 = bf_hi(o.z), r6 = bf_lo(o.w), r7 = bf_hi(o.w);
                w8[g][bj].x = q8x4(r0, r1, r2, r3, qg); w8[g][bj].y = q8x4(r4, r5, r6, r7, qg);
                ss += ((r0 * r0 + r1 * r1) + (r2 * r2 + r3 * r3)) + ((r4 * r4 + r5 * r5) + (r6 * r6 + r7 * r7)); }
            ss += shx(ss, fr + 16 * fq, 16); ss += shx(ss, fr + 16 * fq, 32); ssv[g] = ss;
            asm volatile("" : "+v"(w[g][0]), "+v"(w[g][1]), "+v"(ssv[g]), "+v"(w8[g][0]), "+v"(w8[g][1])); }
        asm volatile("" ::: "memory");
#pragma unroll
        for (int g = 0; g < 8; ++g) { const int row = row0 + (g >> 2) * HALF + (g & 3) * 16; bf16_t* xp = XB + (size_t)row * 4096 + col0; *(u32x4*)xp = w[g][0]; *(u32x4*)(xp + 32) = w[g][1];
            unsigned char* x8 = X8 + (size_t)row * 4096 + u.pn * BM + wc * 64 + 16 * fq; *(u32x4*)x8 = (u32x4){w8[g][0].x, w8[g][0].y, w8[g][1].x, w8[g][1].y};
            if (fq == 0) P[(size_t)row * 64 + u.pn * 4 + wc] = ssv[g]; }
    }
};

__device__ __forceinline__ f32x4 zero4() { f32x4 z; asm volatile("v_mov_b32 %0, 0\n\tv_mov_b32 %1, 0\n\tv_mov_b32 %2, 0\n\tv_mov_b32 %3, 0" : "=v"(z[0]), "=v"(z[1]), "=v"(z[2]), "=v"(z[3])); return z; }
template <class Epi, class Sched, bool ALIGN_EPI = false, bool SP2 = false, bool F8 = false, bool BAL = false, bool I8 = false>
__device__ __forceinline__ void gemm_phase(PG8_LAS unsigned char* lds, const Gemm g, const Sched& S, const Epi& E, const int tid_in) {
    const int tid = tid_in, wid = __builtin_amdgcn_readfirstlane(tid >> 6), lane = tid & 63, wr = wid >> 2, wc = wid & 3, fr = lane & 15, fq = lane >> 4;
    const int K = g.K, nt = K / BK;
    unsigned voffA[2], voffB[2];
#pragma unroll
    for (int i = 0; i < 2; ++i) { int R, C; stage_rc(tid * 16 + i * 8192, R, C); const int Rb = (R >> 5) * 64 + (Epi::PERM ? perm32(R & 31) : (R & 31));
        voffA[i] = (unsigned)(R * K + C) * 2u; voffB[i] = (unsigned)(Rb * K + C) * 2u; }
    const unsigned kstep = (unsigned)(BK * 2);
    const unsigned hstep = (unsigned)HALF * (unsigned)K * 2u;
    const unsigned hstepB = 32u * (unsigned)K * 2u;
    const unsigned tstep = 2u * hstep;
    const unsigned ldsw = (unsigned)wid * 1024u;
    const int aoff = lds_byte(wr * 64 + fr, fq * 8), boff = lds_byte(wc * 32 + fr, fq * 8);
#define PG8_SA(b, h) (((b) * 2 + (h)) * HTB)
#define PG8_SB(b, h) ((4 + (b) * 2 + (h)) * HTB)
#define PG8_STAGE(bufoff, rs, gbase, voff) do { _Pragma("unroll") for (int _i = 0; _i < 2; ++_i) \
        __builtin_amdgcn_raw_ptr_buffer_load_lds(rs, (PG8_LAS void*)(lds + (bufoff) + ldsw + _i * 8192), 16, (int)(voff)[_i], (int)(gbase), 0, 0); } while (0)
#define PG8_STAGE_A(bufoff, gbase, voff) PG8_STAGE(bufoff, rsA, gbase, voff)
#define PG8_STAGE_B(bufoff, gbase, voff) PG8_STAGE(bufoff, rsB, gbase, voff)
#define PG8_LDA(dst, b, h) do { _Pragma("unroll") for (int m = 0; m < 4; ++m) _Pragma("unroll") for (int k = 0; k < 2; ++k) dst[m][k] = *(const PG8_LAS bf16x8*)(lds + PG8_SA(b, h) + aoff + m * 2048 + k * 1024); } while (0)
#define PG8_LDB(dst, b, h) do { _Pragma("unroll") for (int n = 0; n < 2; ++n) _Pragma("unroll") for (int k = 0; k < 2; ++k) dst[n][k] = *(const PG8_LAS bf16x8*)(lds + PG8_SB(b, h) + boff + n * 2048 + k * 1024); } while (0)
#define PG8_MMA(ai, bj, At, Bt) do { __builtin_amdgcn_s_setprio(1); if constexpr (I8) { \
          \
        _Pragma("unroll") for (int m = 0; m < 4; ++m) _Pragma("unroll") for (int n = 0; n < 2; ++n) _Pragma("unroll") for (int k = 0; k < 2; ++k) { \
            const i32x4 b_ = __builtin_bit_cast(i32x4, Bt[n][k]), a_ = __builtin_bit_cast(i32x4, At[m][k]); \
            asm volatile("v_mfma_i32_16x16x64_i8 %0, %1, %2, %0" : "+v"(acc[ai][bj][m][n]) : "v"(b_), "v"(a_)); } } else if constexpr (!F8) { _Pragma("unroll") for (int m = 0; m < 4; ++m) _Pragma("unroll") for (int n = 0; n < 2; ++n) _Pragma("unroll") for (int k = 0; k < 2; ++k) \
        acc[ai][bj][m][n] = __builtin_amdgcn_mfma_f32_16x16x32_bf16(Bt[n][k], At[m][k], acc[ai][bj][m][n], 0, 0, 0); } else { \
          \
          \
        _Pragma("unroll") for (int m = 0; m < 4; ++m) _Pragma("unroll") for (int n = 0; n < 2; ++n) { \
            const i32x4 b0_ = __builtin_bit_cast(i32x4, Bt[n][0]), b1_ = __builtin_bit_cast(i32x4, Bt[n][1]), a0_ = __builtin_bit_cast(i32x4, At[m][0]), a1_ = __builtin_bit_cast(i32x4, At[m][1]); \
            const i32x8 bb_ = __builtin_shufflevector(b0_, b1_, 0, 1, 2, 3, 4, 5, 6, 7), aa_ = __builtin_shufflevector(a0_, a1_, 0, 1, 2, 3, 4, 5, 6, 7); \
            asm volatile("v_mfma_f32_16x16x128_f8f6f4 %0, %1, %2, %0" : "+v"(acc[ai][bj][m][n]) : "v"(bb_), "v"(aa_)); } } \
        __builtin_amdgcn_s_setprio(0); } while (0)
#define PG8_WAIT_V(n) asm volatile("s_waitcnt vmcnt(" #n ")" ::: "memory")
#define PG8_WAIT_L(n) asm volatile("s_waitcnt lgkmcnt(" #n ")" ::: "memory")
#define PG8_BAR __builtin_amdgcn_s_barrier()
#define PG8_SCHED __builtin_amdgcn_sched_barrier(0)
    Unit cur, nxt; int ui = 0;
    if (!S.next(0, cur)) return;
    f32x4 acc[2][2][4][2];
#pragma unroll
    for (int a = 0; a < 2; ++a)
#pragma unroll
        for (int b = 0; b < 2; ++b)
#pragma unroll
            for (int m = 0; m < 4; ++m)
#pragma unroll
                for (int n = 0; n < 2; ++n) acc[a][b][m][n] = zero4();
    bf16x8 At[4][2], B0[2][2], B1[2][2];
    unsigned cA = (unsigned)cur.pm * tstep, cB = (unsigned)cur.pn * tstep;
    const __amdgpu_buffer_rsrc_t rsA = __builtin_amdgcn_make_buffer_rsrc((void*)g.A, 0, (int)((unsigned)g.M * (unsigned)K * 2u), 0x00020000), rsB = __builtin_amdgcn_make_buffer_rsrc((void*)g.Bt, 0, (int)((unsigned)g.N * (unsigned)K * 2u), 0x00020000);
    S.a_ready(cur);
    if constexpr (SP2) {
        PG8_STAGE_B(PG8_SB(0, 0), cB, voffB); PG8_STAGE_B(PG8_SB(0, 1), cB + hstepB, voffB); PG8_STAGE_A(PG8_SA(0, 0), cA, voffA); PG8_STAGE_A(PG8_SA(0, 1), cA + hstep, voffA);
        if (wr == 1) PG8_BAR;
        PG8_WAIT_V(2); PG8_BAR;
        if constexpr (BAL) { PG8_STAGE_B(PG8_SB(1, 0), cB + kstep, voffB); PG8_STAGE_B(PG8_SB(1, 1), cB + hstepB + kstep, voffB); PG8_WAIT_V(4); PG8_BAR; }
        else {
        PG8_STAGE_B(PG8_SB(1, 0), cB + kstep, voffB); PG8_STAGE_A(PG8_SA(1, 0), cA + kstep, voffA); PG8_STAGE_B(PG8_SB(1, 1), cB + hstepB + kstep, voffB);
        PG8_WAIT_V(6); PG8_BAR;
        }
    } else {
        PG8_STAGE_B(PG8_SB(0, 0), cB, voffB); PG8_STAGE_A(PG8_SA(0, 0), cA, voffA); PG8_STAGE_B(PG8_SB(0, 1), cB + hstepB, voffB); PG8_STAGE_A(PG8_SA(0, 1), cA + hstep, voffA);
        if (wr == 1) PG8_BAR;
        PG8_WAIT_V(4); PG8_BAR;
        PG8_STAGE_B(PG8_SB(1, 0), cB + kstep, voffB); PG8_STAGE_A(PG8_SA(1, 0), cA + kstep, voffA); PG8_STAGE_B(PG8_SB(1, 1), cB + hstepB + kstep, voffB);
        PG8_WAIT_V(6); PG8_BAR;
    }
    for (;;) {
        const bool has_next = S.next(ui + 1, nxt);
        const unsigned nA = has_next ? (unsigned)nxt.pm * tstep : cA, nB = has_next ? (unsigned)nxt.pn * tstep : cB;
        for (int t = 0; t < nt; t += 2) {
            const bool last = (t == nt - 2);
            const unsigned a1 = cA + (unsigned)(t + 1) * kstep;
            const unsigned a2 = last ? nA : cA + (unsigned)(t + 2) * kstep, b2 = last ? nB : cB + (unsigned)(t + 2) * kstep;
            const unsigned a3 = a2 + kstep, b3 = b2 + kstep;
            if (last && has_next) S.a_ready(nxt);
            if constexpr (SP2 && BAL) {
            PG8_LDB(B0, 0, 0); PG8_LDB(B1, 0, 1); PG8_SCHED; PG8_LDA(At, 0, 0); PG8_STAGE_A(PG8_SA(1, 0), a1, voffA); PG8_STAGE_A(PG8_SA(1, 1), a1 + hstep, voffA);
            PG8_WAIT_V(8); PG8_WAIT_L(0); PG8_BAR; PG8_MMA(0, 0, At, B0); PG8_MMA(0, 1, At, B1); PG8_BAR; PG8_SCHED;
            PG8_LDA(At, 0, 1); PG8_STAGE_B(PG8_SB(0, 0), b2, voffB); PG8_STAGE_B(PG8_SB(0, 1), b2 + hstepB, voffB);
            PG8_WAIT_V(6); PG8_WAIT_L(0); PG8_BAR; PG8_MMA(1, 0, At, B0); PG8_MMA(1, 1, At, B1); PG8_BAR; PG8_SCHED;
            PG8_LDB(B0, 1, 0); PG8_LDB(B1, 1, 1); PG8_SCHED; PG8_LDA(At, 1, 0); PG8_STAGE_A(PG8_SA(0, 0), a2, voffA); PG8_STAGE_A(PG8_SA(0, 1), a2 + hstep, voffA);
            PG8_WAIT_V(8); PG8_WAIT_L(0); PG8_BAR; PG8_MMA(0, 0, At, B0); PG8_MMA(0, 1, At, B1); PG8_BAR; PG8_SCHED;
            PG8_LDA(At, 1, 1); PG8_STAGE_B(PG8_SB(1, 0), b3, voffB); PG8_STAGE_B(PG8_SB(1, 1), b3 + hstepB, voffB);
            PG8_WAIT_V(6); PG8_WAIT_L(0); PG8_BAR; PG8_MMA(1, 0, At, B0); PG8_MMA(1, 1, At, B1); PG8_BAR; PG8_SCHED;
            } else if constexpr (SP2) {
            PG8_LDB(B0, 0, 0); PG8_LDB(B1, 0, 1); PG8_SCHED; PG8_LDA(At, 0, 0); PG8_STAGE_A(PG8_SA(1, 1), a1 + hstep, voffA);
            PG8_WAIT_V(8); PG8_WAIT_L(0); PG8_BAR; PG8_MMA(0, 0, At, B0); PG8_MMA(0, 1, At, B1); PG8_BAR; PG8_SCHED;
            PG8_LDA(At, 0, 1); PG8_STAGE_B(PG8_SB(0, 0), b2, voffB); PG8_STAGE_B(PG8_SB(0, 1), b2 + hstepB, voffB); PG8_STAGE_A(PG8_SA(0, 0), a2, voffA);
            PG8_WAIT_V(8); PG8_WAIT_L(0); PG8_BAR; PG8_MMA(1, 0, At, B0); PG8_MMA(1, 1, At, B1); PG8_BAR; PG8_SCHED;
            PG8_LDB(B0, 1, 0); PG8_LDB(B1, 1, 1); PG8_SCHED; PG8_LDA(At, 1, 0); PG8_STAGE_A(PG8_SA(0, 1), a2 + hstep, voffA);
            PG8_WAIT_V(8); PG8_WAIT_L(0); PG8_BAR; PG8_MMA(0, 0, At, B0); PG8_MMA(0, 1, At, B1); PG8_BAR; PG8_SCHED;
            PG8_LDA(At, 1, 1); PG8_STAGE_B(PG8_SB(1, 0), b3, voffB); PG8_STAGE_B(PG8_SB(1, 1), b3 + hstepB, voffB); PG8_STAGE_A(PG8_SA(1, 0), a3, voffA);
            PG8_WAIT_V(8); PG8_WAIT_L(0); PG8_BAR; PG8_MMA(1, 0, At, B0); PG8_MMA(1, 1, At, B1); PG8_BAR; PG8_SCHED;
            } else {
            PG8_LDB(B0, 0, 0); PG8_SCHED; PG8_LDA(At, 0, 0); PG8_STAGE_A(PG8_SA(1, 1), a1 + hstep, voffA);
            PG8_WAIT_L(8); PG8_BAR; PG8_WAIT_L(0); PG8_MMA(0, 0, At, B0); PG8_BAR; PG8_SCHED;
            PG8_LDB(B1, 0, 1); PG8_STAGE_B(PG8_SB(0, 0), b2, voffB);
            PG8_BAR; PG8_WAIT_L(0); PG8_MMA(0, 1, At, B1); PG8_BAR;
            PG8_LDA(At, 0, 1); PG8_STAGE_A(PG8_SA(0, 0), a2, voffA);
            PG8_BAR; PG8_WAIT_L(0); PG8_MMA(1, 0, At, B0); PG8_BAR; PG8_SCHED;
            PG8_STAGE_B(PG8_SB(0, 1), b2 + hstepB, voffB);
            PG8_WAIT_V(6); PG8_BAR; PG8_MMA(1, 1, At, B1); PG8_BAR;
            PG8_LDB(B0, 1, 0); PG8_SCHED; PG8_LDA(At, 1, 0); PG8_STAGE_A(PG8_SA(0, 1), a2 + hstep, voffA);
            PG8_WAIT_L(8); PG8_BAR; PG8_WAIT_L(0); PG8_MMA(0, 0, At, B0); PG8_BAR; PG8_SCHED;
            PG8_LDB(B1, 1, 1); PG8_STAGE_B(PG8_SB(1, 0), b3, voffB);
            PG8_BAR; PG8_WAIT_L(0); PG8_MMA(0, 1, At, B1); PG8_BAR;
            PG8_LDA(At, 1, 1); PG8_STAGE_A(PG8_SA(1, 0), a3, voffA);
            PG8_BAR; PG8_WAIT_L(0); PG8_MMA(1, 0, At, B0); PG8_BAR; PG8_SCHED;
            PG8_STAGE_B(PG8_SB(1, 1), b3 + hstepB, voffB);
            PG8_WAIT_V(6); PG8_BAR; PG8_MMA(1, 1, At, B1); PG8_BAR;
            }
        }
        if constexpr (F8 || I8) asm volatile("s_nop 15\n\ts_nop 15" ::: "memory");
        if constexpr (ALIGN_EPI) { if (wr == 0) PG8_BAR; }
        if constexpr (!Epi::AFTER_DRAIN) { int tl_ = tid; asm volatile("" : "+v"(tl_)); E(acc, cur, wr, wc, tl_ & 15, (tl_ >> 4) & 3); S.done(cur); }
        if (!has_next) break;
#pragma unroll
        for (int a = 0; a < 2; ++a)
#pragma unroll
            for (int b = 0; b < 2; ++b)
#pragma unroll
                for (int m = 0; m < 4; ++m)
#pragma unroll
                    for (int n = 0; n < 2; ++n) acc[a][b][m][n] = zero4();
        cur = nxt; cA = nA; cB = nB; ++ui;
        if constexpr (ALIGN_EPI) { if (wr == 1) PG8_BAR; }
    }
    PG8_WAIT_V(0);
    if constexpr (!ALIGN_EPI) { if (wr == 0) PG8_BAR; }
    PG8_BAR;
    if constexpr (Epi::AFTER_DRAIN) { E.fused(acc, cur, wr, wc, fr, fq, lds, wid, lane); S.done(cur); }
#undef PG8_SA
#undef PG8_SB
#undef PG8_STAGE
#undef PG8_STAGE_A
#undef PG8_STAGE_B
#undef PG8_LDA
#undef PG8_LDB
#undef PG8_MMA
#undef PG8_WAIT_V
#undef PG8_WAIT_L
#undef PG8_BAR
#undef PG8_SCHED
}
}
constexpr int NWAVES = 8;
#ifndef MK_PER_PHASE
#define MK_PER_PHASE 0
#endif
constexpr int D = 4096, BATCH = 4, SEQ = 4096, M = BATCH * SEQ, DEPTH = 4, IN_W = 19472, NZ = 19456;
constexpr int OFF_GQ = 0, OFF_GK = 1024, OFF_GV = 2048, OFF_GG = 4096, OFF_SQ = 6144, OFF_SK = 8192, OFF_SV = 8704, OFF_SG = 9216, OFF_GA = 11264, OFF_GB = 15360;
constexpr int LDZ = NZ;
#ifndef NZ_BF_COLS
#define NZ_BF_COLS 3072
#endif
constexpr int NZ_BF = NZ_BF_COLS, NZ_F8 = NZ - NZ_BF;
constexpr float QC_W = 4.0f, QC_X0 = 4.25f, QC_XP = 4.5f, QC_M = 4.3f;
constexpr float W8_SCALE = 64.0f, AB8_SCALE = 8.0f;
constexpr float RMS_EPS = 1e-6f;
constexpr int N_PHASES = 2 + 6 * DEPTH;
constexpr size_t MiB = 1u << 20;
constexpr size_t WS_CTL = 0, CTL_ZERO_BYTES = 1 * MiB;
constexpr size_t WS_WIN = 1 * MiB, WS_WDEC = 609 * MiB, WS_WGLA = 610 * MiB, WS_WSWA = 674 * MiB, WS_WOUT = 738 * MiB;
constexpr size_t WS_XRES = 866 * MiB, WS_XB = 1122 * MiB, WS_Z = 1250 * MiB, WS_GDEC = 1858 * MiB;
constexpr size_t WS_QT = 1859 * MiB, WS_KT = 1891 * MiB, WS_QI = 1923 * MiB, WS_U = 1955 * MiB, WS_SP = 2083 * MiB, WS_DECAY = 2211 * MiB;
constexpr size_t WS_AA = 2212 * MiB, WS_AB = 2276 * MiB, WS_TMP = 2340 * MiB, WS_MERGED = 2596 * MiB, WS_SSQP = 2724 * MiB, WS_X8 = 2936 * MiB, WS_SX = 3000 * MiB, WS_WIN8 = 3001 * MiB, WS_GT = 3321 * MiB, WS_END = 3577 * MiB;
static_assert(WS_WIN8 + (size_t)DEPTH * NZ_F8 * D <= WS_GT && WS_SSQP + 4 * MiB <= WS_X8, "int8 weight copies");
static_assert(WS_WIN + (size_t)DEPTH * NZ * D * 2 <= WS_WDEC && WS_Z + (size_t)M * NZ * 2 <= WS_GDEC && WS_XRES + (size_t)M * D * 4 <= WS_XB, "ws map");
constexpr int CW_TMO = 0, CW_BAR = 4096, CW_TS = 8192;
static_assert(CW_BAR + 3456 <= CW_TS && (size_t)(CW_TS + DEPTH * 256 * 8) * 4 <= CTL_ZERO_BYTES, "CTL map");
constexpr int RING_BYTES = 131072, LDSCTL_OFF = RING_BYTES, MISC_OFF = LDSCTL_OFF + 320, RS_OFF = LDSCTL_OFF + 1024, RS2_OFF = LDSCTL_OFF + 2048, WQ_OFF = LDSCTL_OFF + 3072, RS3_OFF = LDSCTL_OFF + 4096, MQ_OFF = LDSCTL_OFF + 3072 + 512, LDS_BYTES = 147456;

#define GAS __attribute__((address_space(1)))
#define LAS __attribute__((address_space(3)))
typedef unsigned short bf16;
typedef unsigned v4u __attribute__((ext_vector_type(4)));
typedef unsigned v2u __attribute__((ext_vector_type(2)));
typedef float f32x4 __attribute__((ext_vector_type(4)));
typedef short bf16x8 __attribute__((ext_vector_type(8)));
typedef short s16x4 __attribute__((ext_vector_type(4)));
typedef GAS unsigned gu32;
#define RLX_AGENT __ATOMIC_RELAXED, __HIP_MEMORY_SCOPE_AGENT
#define LDS_WAIT() asm volatile("s_waitcnt lgkmcnt(0)" ::: "memory")
__device__ __forceinline__ unsigned f2bf(float f) { unsigned u = __builtin_bit_cast(unsigned, f); return (u + 0x7fffu + ((u >> 16) & 1u)) >> 16; }
__device__ __forceinline__ unsigned pk2(float lo, float hi) { return pg8::cvt_pk_bf16(lo, hi); }
__device__ __forceinline__ float bf2f(unsigned short b) { return __uint_as_float(((unsigned)b) << 16); }
__device__ __forceinline__ float bflo(unsigned w) { return __uint_as_float(w << 16); }
__device__ __forceinline__ float bfhi(unsigned w) { return __uint_as_float(w & 0xffff0000u); }
#define MFMA16(a, b, c) __builtin_amdgcn_mfma_f32_16x16x32_bf16((a), (b), (c), 0, 0, 0)
__device__ __forceinline__ bf16x8 tr_frag(LAS unsigned char* base, int rs, int k0, int n0, int lane) {
    const int g = lane >> 4, q = (lane & 15) >> 2, p = lane & 3;
    LAS unsigned char* a = base + (k0 + 8 * g + q) * rs + (n0 + 4 * p) * 2;
    const s16x4 lo = __builtin_amdgcn_ds_read_tr16_b64_v4i16((LAS s16x4*)a);
    const s16x4 hi = __builtin_amdgcn_ds_read_tr16_b64_v4i16((LAS s16x4*)(a + 4 * rs));
    return (bf16x8){lo[0], lo[1], lo[2], lo[3], hi[0], hi[1], hi[2], hi[3]};
}
#define XB_TMO      128
#define XB_XCNT(j)  (256  + 64 * (j))
#define XB_XSUB(j)  (1280 + 64 * (j))
#define XB_XGEN(j)  (2304 + 64 * (j))
#define XB_TOP      3328
#define XB_TOPGEN   3392
#define XCD_BAR_WORDS 3456
#define XB_SPIN_CAP (1u << 18)

__device__ __forceinline__ unsigned xb_ld(unsigned* p)              { return __hip_atomic_load(p, __ATOMIC_RELAXED, __HIP_MEMORY_SCOPE_AGENT); }
__device__ __forceinline__ unsigned xb_add(unsigned* p, unsigned v) { return __hip_atomic_fetch_add(p, v, __ATOMIC_RELAXED, __HIP_MEMORY_SCOPE_AGENT); }
__device__ __forceinline__ unsigned xb_xcc_id() { return (unsigned)__builtin_amdgcn_s_getreg((3 << 11) | 20) & 0xFu; }
#define XB_SPIN(cond, bar) do { unsigned _sp = 0; while (cond) { __builtin_amdgcn_s_sleep(1); \
    if ((++_sp & 255u) == 0u) { if (xb_ld(&(bar)[XB_TMO])) break; if (_sp > XB_SPIN_CAP) { atomicAdd(&(bar)[XB_TMO], 1u); break; } } } } while (0)

struct XcdBarrier {
    unsigned* bar; unsigned x;
    volatile LAS unsigned* st;
};

__device__ __forceinline__ XcdBarrier xcd_barrier_post(unsigned* bar, volatile LAS unsigned* st) {
    XcdBarrier b; b.bar = bar; b.x = xb_xcc_id(); b.st = st;
    if (threadIdx.x == 0) (void)xb_add(&bar[XB_XCNT(b.x)], 1u);
    return b;
}
__device__ __forceinline__ void xcd_barrier_complete(unsigned* bar, unsigned x, unsigned& nloc, unsigned& nx) {
    const unsigned G = gridDim.x * gridDim.y * gridDim.z;
    unsigned sum, cnt, mine, sp = 0u;
    for (;;) {
        sum = 0u; cnt = 0u; mine = 0u;
#pragma unroll
        for (unsigned j = 0; j < 16; ++j) { const unsigned c = xb_ld(&bar[XB_XCNT(j)]); sum += c; cnt += (c > 0u) ? 1u : 0u; mine = (j == x) ? c : mine; }
        if (sum == G) break;
        __builtin_amdgcn_s_sleep(1);
        if ((++sp & 255u) == 0u) { if (xb_ld(&bar[XB_TMO])) break; if (sp > XB_SPIN_CAP) { atomicAdd(&bar[XB_TMO], 1u); break; } }
    }
    nloc = mine > 0u ? mine : 1u; nx = cnt > 0u ? cnt : 1u;
}

__device__ __forceinline__ void xcd_barrier(const XcdBarrier& b) {
    asm volatile("s_waitcnt vmcnt(0)" ::: "memory");
    __syncthreads();
    if (threadIdx.x == 0) {
        unsigned* bar = b.bar;
        __builtin_amdgcn_s_waitcnt(0);
        unsigned nloc = b.st[0], nx = b.st[1];
        if (nloc == 0u) { xcd_barrier_complete(bar, b.x, nloc, nx); b.st[0] = nloc; b.st[1] = nx; }
        const unsigned old = xb_add(&bar[XB_XSUB(b.x)], 1u);
        const unsigned gen = old / nloc;
        if (old + 1u == (gen + 1u) * nloc) {
            __builtin_amdgcn_fence(__ATOMIC_RELEASE, "agent");
            asm volatile("s_waitcnt vmcnt(0)" ::: "memory");
            const unsigned og = xb_add(&bar[XB_TOP], 1u);
            const unsigned tg = og / nx;
            if (og + 1u == (tg + 1u) * nx) xb_add(&bar[XB_TOPGEN], 1u);
            else XB_SPIN(xb_ld(&bar[XB_TOPGEN]) == tg, bar);
            __builtin_amdgcn_fence(__ATOMIC_ACQUIRE, "agent");
            xb_add(&bar[XB_XGEN(b.x)], 1u);
            asm volatile("s_waitcnt vmcnt(0)" ::: "memory");
        } else {
            XB_SPIN(xb_ld(&bar[XB_XGEN(b.x)]) == gen, bar);
            __builtin_amdgcn_fence(__ATOMIC_ACQUIRE, "agent");
            asm volatile("s_waitcnt vmcnt(0)" ::: "memory");
        }
    }
    __syncthreads();
}
struct Frame {
    LAS unsigned char* lds; volatile LAS unsigned* MISC; gu32* ctl; unsigned char* ws;
    int tid, lane, wave, G;
    const float *x, *norm_g, *w_in, *b_gates, *w_up, *b_dec, *gla_g, *sinks, *w_gla, *w_swa, *w_out, *fin_g; float* out;
};
__device__ __forceinline__ float wave_sum(float v, int lane_) {
#pragma unroll
    for (int o = 1; o < 64; o <<= 1) v += pg8::shx(v, lane_, o);
    return v;
}

__device__ __forceinline__ void p0_transpose_item(const float* W, size_t ldw, int scol, int K, bf16* WT, int drow, const float* gain, float scale, int mode  , LAS unsigned char* scr, int kb, int lane) {
    const bool f8 = mode != 0, had = mode == 3; if (mode == 3) mode = 2;
    const int k0 = 64 * kb, lr = lane >> 4, lc = lane & 15;
    f32x4 v[16];
#pragma unroll
    for (int i = 0; i < 16; ++i) v[i] = *(const GAS f32x4*)(W + (size_t)(k0 + 4 * i + lr) * ldw + scol + 4 * lc);
    if (had) {
#pragma unroll
        for (int i = 0; i < 16; ++i) {
#pragma unroll
            for (int e = 0; e < 4; ++e) { const float o = pg8::shx(v[i][e], lane, 16); v[i][e] = (lane & 16) ? o - v[i][e] : v[i][e] + o; }
#pragma unroll
            for (int e = 0; e < 4; ++e) { const float o = pg8::shx(v[i][e], lane, 32); v[i][e] = (lane & 32) ? o - v[i][e] : v[i][e] + o; } }
#pragma unroll
        for (int i = 0; i < 16; i += 2) { const f32x4 a = v[i] + v[i + 1], b = v[i] - v[i + 1]; v[i] = a; v[i + 1] = b; }
    }
#pragma unroll
    for (int i = 0; i < 16; ++i) { const float gk = gain ? gain[k0 + 4 * i + lr] * scale : scale; f32x4 a = v[i] * gk;
        v2u o;
        if (mode == 2) { unsigned u[4];
            _Pragma("unroll") for (int e = 0; e < 4; ++e) u[e] = __float_as_uint(__builtin_amdgcn_fmed3f(__builtin_fmaf(v[i][e], gk, 12582912.0f), 12582912.0f - 127.0f, 12582912.0f + 127.0f));
            o.x = __builtin_amdgcn_perm(u[1], u[0], 0x05040100u); o.y = __builtin_amdgcn_perm(u[3], u[2], 0x05040100u); }
        else { o.x = pk2(a[0], a[1]); o.y = pk2(a[2], a[3]); }
        *(LAS v2u*)(scr + (4 * i + lr) * 144 + 8 * lc) = o; }
    LDS_WAIT(); asm volatile("" ::: "memory");
#pragma unroll
    for (int kh = 0; kh < 2; ++kh)
#pragma unroll
        for (int nq = 0; nq < 4; ++nq) { const bf16x8 t = tr_frag(scr, 144, 32 * kh, 16 * nq, lane);
            if (!f8) *(GAS bf16x8*)(WT + (size_t)(drow + 16 * nq + lc) * K + k0 + 32 * kh + 8 * lr) = t;
            else if (mode == 2) { const v4u tt = __builtin_bit_cast(v4u, t); v2u o; o.x = __builtin_amdgcn_perm(tt.y, tt.x, 0x06040200u); o.y = __builtin_amdgcn_perm(tt.w, tt.z, 0x06040200u);
                   *(GAS v2u*)((unsigned char*)WT + (size_t)(drow + 16 * nq + lc) * K + pg8::kperm8(k0 + 32 * kh + 8 * lr)) = o; }
            else { int q0 = __builtin_amdgcn_cvt_pk_fp8_f32(bf2f((unsigned short)t[0]), bf2f((unsigned short)t[1]), 0, false); q0 = __builtin_amdgcn_cvt_pk_fp8_f32(bf2f((unsigned short)t[2]), bf2f((unsigned short)t[3]), q0, true);
                   int q1 = __builtin_amdgcn_cvt_pk_fp8_f32(bf2f((unsigned short)t[4]), bf2f((unsigned short)t[5]), 0, false); q1 = __builtin_amdgcn_cvt_pk_fp8_f32(bf2f((unsigned short)t[6]), bf2f((unsigned short)t[7]), q1, true);
                   v2u o; o.x = (unsigned)q0; o.y = (unsigned)q1; *(GAS v2u*)((unsigned char*)WT + (size_t)(drow + 16 * nq + lc) * K + k0 + 32 * kh + 8 * lr) = o; } }
    LDS_WAIT(); asm volatile("" ::: "memory");
}
__device__ __forceinline__ void p0_prologue(Frame& F) {
    LAS unsigned char* scr = F.lds + F.wave * 16384;
    const int gw = blockIdx.x * NWAVES + F.wave, NGW = F.G * NWAVES;
    LAS float* wq = (LAS float*)(F.lds + WQ_OFF); LAS float* wred = (LAS float*)(F.lds + WQ_OFF + 64);
    for (int l = 0; l < DEPTH; ++l) { float s = 0.f;
#pragma unroll 4
        for (int j = 0; j < 16; ++j) { const int k = 256 * j; const float gk = F.norm_g[l * D + k]; const float a = F.w_in[((size_t)l * D + k) * IN_W + 8192 + 2 * F.tid] * gk, b = F.w_in[((size_t)l * D + k) * IN_W + 8192 + 2 * F.tid + 1] * gk; s += a * a + b * b; }
        s = wave_sum(s, F.lane); if (F.lane == 0) wred[l * 8 + F.wave] = s;
        float s2 = 0.f;
#pragma unroll 4
        for (int j = 0; j < 16; ++j) { const float a = F.w_out[((size_t)l * D + 256 * j) * D + 2 * F.tid], b = F.w_out[((size_t)l * D + 256 * j) * D + 2 * F.tid + 1]; s2 += a * a + b * b; }
        s2 = wave_sum(s2, F.lane); if (F.lane == 0) wred[(DEPTH + l) * 8 + F.wave] = s2; }
    __syncthreads();
    if (F.tid < 2 * DEPTH) { float s = 0.f;
#pragma unroll
        for (int w_ = 0; w_ < 8; ++w_) s += wred[F.tid * 8 + w_];
        const float q = 127.0f / QC_W * __builtin_amdgcn_rsqf(s * (1.0f / 16384.0f) + 1e-30f); wq[F.tid] = q; ((float*)(F.ws + WS_SX))[2 * M + F.tid] = q; }
    __syncthreads();
    constexpr int I_IN = 64 * 304, I_GLA = 32 * 64, I_OUT = 64 * 64, I_L = I_IN + 2 * I_GLA + I_OUT;
    for (int it = gw; it < DEPTH * I_L; it += NGW) {
        const int l = it / I_L; int r = it - l * I_L;
        if (r < I_IN) { const int kb = r / 304, nb = r - kb * 304; const int scol = nb < 96 ? nb * 64 : nb * 64 + 16;
            if (nb < NZ_BF / 64) p0_transpose_item(F.w_in + (size_t)l * D * IN_W, IN_W, scol, D, (bf16*)(F.ws + WS_WIN) + (size_t)l * NZ * D, nb * 64, F.norm_g + l * D, 1.0f, 0, scr, kb, F.lane);
            else p0_transpose_item(F.w_in + (size_t)l * D * IN_W, IN_W, scol, D, (bf16*)(F.ws + WS_WIN8 + (size_t)l * NZ_F8 * D), nb * 64 - NZ_BF, F.norm_g + l * D, wq[l], 2, scr, kb, F.lane);
            continue; }
        r -= I_IN;
        if (r < I_GLA) { const int kb = r >> 6, nb = r & 63; p0_transpose_item(F.w_gla + (size_t)l * 2048 * D, D, nb * 64, 2048, (bf16*)(F.ws + WS_WGLA) + (size_t)l * D * 2048, nb * 64, nullptr, 1.0f, 0, scr, kb, F.lane); continue; }
        r -= I_GLA;
        if (r < I_GLA) { const int kb = r >> 6, nb = r & 63; p0_transpose_item(F.w_swa + (size_t)l * 2048 * D, D, nb * 64, 2048, (bf16*)(F.ws + WS_WSWA + (size_t)l * D * 2048), nb * 64, nullptr, W8_SCALE, 1, scr, kb, F.lane); continue; }
        r -= I_GLA;
        { const int kb = r >> 6, nb = r & 63; p0_transpose_item(F.w_out + (size_t)l * D * D, D, nb * 64, D, (bf16*)(F.ws + WS_WOUT + (size_t)l * D * D), nb * 64, nullptr, wq[DEPTH + l] * 0.35355339f, 3, scr, kb, F.lane); }
    }
    for (int idx = blockIdx.x * (NWAVES * 64) + F.tid; idx < DEPTH * 16 * D; idx += F.G * NWAVES * 64) {
        const int l = idx >> 16, j = (idx >> 12) & 15, k = idx & 4095;
        ((bf16*)(F.ws + WS_WDEC))[idx] = (bf16)f2bf(F.norm_g[l * D + k] * F.w_in[((size_t)l * D + k) * IN_W + 6144 + j]);
    }
    float* ssqp = (float*)(F.ws + WS_SSQP); float* sx0 = (float*)(F.ws + WS_SX);
    for (int m = gw; m < M; m += NGW) {
        const GAS f32x4* xr = (const GAS f32x4*)(F.x + (size_t)m * D) + F.lane; GAS v2u* o8 = (GAS v2u*)((bf16*)(F.ws + WS_XB) + (size_t)m * D) + F.lane; GAS unsigned* q8 = (GAS unsigned*)(F.ws + WS_X8 + (size_t)m * D) + F.lane; float s = 0.f;
        v2u w[16];
#pragma unroll
        for (int j = 0; j < 16; ++j) { const f32x4 v = xr[64 * j]; w[j].x = pk2(v.x, v.y); w[j].y = pk2(v.z, v.w); o8[64 * j] = w[j];
            const float r0 = bflo(w[j].x), r1 = bfhi(w[j].x), r2 = bflo(w[j].y), r3 = bfhi(w[j].y); s += (r0 * r0 + r1 * r1) + (r2 * r2 + r3 * r3); }
        s = wave_sum(s, F.lane); ssqp[(size_t)m * 64 + F.lane] = (F.lane == 0) ? s : 0.f;
        const float q = 127.0f / QC_X0 * __builtin_amdgcn_rsqf(s * (1.0f / D) + RMS_EPS);
        if (F.lane == 0) sx0[m] = q;
#pragma unroll
        for (int j = 0; j < 16; ++j) { const int c = 4 * F.lane + 256 * j; *(GAS unsigned*)(F.ws + WS_X8 + (size_t)m * D + pg8::kperm8(c & ~7) + (c & 7)) = pg8::q8x4(bflo(w[j].x), bfhi(w[j].x), bflo(w[j].y), bfhi(w[j].y), q); }
    }
}
__device__ __forceinline__ void final_norm(Frame& F) {
    const int gw = blockIdx.x * NWAVES + F.wave, NGW = F.G * NWAVES;
    const bf16* X = (const bf16*)(F.ws + WS_XB);
    for (int m = gw; m < M; m += NGW) {
        const GAS v4u* xr = (const GAS v4u*)(X + (size_t)m * D) + F.lane; const GAS f32x4* gr = (const GAS f32x4*)F.fin_g + 2 * F.lane; GAS f32x4* orow = (GAS f32x4*)(F.out + (size_t)m * D) + 2 * F.lane;
        v4u v[8]; float s = 0.f;
#pragma unroll
        for (int j = 0; j < 8; ++j) { v[j] = xr[64 * j]; const float r0 = bflo(v[j].x), r1 = bfhi(v[j].x), r2 = bflo(v[j].y), r3 = bfhi(v[j].y), r4 = bflo(v[j].z), r5 = bfhi(v[j].z), r6 = bflo(v[j].w), r7 = bfhi(v[j].w);
            s += ((r0 * r0 + r1 * r1) + (r2 * r2 + r3 * r3)) + ((r4 * r4 + r5 * r5) + (r6 * r6 + r7 * r7)); }
        const float rs = __builtin_amdgcn_rsqf(wave_sum(s, F.lane) * (1.0f / D) + RMS_EPS);
#pragma unroll
        for (int j = 0; j < 8; ++j) { const f32x4 g0 = gr[128 * j], g1 = gr[128 * j + 1];
            orow[128 * j] = (f32x4){bflo(v[j].x) * rs * g0[0], bfhi(v[j].x) * rs * g0[1], bflo(v[j].y) * rs * g0[2], bfhi(v[j].y) * rs * g0[3]};
            orow[128 * j + 1] = (f32x4){bflo(v[j].z) * rs * g1[0], bfhi(v[j].z) * rs * g1[1], bflo(v[j].w) * rs * g1[2], bfhi(v[j].w) * rs * g1[3]}; }
    }
}
__device__ __forceinline__ void gdec_phase(Frame& F, int l) {
    LAS float* red = (LAS float*)F.lds;
    const bf16* Wd = (const bf16*)(F.ws + WS_WDEC) + (size_t)l * 16 * D; const bf16* XBp = (const bf16*)(F.ws + WS_XB); const float* ssqp = (const float*)(F.ws + WS_SSQP); float* GD = (float*)(F.ws + WS_GDEC);
    const int lane = F.lane, fr = lane & 15, fq = lane >> 4;
    for (int rb = blockIdx.x; rb < M / 64; rb += F.G) {
        const int r0 = (F.G == 256) ? ((8 * (rb & 7) + ((rb >> 3) & 7)) * 256 + (rb >> 6) * 64) : rb * 64, k0 = F.wave * 512;
        f32x4 acc[4];
#pragma unroll
        for (int rt = 0; rt < 4; ++rt) acc[rt] = (f32x4){0.f, 0.f, 0.f, 0.f};
#pragma unroll 4
        for (int ks = 0; ks < 16; ++ks) { const int k = k0 + ks * 32 + 8 * fq;
            const bf16x8 X = *(const GAS bf16x8*)(Wd + (size_t)fr * D + k);
#pragma unroll
            for (int rt = 0; rt < 4; ++rt) { const bf16x8 Y = *(const GAS bf16x8*)(XBp + (size_t)(r0 + rt * 16 + fr) * D + k); acc[rt] = MFMA16(X, Y, acc[rt]); } }
#pragma unroll
        for (int rt = 0; rt < 4; ++rt) *(LAS f32x4*)(red + ((F.wave * 4 + rt) * 64 + lane) * 4) = acc[rt];
        __syncthreads();
        if (F.tid < 256) { const int rt = F.tid >> 6, ln = F.tid & 63; f32x4 s = (f32x4){0.f, 0.f, 0.f, 0.f};
#pragma unroll
            for (int w = 0; w < 8; ++w) s += *(LAS f32x4*)(red + ((w * 4 + rt) * 64 + ln) * 4);
            const int row = r0 + rt * 16 + (ln & 15); const float rs = pg8::row_rstd(ssqp, row);
            *(GAS f32x4*)(GD + (size_t)row * 16 + 4 * (ln >> 4)) = s * rs; }
        __syncthreads();
    }
}
constexpr int NGROUP = BATCH * 8 * 8;
constexpr int GA_GD = 0, GA_BL = 4096, GA_KS = GA_BL + 64 * 528, GA_V = GA_KS + 64 * 272, GA_SEG = GA_V + 64 * 528, GA_BRL = GA_SEG + 2048, GA_EB = GA_BRL + 1024, GA_EL = GA_EB + 512, GA_END = GA_EL + 512;
static_assert(GA_END <= RING_BYTES, "GLA-a LDS map");
__device__ __forceinline__ void gla_a_phase(Frame& F, int l) {
    LAS unsigned char* lds = F.lds;
    LAS float* gd = (LAS float*)(lds + GA_GD); LAS float* bL = (LAS float*)(lds + GA_BL); LAS unsigned char* ksL = lds + GA_KS; LAS unsigned char* Vl = lds + GA_V; LAS float* seg = (LAS float*)(lds + GA_SEG); LAS float* brl = (LAS float*)(lds + GA_BRL); LAS float* ebL = (LAS float*)(lds + GA_EB); LAS float* elL = (LAS float*)(lds + GA_EL);
    const int tid = F.tid, lane = F.lane, w = F.wave, d = tid & 127, tq = tid >> 7, fr = lane & 15, fq = lane >> 4;
    const bf16* Z = (const bf16*)(F.ws + WS_Z); const float* GD = (const float*)(F.ws + WS_GDEC);
    bf16* QT = (bf16*)(F.ws + WS_QT); bf16* KT = (bf16*)(F.ws + WS_KT); bf16* SLOC = (bf16*)(F.ws + WS_U);
    float* EBREF = (float*)(F.ws + WS_QI); float* ELR = EBREF + (size_t)BATCH * 8 * 64 * 128; float* DG = ELR + (size_t)BATCH * 8 * 64 * 128;
    const float SC = 0.08838834764831845f;
    f32x4 pgd; v4u pv[4], pq[2], pk[2];
#define GA_FETCH(item_) do { const int n_ = (item_) & 63, h_ = ((item_) >> 6) & 7, b_ = (item_) >> 9, t0_ = b_ * SEQ + n_ * 64; \
        pgd = *(const GAS f32x4*)(GD + (size_t)t0_ * 16 + (tid & 255) * 4); \
        _Pragma("unroll") for (int i = 0; i < 4; ++i) { const int c = tid + 512 * i, t = c >> 5, dv0 = (c & 31) * 8; pv[i] = *(const GAS v4u*)(Z + (size_t)(t0_ + t) * LDZ + OFF_GV + h_ * 256 + dv0); } \
        _Pragma("unroll") for (int i = 0; i < 2; ++i) { const int id = tid + 512 * i, t = id >> 4, d0 = (id & 15) * 8; const size_t zr = (size_t)(t0_ + t) * LDZ + h_ * 128 + d0; pq[i] = *(const GAS v4u*)(Z + zr + OFF_GQ); pk[i] = *(const GAS v4u*)(Z + zr + OFF_GK); } } while (0)
    { const int g0_ = (int)blockIdx.x < NGROUP ? (int)blockIdx.x : NGROUP - 1; GA_FETCH((g0_ >> 3) * 64 + (g0_ & 7) * 8); }
    for (int gi = blockIdx.x; gi < NGROUP; gi += F.G) {
        const int bh = gi >> 3, g = gi & 7, h = bh & 7, b = bh >> 3;
        float wu[16];
#pragma unroll
        for (int r = 0; r < 16; ++r) wu[r] = F.w_up[(size_t)(l * 16 + r) * 1024 + h * 128 + d];
        const float bias = F.b_dec[l * 1024 + h * 128 + d];
        f32x4 acc[8][2];
#pragma unroll
        for (int i = 0; i < 8; ++i) { acc[i][0] = (f32x4){0.f, 0.f, 0.f, 0.f}; acc[i][1] = (f32x4){0.f, 0.f, 0.f, 0.f}; }
        float sumbl = 0.f;
#pragma unroll 1
        for (int j = 0; j < 8; ++j) {
            const int n = 8 * g + j, item = bh * 64 + n, t0 = b * SEQ + n * 64;
            if (tid < 256) *(LAS f32x4*)(gd + tid * 4) = pgd;
#pragma unroll
            for (int i = 0; i < 4; ++i) { const int c = tid + 512 * i, t = c >> 5, dv0 = (c & 31) * 8; *(LAS v4u*)(Vl + t * 528 + dv0 * 2) = pv[i]; }
            v4u q8[2], k8[2];
#pragma unroll
            for (int i = 0; i < 2; ++i) { q8[i] = pq[i]; k8[i] = pk[i]; }
            __syncthreads();
            { const int nx = (j < 7) ? item + 1 : ((gi + F.G) >> 3) * 64 + ((gi + F.G) & 7) * 8; if (j < 7 || gi + F.G < NGROUP) GA_FETCH(nx); }
            float c[16]; float run = 0.f;
#pragma unroll
            for (int i = 0; i < 16; ++i) { const int t = 16 * tq + i; float lg = bias; const f32x4 g0 = *(LAS f32x4*)(gd + t * 16), g1 = *(LAS f32x4*)(gd + t * 16 + 4), g2 = *(LAS f32x4*)(gd + t * 16 + 8), g3 = *(LAS f32x4*)(gd + t * 16 + 12);
                lg += g0[0] * wu[0] + g0[1] * wu[1] + g0[2] * wu[2] + g0[3] * wu[3]; lg += g1[0] * wu[4] + g1[1] * wu[5] + g1[2] * wu[6] + g1[3] * wu[7];
                lg += g2[0] * wu[8] + g2[1] * wu[9] + g2[2] * wu[10] + g2[3] * wu[11]; lg += g3[0] * wu[12] + g3[1] * wu[13] + g3[2] * wu[14] + g3[3] * wu[15];
                const float ls = fminf(lg, 0.f) - __logf(1.0f + __expf(-fabsf(lg))); const float la = fmaxf(ls * (1.0f / 16.0f), -1.0f); run += la; c[i] = run; }
            seg[tq * 128 + d] = run;
            __syncthreads();
            float pre = 0.f;
            if (tq > 0) pre += seg[d]; if (tq > 1) pre += seg[128 + d]; if (tq > 2) pre += seg[256 + d];
#pragma unroll
            for (int i = 0; i < 16; ++i) bL[(16 * tq + i) * 132 + d] = c[i] + pre;
            if (tq == 2) brl[d] = c[0] + pre;
            if (tq == 3) brl[128 + d] = c[15] + pre;
            __syncthreads();
            if (tid < 128) { const float bref = brl[tid], blast = brl[128 + tid], eb = __expf(bref), el = __expf(blast - bref); ebL[tid] = eb; elL[tid] = el; sumbl += blast;
                EBREF[(size_t)item * 128 + tid] = eb; ELR[(size_t)item * 128 + tid] = el; }
#pragma unroll
            for (int i = 0; i < 2; ++i) { const int id = tid + 512 * i, t = id >> 4, d0 = (id & 15) * 8;
                const f32x4 b0 = *(LAS f32x4*)(bL + t * 132 + d0), b1 = *(LAS f32x4*)(bL + t * 132 + d0 + 4), r0 = *(LAS f32x4*)(brl + d0), r1 = *(LAS f32x4*)(brl + d0 + 4);
                const float bb[8] = {b0[0], b0[1], b0[2], b0[3], b1[0], b1[1], b1[2], b1[3]}, rr[8] = {r0[0], r0[1], r0[2], r0[3], r1[0], r1[1], r1[2], r1[3]};
                const unsigned qw[4] = {q8[i].x, q8[i].y, q8[i].z, q8[i].w}, kw[4] = {k8[i].x, k8[i].y, k8[i].z, k8[i].w};
                float oq[8], ok[8];
#pragma unroll
                for (int jj = 0; jj < 8; ++jj) { const float q = ((jj & 1) ? bfhi(qw[jj >> 1]) : bflo(qw[jj >> 1])) * SC, k = (jj & 1) ? bfhi(kw[jj >> 1]) : bflo(kw[jj >> 1]);
                    const float e1 = __expf(bb[jj] - rr[jj]), e2 = __builtin_amdgcn_rcpf(e1);
                    oq[jj] = q * e1; ok[jj] = k * e2; }
                const size_t o = (size_t)(t0 + t) * 1024 + h * 128 + d0;
                v4u w4; w4.x = pk2(oq[0], oq[1]); w4.y = pk2(oq[2], oq[3]); w4.z = pk2(oq[4], oq[5]); w4.w = pk2(oq[6], oq[7]); *(GAS v4u*)(QT + o) = w4;
                w4.x = pk2(ok[0], ok[1]); w4.y = pk2(ok[2], ok[3]); w4.z = pk2(ok[4], ok[5]); w4.w = pk2(ok[6], ok[7]); *(GAS v4u*)(KT + o) = w4; *(LAS v4u*)(ksL + t * 272 + d0 * 2) = w4; }
            __syncthreads();
#pragma unroll
            for (int dkt = 0; dkt < 8; ++dkt) { const f32x4 e4 = *(LAS f32x4*)(ebL + dkt * 16 + 4 * fq); acc[dkt][0] *= e4; acc[dkt][1] *= e4; }
#pragma unroll
            for (int ks = 0; ks < 2; ++ks) { bf16x8 Y[2];
#pragma unroll
                for (int jv = 0; jv < 2; ++jv) Y[jv] = tr_frag(Vl, 528, ks * 32, (2 * w + jv) * 16, lane);
#pragma unroll
                for (int dkt = 0; dkt < 8; ++dkt) { const bf16x8 X = tr_frag(ksL, 272, ks * 32, dkt * 16, lane);
                    acc[dkt][0] = MFMA16(X, Y[0], acc[dkt][0]); acc[dkt][1] = MFMA16(X, Y[1], acc[dkt][1]); } }
#pragma unroll
            for (int dkt = 0; dkt < 8; ++dkt) { const f32x4 e4 = *(LAS f32x4*)(elL + dkt * 16 + 4 * fq); acc[dkt][0] *= e4; acc[dkt][1] *= e4; }
            __syncthreads();
        }
#pragma unroll
        for (int dkt = 0; dkt < 8; ++dkt)
#pragma unroll
            for (int jv = 0; jv < 2; ++jv) { const int dv = (2 * w + jv) * 16 + fr, dk = dkt * 16 + 4 * fq; const f32x4 a = acc[dkt][jv];
                v2u o; o.x = pk2(a[0], a[1]); o.y = pk2(a[2], a[3]); *(GAS v2u*)(SLOC + ((size_t)gi * 256 + dv) * 128 + dk) = o; }
        if (tid < 128) DG[(size_t)gi * 128 + tid] = __expf(sumbl);
    }
#undef GA_FETCH
}
__device__ __forceinline__ void gla_scan_phase(Frame& F) {
    const bf16* SLOC = (const bf16*)(F.ws + WS_U); bf16* SST = (bf16*)(F.ws + WS_SP); const float* DG = (const float*)(F.ws + WS_QI) + (size_t)2 * BATCH * 8 * 64 * 128;
    for (int idx = blockIdx.x * (NWAVES * 64) + F.tid; idx < BATCH * 8 * 256 * 16; idx += F.G * NWAVES * 64) {
        const int bh = idx >> 12, dv = (idx >> 4) & 255, dk0 = (idx & 15) * 8;
        float S[8]; float z0_; asm volatile("v_mov_b32 %0, 0" : "=v"(z0_));
#pragma unroll
        for (int j = 0; j < 8; ++j) S[j] = z0_;
#pragma unroll
        for (int g = 0; g < 8; ++g) { const size_t gi = (size_t)bh * 8 + g, off = (gi * 256 + dv) * 128 + dk0;
            const v4u u = *(const GAS v4u*)(SLOC + off); const f32x4 d0 = *(const GAS f32x4*)(DG + gi * 128 + dk0), d1 = *(const GAS f32x4*)(DG + gi * 128 + dk0 + 4);
            v4u o; o.x = pk2(S[0], S[1]); o.y = pk2(S[2], S[3]); o.z = pk2(S[4], S[5]); o.w = pk2(S[6], S[7]); *(GAS v4u*)(SST + off) = o;
            S[0] = d0[0] * S[0] + bflo(u.x); S[1] = d0[1] * S[1] + bfhi(u.x); S[2] = d0[2] * S[2] + bflo(u.y); S[3] = d0[3] * S[3] + bfhi(u.y);
            S[4] = d1[0] * S[4] + bflo(u.z); S[5] = d1[1] * S[5] + bfhi(u.z); S[6] = d1[2] * S[6] + bflo(u.w); S[7] = d1[3] * S[7] + bfhi(u.w); }
    }
}
constexpr int GC_QT = 0, GC_KT = 17408, GC_V = 34816, GC_AL = GC_V + 64 * 528, GC_PART = GC_AL + 64 * 144, GC_EB = GC_PART + 2048, GC_EL = GC_EB + 512, GC_END = GC_EL + 512;
static_assert(GC_END <= RING_BYTES, "GLA-c LDS map");
__device__ __forceinline__ void gla_c_phase(Frame& F, int l) {
    LAS unsigned char* lds = F.lds;
    LAS bf16* qT = (LAS bf16*)(lds + GC_QT); LAS bf16* kT = (LAS bf16*)(lds + GC_KT); LAS unsigned char* Vl = lds + GC_V; LAS bf16* Al = (LAS bf16*)(lds + GC_AL);
    LAS float* part = (LAS float*)(lds + GC_PART); LAS float* ebL = (LAS float*)(lds + GC_EB); LAS float* elL = (LAS float*)(lds + GC_EL);
    const int tid = F.tid, lane = F.lane, w = F.wave, fr = lane & 15, fq = lane >> 4;
    const bf16* Z = (const bf16*)(F.ws + WS_Z); const bf16* QT = (const bf16*)(F.ws + WS_QT); const bf16* KT = (const bf16*)(F.ws + WS_KT); const bf16* SST = (const bf16*)(F.ws + WS_SP);
    const float* EBREF = (const float*)(F.ws + WS_QI); const float* ELR = EBREF + (size_t)BATCH * 8 * 64 * 128;
    bf16* AA = (bf16*)(F.ws + WS_AA);
    v4u rq[2], rk[2], rv[4]; float reb, rel;
#define GC_FETCH(item_) do { const int n_ = (item_) & 63, h_ = ((item_) >> 6) & 7, b_ = (item_) >> 9, t0_ = b_ * SEQ + n_ * 64; \
        _Pragma("unroll") for (int i = 0; i < 2; ++i) { const int c = tid + 512 * i, t = c >> 4, d0 = (c & 15) * 8; const size_t g_ = (size_t)(t0_ + t) * 1024 + h_ * 128 + d0; rq[i] = *(const GAS v4u*)(QT + g_); rk[i] = *(const GAS v4u*)(KT + g_); } \
        _Pragma("unroll") for (int i = 0; i < 4; ++i) { const int c = tid + 512 * i, t = c >> 5, dv0 = (c & 31) * 8; rv[i] = *(const GAS v4u*)(Z + (size_t)(t0_ + t) * LDZ + OFF_GV + h_ * 256 + dv0); } \
        reb = EBREF[(size_t)(item_) * 128 + (tid & 127)]; rel = ELR[(size_t)(item_) * 128 + (tid & 127)]; } while (0)
    { const int g0_ = (int)blockIdx.x < NGROUP ? (int)blockIdx.x : NGROUP - 1; GC_FETCH((g0_ >> 3) * 64 + (g0_ & 7) * 8); }
    for (int gi = blockIdx.x; gi < NGROUP; gi += F.G) {
        const int bh = gi >> 3, g = gi & 7, h = bh & 7, b = bh >> 3;
        f32x4 Sa[8][2];
#pragma unroll
        for (int dkt = 0; dkt < 8; ++dkt)
#pragma unroll
            for (int jv = 0; jv < 2; ++jv) { const v2u s = *(const GAS v2u*)(SST + ((size_t)gi * 256 + (2 * w + jv) * 16 + fr) * 128 + dkt * 16 + 4 * fq); Sa[dkt][jv] = (f32x4){bflo(s.x), bfhi(s.x), bflo(s.y), bfhi(s.y)}; }
#pragma unroll 1
        for (int j = 0; j < 8; ++j) {
            const int n = 8 * g + j, item = bh * 64 + n, t0 = b * SEQ + n * 64;
#pragma unroll
            for (int i = 0; i < 2; ++i) { const int c = tid + 512 * i, t = c >> 4, d0 = (c & 15) * 8; *(LAS v4u*)(qT + t * 136 + d0) = rq[i]; *(LAS v4u*)(kT + t * 136 + d0) = rk[i]; }
#pragma unroll
            for (int i = 0; i < 4; ++i) { const int c = tid + 512 * i, t = c >> 5, dv0 = (c & 31) * 8; *(LAS v4u*)(Vl + t * 528 + dv0 * 2) = rv[i]; }
            if (tid < 128) { ebL[tid] = reb; elL[tid] = rel; }
            __syncthreads();
            { const int nx = (j < 7) ? item + 1 : ((gi + F.G) >> 3) * 64 + ((gi + F.G) & 7) * 8; if (j < 7 || gi + F.G < NGROUP) GC_FETCH(nx); }
            { const int it = w >> 1;
#pragma unroll
              for (int jj = 0; jj < 2; ++jj) { const int jt = 2 * (w & 1) + jj; f32x4 a = (f32x4){0.f, 0.f, 0.f, 0.f};
                  if (jt <= it) {
#pragma unroll
                      for (int ks = 0; ks < 4; ++ks) { const bf16x8 X = *(LAS bf16x8*)(kT + (jt * 16 + fr) * 136 + ks * 32 + 8 * fq); const bf16x8 Y = *(LAS bf16x8*)(qT + (it * 16 + fr) * 136 + ks * 32 + 8 * fq); a = MFMA16(X, Y, a); }
                      const int ii = it * 16 + fr, j0 = jt * 16 + 4 * fq;
#pragma unroll
                      for (int e = 0; e < 4; ++e) if (j0 + e > ii) a[e] = 0.f;
                  }
                  v2u o; o.x = pk2(a[0], a[1]); o.y = pk2(a[2], a[3]); *(LAS v2u*)(Al + (it * 16 + fr) * 72 + jt * 16 + 4 * fq) = o; } }
#pragma unroll
            for (int dkt = 0; dkt < 8; ++dkt) { const f32x4 e4 = *(LAS f32x4*)(ebL + dkt * 16 + 4 * fq); Sa[dkt][0] *= e4; Sa[dkt][1] *= e4; }
            __syncthreads();
            f32x4 acc[2][4];
#pragma unroll
            for (int jv = 0; jv < 2; ++jv)
#pragma unroll
                for (int tt = 0; tt < 4; ++tt) acc[jv][tt] = (f32x4){0.f, 0.f, 0.f, 0.f};
#pragma unroll
            for (int ks = 0; ks < 4; ++ks) { bf16x8 X[2];
#pragma unroll
                for (int jv = 0; jv < 2; ++jv) { const f32x4 s0 = Sa[2 * ks][jv], s1 = Sa[2 * ks + 1][jv]; v4u p; p.x = pk2(s0[0], s0[1]); p.y = pk2(s0[2], s0[3]); p.z = pk2(s1[0], s1[1]); p.w = pk2(s1[2], s1[3]); X[jv] = __builtin_bit_cast(bf16x8, p); }
#pragma unroll
                for (int tt = 0; tt < 4; ++tt) { const v2u y0 = *(LAS v2u*)(qT + (tt * 16 + fr) * 136 + ks * 32 + 4 * fq), y1 = *(LAS v2u*)(qT + (tt * 16 + fr) * 136 + ks * 32 + 16 + 4 * fq);
                    v4u yy; yy.x = y0.x; yy.y = y0.y; yy.z = y1.x; yy.w = y1.y; const bf16x8 Y = __builtin_bit_cast(bf16x8, yy);
                    acc[0][tt] = MFMA16(X[0], Y, acc[0][tt]); acc[1][tt] = MFMA16(X[1], Y, acc[1][tt]); } }
#pragma unroll
            for (int ks = 0; ks < 2; ++ks) { bf16x8 X[2];
#pragma unroll
                for (int jv = 0; jv < 2; ++jv) X[jv] = tr_frag(Vl, 528, ks * 32, (2 * w + jv) * 16, lane);
#pragma unroll
                for (int tt = 0; tt < 4; ++tt) { if (ks == 1 && tt < 2) continue; const bf16x8 Y = *(LAS bf16x8*)(Al + (tt * 16 + fr) * 72 + ks * 32 + 8 * fq); acc[0][tt] = MFMA16(X[0], Y, acc[0][tt]); acc[1][tt] = MFMA16(X[1], Y, acc[1][tt]); }
#pragma unroll
                for (int dkt = 0; dkt < 8; ++dkt) { const bf16x8 K = tr_frag((LAS unsigned char*)kT, 272, ks * 32, dkt * 16, lane);
                    Sa[dkt][0] = MFMA16(K, X[0], Sa[dkt][0]); Sa[dkt][1] = MFMA16(K, X[1], Sa[dkt][1]); } }
#pragma unroll
            for (int dkt = 0; dkt < 8; ++dkt) { const f32x4 e4 = *(LAS f32x4*)(elL + dkt * 16 + 4 * fq); Sa[dkt][0] *= e4; Sa[dkt][1] *= e4; }
            v2u gg[4][2];
#pragma unroll
            for (int jv = 0; jv < 2; ++jv)
#pragma unroll
                for (int tt = 0; tt < 4; ++tt) gg[tt][jv] = *(const GAS v2u*)(Z + (size_t)(t0 + tt * 16 + fr) * LDZ + OFF_GG + h * 256 + (2 * w + jv) * 16 + 4 * fq);
#pragma unroll
            for (int tt = 0; tt < 4; ++tt) { float s = 0.f;
#pragma unroll
                for (int jv = 0; jv < 2; ++jv) { const f32x4 a = acc[jv][tt]; s += (a[0] * a[0] + a[1] * a[1]) + (a[2] * a[2] + a[3] * a[3]); }
                s += pg8::shx(s, lane, 16); s += pg8::shx(s, lane, 32);
                if (fq == 0) part[(tt * 16 + fr) * 8 + w] = s; }
            __syncthreads();
#pragma unroll
            for (int tt = 0; tt < 4; ++tt) { const int t = tt * 16 + fr; const f32x4 p0 = *(LAS f32x4*)(part + t * 8), p1 = *(LAS f32x4*)(part + t * 8 + 4);
                const float rs = __builtin_amdgcn_rsqf(((p0[0] + p0[1]) + (p0[2] + p0[3]) + (p1[0] + p1[1]) + (p1[2] + p1[3])) * (1.0f / 256.0f) + RMS_EPS);
#pragma unroll
                for (int jv = 0; jv < 2; ++jv) { const int dv = (2 * w + jv) * 16 + 4 * fq; const v2u gv = gg[tt][jv]; const f32x4 a = acc[jv][tt]; const f32x4 gn = *(const GAS f32x4*)(F.gla_g + l * 256 + dv);
                    const float g0 = bflo(gv.x), g1 = bfhi(gv.x), g2 = bflo(gv.y), g3 = bfhi(gv.y);
                    const float o0 = a[0] * rs * gn[0] * g0 * __builtin_amdgcn_rcpf(1.0f + __expf(-g0)), o1 = a[1] * rs * gn[1] * g1 * __builtin_amdgcn_rcpf(1.0f + __expf(-g1));
                    const float o2 = a[2] * rs * gn[2] * g2 * __builtin_amdgcn_rcpf(1.0f + __expf(-g2)), o3 = a[3] * rs * gn[3] * g3 * __builtin_amdgcn_rcpf(1.0f + __expf(-g3));
                    v2u o; o.x = pk2(o0, o1); o.y = pk2(o2, o3); *(GAS v2u*)(AA + (size_t)(t0 + t) * 2048 + h * 256 + dv) = o; } }
        }
    }
    __syncthreads();
#undef GC_FETCH
}
constexpr int SW_K = 0, SW_V = 256 * 144, SW_P = SW_V + 288 * 144, SW_END = SW_P + 8 * 16 * 336;
static_assert(SW_END <= RING_BYTES, "SWA LDS map");
__device__ __forceinline__ void swa_phase(Frame& F, int l) {
    LAS unsigned char* lds = F.lds;
    LAS bf16* Kl = (LAS bf16*)(lds + SW_K); LAS unsigned char* Vl = lds + SW_V;
    const int tid = F.tid, lane = F.lane, w = F.wave, fr = lane & 15, fq = lane >> 4;
    LAS bf16* Pl = (LAS bf16*)(lds + SW_P + w * (16 * 336));
    const bf16* Z = (const bf16*)(F.ws + WS_Z); unsigned char* AB8 = F.ws + WS_AB;
    for (int i = tid; i < 32 * 144 / 4; i += NWAVES * 64) ((LAS unsigned*)(Vl + 256 * 144))[i] = 0u;
    const int NITEM = BATCH * 32 * 8;
    f32x4 pen0, pen8;
#pragma unroll
    for (int e = 0; e < 4; ++e) { pen0[e] = (4 * fq + e <= fr) ? -1e30f : 0.f; pen8[e] = (4 * fq + e > fr) ? -1e30f : 0.f; }
    v4u kreg[4], vreg[4];
#define SW_FETCH(item_) do { const int g_ = (item_) & 7, qb_ = ((item_) >> 3) & 31, b_ = (item_) >> 8, q0_ = b_ * SEQ + qb_ * 128; \
        _Pragma("unroll") for (int i = 0; i < 4; ++i) { const int c = tid + 512 * i, kr = c >> 3, d0 = (c & 7) * 8; int tok = q0_ - 128 + kr; if (tok < b_ * SEQ) tok = b_ * SEQ; \
            const size_t zr = (size_t)tok * LDZ + g_ * 64 + d0; kreg[i] = *(const GAS v4u*)(Z + zr + OFF_SK); vreg[i] = *(const GAS v4u*)(Z + zr + OFF_SV); } } while (0)
    SW_FETCH((int)blockIdx.x < NITEM ? (int)blockIdx.x : NITEM - 1);
    for (int item = blockIdx.x; item < NITEM; item += F.G) {
        const int g = item & 7, qb = (item >> 3) & 31, b = item >> 8, q0 = b * SEQ + qb * 128;
#pragma unroll
        for (int i = 0; i < 4; ++i) { const int c = tid + 512 * i, kr = c >> 3, d0 = (c & 7) * 8; *(LAS v4u*)(Kl + kr * 72 + d0) = kreg[i]; *(LAS v4u*)(Vl + kr * 144 + d0 * 2) = vreg[i]; }
        const int r = w >> 1, hq = g * 4 + r; const float sink = F.sinks[l * 32 + hq];
        bf16x8 Yc[2]; v2u gc[4];
        { const size_t qrow = (size_t)(q0 + 64 * (w & 1) + fr);
#pragma unroll
          for (int ks = 0; ks < 2; ++ks) Yc[ks] = *(const GAS bf16x8*)(Z + qrow * LDZ + OFF_SQ + hq * 64 + ks * 32 + 8 * fq);
#pragma unroll
          for (int c = 0; c < 4; ++c) gc[c] = *(const GAS v2u*)(Z + qrow * LDZ + OFF_SG + hq * 64 + c * 16 + 4 * fq); }
        __syncthreads();
        if (item + F.G < NITEM) SW_FETCH(item + F.G);
#pragma unroll 1
        for (int qt = 0; qt < 4; ++qt) {
            const int ql0 = 64 * (w & 1) + 16 * qt; const size_t qrow = (size_t)(q0 + ql0 + fr);
            bf16x8 Yn[2]; v2u gn[4];
            { const size_t qn = (size_t)(q0 + 64 * (w & 1) + 16 * ((qt + 1) & 3) + fr);
#pragma unroll
              for (int ks = 0; ks < 2; ++ks) Yn[ks] = *(const GAS bf16x8*)(Z + qn * LDZ + OFF_SQ + hq * 64 + ks * 32 + 8 * fq);
#pragma unroll
              for (int c = 0; c < 4; ++c) gn[c] = *(const GAS v2u*)(Z + qn * LDZ + OFF_SG + hq * 64 + c * 16 + 4 * fq); }
            f32x4 S[9];
#pragma unroll
            for (int kt = 0; kt < 9; ++kt) { f32x4 a = (f32x4){0.f, 0.f, 0.f, 0.f};
#pragma unroll
                for (int ks = 0; ks < 2; ++ks) { const bf16x8 X = *(LAS bf16x8*)(Kl + (ql0 + 16 * kt + fr) * 72 + ks * 32 + 8 * fq); a = MFMA16(X, Yc[ks], a); }
                S[kt] = a; }
            const int qpos = qb * 128 + ql0 + fr; const float CS = 0.125f * 1.4426950408889634f, sink2 = sink * 1.4426950408889634f;
            S[0] += pen0; S[8] += pen8;
            if (qb == 0) {
#pragma unroll
                for (int kt = 0; kt < 8; ++kt)
#pragma unroll
                    for (int e = 0; e < 4; ++e) if (qpos - 128 + 16 * kt + 4 * fq + e - fr < 0) S[kt][e] = -1e30f; }
            float mr = S[0][0];
#pragma unroll
            for (int kt = 0; kt < 9; ++kt) mr = fmaxf(fmaxf(mr, fmaxf(S[kt][0], S[kt][1])), fmaxf(S[kt][2], S[kt][3]));
            mr = fmaxf(mr, pg8::shx(mr, lane, 16)); mr = fmaxf(mr, pg8::shx(mr, lane, 32));
            const float m2 = fmaxf(mr * CS, sink2);
            float sum = 0.f;
#pragma unroll
            for (int kt = 0; kt < 9; ++kt) { f32x4 p;
#pragma unroll
                for (int e = 0; e < 4; ++e) { p[e] = __builtin_amdgcn_exp2f(S[kt][e] * CS - m2); sum += p[e]; }
                v2u o; o.x = pk2(p[0], p[1]); o.y = pk2(p[2], p[3]); *(LAS v2u*)(Pl + fr * 168 + 16 * kt + 4 * fq) = o; }
            { unsigned z0 = 0u; asm volatile("" : "+v"(z0)); v2u o; o.x = z0; o.y = z0; *(LAS v2u*)(Pl + fr * 168 + 144 + 4 * fq) = o; }
            sum += pg8::shx(sum, lane, 16); sum += pg8::shx(sum, lane, 32);
            const float iv = __builtin_amdgcn_rcpf(sum + __builtin_amdgcn_exp2f(sink2 - m2)) * AB8_SCALE;
            LDS_WAIT(); asm volatile("" ::: "memory");
            f32x4 O[4];
#pragma unroll
            for (int c = 0; c < 4; ++c) O[c] = (f32x4){0.f, 0.f, 0.f, 0.f};
#pragma unroll
            for (int k5 = 0; k5 < 5; ++k5) { const bf16x8 Y = *(LAS bf16x8*)(Pl + fr * 168 + k5 * 32 + 8 * fq);
#pragma unroll
                for (int c = 0; c < 4; ++c) { const bf16x8 X = tr_frag(Vl, 144, ql0 + 32 * k5, c * 16, lane); O[c] = MFMA16(X, Y, O[c]); } }
#pragma unroll
            for (int c = 0; c < 4; ++c) { const int dd = hq * 64 + c * 16 + 4 * fq; const v2u gv = gc[c];
                const float g0 = bflo(gv.x), g1 = bfhi(gv.x), g2 = bflo(gv.y), g3 = bfhi(gv.y);
                const float o0 = O[c][0] * iv * g0 * __builtin_amdgcn_rcpf(1.0f + __expf(-g0)), o1 = O[c][1] * iv * g1 * __builtin_amdgcn_rcpf(1.0f + __expf(-g1));
                const float o2 = O[c][2] * iv * g2 * __builtin_amdgcn_rcpf(1.0f + __expf(-g2)), o3 = O[c][3] * iv * g3 * __builtin_amdgcn_rcpf(1.0f + __expf(-g3));
                int q = __builtin_amdgcn_cvt_pk_fp8_f32(o0, o1, 0, false); q = __builtin_amdgcn_cvt_pk_fp8_f32(o2, o3, q, true); *(GAS unsigned*)(AB8 + qrow * 2048 + dd) = (unsigned)q; }
            asm volatile("" ::: "memory");
#pragma unroll
            for (int ks = 0; ks < 2; ++ks) Yc[ks] = Yn[ks];
#pragma unroll
            for (int c = 0; c < 4; ++c) gc[c] = gn[c];
        }
        __syncthreads();
    }
#undef SW_FETCH
}
#ifndef GEMM_BAL
#define GEMM_BAL true
#endif
#ifndef REP_PRO
#define REP_PRO 1
#endif
#ifndef REP_P1
#define REP_P1 1
#endif
#ifndef REP_GA
#define REP_GA 1
#endif
#ifndef REP_SWA
#define REP_SWA 1
#endif
#ifndef REP_SCAN
#define REP_SCAN 1
#endif
#ifndef REP_GC
#define REP_GC 1
#endif
#ifndef REP_P3
#define REP_P3 1
#endif
#ifndef REP_BAR
#define REP_BAR 1
#endif
#ifndef REP_P4
#define REP_P4 1
#endif
struct Args { const float* in[12]; float* out; unsigned char* ws; int ph_lo, ph_hi; };
static_assert(sizeof(Args) == 14 * 8 + 8, "Args has no holes");
__global__ void __launch_bounds__(NWAVES * 64, 2) hybrid_fwd(Args args) {
    extern __shared__ __attribute__((aligned(16))) unsigned char lds[];
    Frame F;
    F.lds = (LAS unsigned char*)lds; F.MISC = (volatile LAS unsigned*)(F.lds + MISC_OFF);
    F.tid = threadIdx.x; F.lane = F.tid & 63; F.wave = __builtin_amdgcn_readfirstlane(F.tid >> 6); F.G = gridDim.x;
    F.ws = args.ws; F.ctl = (gu32*)(args.ws + WS_CTL);
    F.x = args.in[0]; F.norm_g = args.in[1]; F.w_in = args.in[2]; F.b_gates = args.in[3]; F.w_up = args.in[4]; F.b_dec = args.in[5]; F.gla_g = args.in[6]; F.sinks = args.in[7];
    F.w_gla = args.in[8]; F.w_swa = args.in[9]; F.w_out = args.in[10]; F.fin_g = args.in[11]; F.out = args.out;
    for (int u = F.tid; u < (LDS_BYTES - LDSCTL_OFF) / 4; u += NWAVES * 64) ((LAS unsigned*)(F.lds + LDSCTL_OFF))[u] = 0u;
    __syncthreads();
    XcdBarrier bar; bar.bar = (unsigned*)(F.ctl + CW_BAR); bar.x = 0; bar.st = nullptr;
    if (!MK_PER_PHASE) bar = xcd_barrier_post((unsigned*)(F.ctl + CW_BAR), F.MISC + 8);
    const int wv0 = __builtin_amdgcn_readfirstlane(threadIdx.x >> 6);
    const int lo = args.ph_lo, hi = args.ph_hi;
#if MK_PER_PHASE
#define IN(k) (lo <= (k) && (k) < hi)
#else
#define IN(k) true
#endif
#define PHASE_BEGIN() do { unsigned m_ = ~0u; asm volatile("" : "+s"(m_)); int t_ = wv0 * 64 + (int)__builtin_amdgcn_mbcnt_hi(m_, __builtin_amdgcn_mbcnt_lo(m_, 0u)); asm volatile("" : "+v"(t_)); F.tid = t_; F.lane = t_ & 63; F.wave = __builtin_amdgcn_readfirstlane(t_ >> 6); unsigned long long z_ = 0ull; asm volatile("" : "+s"(z_)); unsigned char* w_ = args.ws + z_; F.ws = w_; F.ctl = (gu32*)(w_ + WS_CTL); } while (0)
#define SEAM(k) do { if (IN(k) && IN((k) + 1)) { unsigned long long z_ = 0ull; asm volatile("" : "+s"(z_)); bar.bar = (unsigned*)(args.ws + WS_CTL + z_) + CW_BAR; for (int rb_ = 0; rb_ < REP_BAR; ++rb_) xcd_barrier(bar); } } while (0)
    if (IN(0)) for (int rep = 0; rep < REP_PRO; ++rep) { PHASE_BEGIN(); p0_prologue(F); }
    SEAM(0);
    for (int l = 0; l < DEPTH; ++l) {
        const int p = 1 + 6 * l;
        if (IN(p)) for (int rep = 0; rep < REP_P1; ++rep) {
            PHASE_BEGIN(); const bf16* XBp = (const bf16*)(F.ws + WS_XB); bf16* Zp = (bf16*)(F.ws + WS_Z);
            gdec_phase(F, l);
            pg8::StaticOrder S; S.init(M, NZ_BF, F.G, (int)blockIdx.x);
            pg8::EpiZ E; E.Z = Zp; E.P = (const float*)(F.ws + WS_SSQP); E.rsl = (const LAS float*)(F.lds + RS_OFF); E.mul = 1.0f;
            const float* SXc = (const float*)(F.ws + WS_SX) + (size_t)(l & 1) * M; float* SXn = (float*)(F.ws + WS_SX) + (size_t)((l + 1) & 1) * M; const float iwq = 1.0f / ((const float*)(F.ws + WS_SX))[2 * M + l];
            { pg8::Unit u0; const bool has = S.next(0, u0); E.pm0 = has ? u0.pm : -1;
              if (has && F.tid < 256) { const int row = u0.pm * 256 + F.tid; const float rstd = pg8::row_rstd(E.P, row); ((LAS float*)(F.lds + RS_OFF))[F.tid] = rstd;
                  ((LAS float*)(F.lds + RS2_OFF))[F.tid] = rstd * iwq * __builtin_amdgcn_rcpf(SXc[row]); SXn[row] = (127.0f / QC_XP) * rstd; ((LAS float*)(F.lds + RS3_OFF))[F.tid] = (127.0f / QC_XP) * rstd; }
              __syncthreads(); }
            { pg8::Gemm g{XBp, (const bf16*)(F.ws + WS_WIN) + (size_t)l * NZ * D, M, NZ_BF, D};
              pg8::gemm_phase<pg8::EpiZ, pg8::StaticOrder, true, true, false, GEMM_BAL>(F.lds, g, S, E, F.tid); }
            { pg8::StaticOrder S8; S8.init(M, NZ_F8, F.G, (int)blockIdx.x); pg8::Unit u0; const bool has = S8.next(0, u0);
              pg8::EpiZ8 E8{Zp + NZ_BF, E.P, SXc, iwq, (!has || u0.pm != E.pm0) ? -1 : E.pm0, (const LAS float*)(F.lds + RS2_OFF), F.ws + WS_GT, (OFF_GA - NZ_BF) / 256};
              pg8::Gemm g{(const bf16*)(F.ws + WS_X8), (const bf16*)(F.ws + WS_WIN8 + (size_t)l * NZ_F8 * D), M, NZ_F8, D / 2};
              pg8::gemm_phase<pg8::EpiZ8, pg8::StaticOrder, true, true, false, GEMM_BAL, true>(F.lds, g, S8, E8, F.tid); }
        }
        SEAM(p);
        if (IN(p + 1)) { for (int rep = 0; rep < REP_GA; ++rep) { PHASE_BEGIN(); gla_a_phase(F, l); } for (int rep = 0; rep < REP_SWA; ++rep) { PHASE_BEGIN(); swa_phase(F, l); } }
        SEAM(p + 1);
        if (IN(p + 2)) for (int rep = 0; rep < REP_SCAN; ++rep) { PHASE_BEGIN(); gla_scan_phase(F); }
        SEAM(p + 2);
        if (IN(p + 3)) for (int rep = 0; rep < REP_GC; ++rep) { PHASE_BEGIN(); gla_c_phase(F, l); }
        SEAM(p + 3);
        if (IN(p + 4)) for (int rep = 0; rep < REP_P3; ++rep) {
            { PHASE_BEGIN(); bf16* Zp = (bf16*)(F.ws + WS_Z); pg8::Gemm g{(const bf16*)(F.ws + WS_AA), (const bf16*)(F.ws + WS_WGLA) + (size_t)l * D * 2048, M, D, 2048}; pg8::StaticOrder S; S.init(M, D, F.G, (int)blockIdx.x);
              LAS float* mred = (LAS float*)(F.lds + MQ_OFF + 16); if (F.tid < 8) mred[F.tid] = 0.f; __syncthreads();
              int nu = ((M / 256) * (D / 256) - (int)blockIdx.x + F.G - 1) / F.G; asm volatile("" : "+s"(nu));
              pg8::EpiGateA E{F.ws + WS_GT, F.b_gates + (size_t)(l * 2 + 0) * D, F.ws + WS_TMP, (LAS float*)mred};
              pg8::gemm_phase<pg8::EpiGateA, pg8::StaticOrder, false, true, false, GEMM_BAL>(F.lds, g, S, E, F.tid);
              __syncthreads();
              if (F.tid == 0) { float t = 0.f;
#pragma unroll
                  for (int w_ = 0; w_ < 8; ++w_) t += mred[w_];
                  *(LAS float*)(F.lds + MQ_OFF) = (127.0f / QC_M) * __builtin_amdgcn_rsqf(t / (65536.0f * (float)(nu > 0 ? nu : 1)) + 1e-30f); }
              __syncthreads(); }
            { PHASE_BEGIN(); bf16* Zp = (bf16*)(F.ws + WS_Z); pg8::Gemm g{(const bf16*)(F.ws + WS_AB), (const bf16*)(F.ws + WS_WSWA + (size_t)l * D * 2048), M, D, 1024}; pg8::StaticOrder S; S.init(M, D, F.G, (int)blockIdx.x);
              pg8::EpiGateB8 E{F.ws + WS_GT + (size_t)1024 * 131072, F.b_gates + (size_t)(l * 2 + 1) * D, F.ws + WS_TMP, F.ws + WS_MERGED, 1.0f / (W8_SCALE * AB8_SCALE), *(const LAS float*)(F.lds + MQ_OFF) * 0.35355339f};
              pg8::gemm_phase<pg8::EpiGateB8, pg8::StaticOrder, false, true, true, GEMM_BAL>(F.lds, g, S, E, F.tid); }
        }
        SEAM(p + 4);
        if (IN(p + 5)) for (int rep = 0; rep < REP_P4; ++rep) {
            PHASE_BEGIN(); pg8::Gemm g{(const bf16*)(F.ws + WS_MERGED), (const bf16*)(F.ws + WS_WOUT + (size_t)l * D * D), M, D, D / 2};
            pg8::EpiRes E{(bf16*)(F.ws + (rep ? WS_TMP : WS_XB)), (float*)(F.ws + (rep ? WS_TMP + 192 * MiB : WS_SSQP)), F.ws + (rep ? WS_TMP + 128 * MiB : WS_X8), (const float*)(F.ws + WS_SX) + (size_t)((l + 1) & 1) * M, (const LAS float*)(F.lds + RS3_OFF), -1, 1.0f / (*(const LAS float*)(F.lds + MQ_OFF) * ((const float*)(F.ws + WS_SX))[2 * M + DEPTH + l])};
            { pg8::StaticOrder S0; S0.init(M, D, F.G, (int)blockIdx.x); pg8::Unit u0; if (S0.next(0, u0)) E.pm0 = u0.pm; }
#if defined(PROBE_P4_HOT)
            if (rep) { pg8::HotOrder S; S.init(M, D, F.G, (int)blockIdx.x); pg8::gemm_phase<pg8::EpiRes, pg8::HotOrder, false, true, false, GEMM_BAL, true>(F.lds, g, S, E, F.tid); } else
#endif
            { pg8::StaticOrder S; S.init(M, D, F.G, (int)blockIdx.x); pg8::gemm_phase<pg8::EpiRes, pg8::StaticOrder, false, true, false, GEMM_BAL, true>(F.lds, g, S, E, F.tid); }
        }
        SEAM(p + 5);

    }
    if (IN(N_PHASES - 1)) { PHASE_BEGIN(); final_norm(F); }
#undef IN
#undef SEAM
}

extern "C" void kernel_launch(void* const* d_in, const int* in_sizes, int n_in, void* d_out, int out_size, void* d_ws, size_t ws_size, hipStream_t stream) {
    static int grid = 0;
    if (grid == 0) {
        if (n_in != 12 || in_sizes[0] != M * D || out_size != M * D || ws_size < WS_END) { fprintf(stderr, "kernel_launch: unexpected shapes (n_in %d, in0 %d, out %d, ws %zu < %zu); nothing launched\n", n_in, n_in > 0 ? in_sizes[0] : -1, out_size, ws_size, (size_t)WS_END); grid = -1; return; }
        int dev = 0, cus = 0, per_cu = 0;
        if (hipGetDevice(&dev) != hipSuccess || hipDeviceGetAttribute(&cus, hipDeviceAttributeMultiprocessorCount, dev) != hipSuccess) { grid = -1; return; }
        if (hipFuncSetAttribute((const void*)hybrid_fwd, hipFuncAttributeMaxDynamicSharedMemorySize, LDS_BYTES) != hipSuccess) { fprintf(stderr, "kernel_launch: hipFuncSetAttribute failed\n"); grid = -1; return; }
        if (hipOccupancyMaxActiveBlocksPerMultiprocessor(&per_cu, (const void*)hybrid_fwd, NWAVES * 64, LDS_BYTES) != hipSuccess || per_cu < 1) { fprintf(stderr, "kernel_launch: occupancy query reports %d blocks per CU\n", per_cu); }
        (void)hipGetLastError();
        grid = cus;
    }
    if (grid < 0) return;
    if (hipMemsetAsync((char*)d_ws + WS_CTL, 0, CTL_ZERO_BYTES, stream) != hipSuccess) return;
    Args a{};
    for (int i = 0; i < 12; ++i) a.in[i] = (const float*)d_in[i];
    a.out = (float*)d_out; a.ws = (unsigned char*)d_ws;
#if MK_PER_PHASE
    for (int ph = 0; ph < N_PHASES; ++ph) { a.ph_lo = ph; a.ph_hi = ph + 1; hipLaunchKernelGGL(hybrid_fwd, dim3(grid), dim3(NWAVES * 64), LDS_BYTES, stream, a); }
#else
    a.ph_lo = 0; a.ph_hi = N_PHASES; hipLaunchKernelGGL(hybrid_fwd, dim3(grid), dim3(NWAVES * 64), LDS_BYTES, stream, a);
#endif
    const hipError_t le = hipPeekAtLastError();
    if (le != hipSuccess) fprintf(stderr, "kernel_launch: launch failed: %s\n", hipGetErrorName(le));
}
```

```cpp
#include <hip/hip_runtime.h>
#include <cstdio>
#include <cstdint>
namespace pg8 {
#define PG8_LAS __attribute__((address_space(3)))
typedef unsigned short bf16_t;
typedef short bf16x8 __attribute__((ext_vector_type(8)));
typedef float f32x4 __attribute__((ext_vector_type(4)));
typedef unsigned u32x4 __attribute__((ext_vector_type(4)));
typedef int i32x4 __attribute__((ext_vector_type(4)));
typedef int i32x8 __attribute__((ext_vector_type(8)));
constexpr int BM = 256, BK = 64, HALF = 128, HTB = HALF * BK * 2  , STAGE_BYTES = 8 * HTB, NXCD = 8, WGM = 8;

__host__ __device__ __forceinline__ int lds_byte(int r, int c) { const int st = (r >> 4) * 2 + (c >> 5), rr = r & 15, cc = c & 31, ob = rr * 64 + cc * 2; return st * 1024 + (ob ^ (((ob >> 9) & 1) << 5)); }
__host__ __device__ __forceinline__ void stage_rc(int b, int& R, int& C) { const int st = b / 1024, sb = b % 1024, swz = sb ^ (((sb >> 9) & 1) << 5); R = (st >> 1) * 16 + swz / 64; C = (st & 1) * 32 + (swz % 64) / 2; }
__host__ __device__ __forceinline__ int perm32(int rho) { const int n = rho >> 4, i = rho & 15; return 8 * (i >> 2) + 4 * n + (i & 3); }

struct Unit { int pm, pn; };
struct Gemm { const bf16_t* A; const bf16_t* Bt; int M, N, K; };

struct StaticOrder {
    int nM, nN, nwg, G, c;
    __host__ __device__ void init(int M, int N, int G_, int c_) { nM = M / BM; nN = N / BM; nwg = nM * nN; G = G_; c = c_; }
    __host__ __device__ bool next(int i, Unit& u) const {
        const long L = (long)i * G + c; if (L >= nwg) return false;
        int wgid = (int)L; { const int q = nwg / NXCD, r = nwg % NXCD, xcd = wgid % NXCD, off = wgid / NXCD; wgid = (xcd < r ? xcd * (q + 1) : r * (q + 1) + (xcd - r) * q) + off; }
        const int nig = WGM * nN, gid = wgid / nig, fm = gid * WGM, gsz = (nM - fm) < WGM ? (nM - fm) : WGM;
        u.pm = fm + ((wgid % nig) % gsz); u.pn = (wgid % nig) / gsz; return true;
    }
    __device__ __forceinline__ void a_ready(const Unit&) const {}
    __device__ __forceinline__ void done(const Unit&) const {}
};
typedef unsigned u32x2 __attribute__((ext_vector_type(2)));
typedef float f32x2c __attribute__((ext_vector_type(2))); typedef __bf16 bf16x2c __attribute__((ext_vector_type(2)));
__device__ __forceinline__ unsigned cvt_pk_bf16(float lo, float hi) { const f32x2c v = {lo, hi}; return __builtin_bit_cast(unsigned, __builtin_convertvector(v, bf16x2c)); }
typedef float f32x2 __attribute__((ext_vector_type(2)));
struct HotOrder : StaticOrder { __host__ __device__ bool next(int i, Unit& u) const { const bool r = StaticOrder::next(i, u); u.pm = c & 7; u.pn = 0; return r; } };
constexpr int LDZ = 19456;
__device__ __forceinline__ float bf_lo(unsigned w) { return __uint_as_float(w << 16); }
__device__ __forceinline__ float bf_hi(unsigned w) { return __uint_as_float(w & 0xffff0000u); }
__device__ __forceinline__ float sigmoidf_(float x) { return __builtin_amdgcn_rcpf(1.0f + __expf(-x)); }
__host__ __device__ __forceinline__ int kperm8(int k) { return (k & ~63) | ((k & 0x18) << 1) | ((k >> 2) & 8) | (k & 7); }
__device__ __forceinline__ unsigned q8x4(float a, float b, float c, float d, float q) {
    const float MG = 12582912.0f, LO = MG - 127.0f, HI = MG + 127.0f;
    const unsigned i0 = __float_as_uint(__builtin_amdgcn_fmed3f(__builtin_fmaf(a, q, MG), LO, HI)), i1 = __float_as_uint(__builtin_amdgcn_fmed3f(__builtin_fmaf(b, q, MG), LO, HI));
    const unsigned i2 = __float_as_uint(__builtin_amdgcn_fmed3f(__builtin_fmaf(c, q, MG), LO, HI)), i3 = __float_as_uint(__builtin_amdgcn_fmed3f(__builtin_fmaf(d, q, MG), LO, HI));
    return __builtin_amdgcn_perm(i1, i0, 0x0c0c0400u) | __builtin_amdgcn_perm(i3, i2, 0x04000c0cu);
}
__device__ __forceinline__ float shx(float v, int lane, int mask) { return __int_as_float(__builtin_amdgcn_ds_bpermute((lane ^ mask) << 2, __float_as_int(v))); }
__device__ __forceinline__ float row_ssq(const float* P, int row) {
    const f32x4* p = (const f32x4*)(P + (size_t)row * 64); float s = 0.f;
#pragma unroll
    for (int j = 0; j < 16; ++j) { const f32x4 v = p[j]; s += (v[0] + v[1]) + (v[2] + v[3]); }
    return s;
}
__device__ __forceinline__ float row_rstd(const float* P, int row) { return __builtin_amdgcn_rsqf(row_ssq(P, row) * (1.0f / 4096.0f) + 1e-6f); }
__device__ __forceinline__ float row_rstd_slow(const float* P, int row) {
    const f32x4* p = (const f32x4*)(P + (size_t)row * 64); float s = 0.f;
#pragma unroll 1
    for (int j = 0; j < 16; ++j) { const f32x4 v = p[j]; s += (v[0] + v[1]) + (v[2] + v[3]); }
    return __builtin_amdgcn_rsqf(s * (1.0f / 4096.0f) + 1e-6f);
}
struct EpiZ {
    static constexpr bool PERM = true, AFTER_DRAIN = false, IDEMP = true;
    bf16_t* Z; const float* P; int pm0; const PG8_LAS float* rsl; float mul;
    __device__ __forceinline__ void operator()(const f32x4 (&acc)[2][2][4][2], const Unit& u, int wr, int wc, int fr_in, int fq_in) const {
        int fr = fr_in, fq = fq_in; asm volatile("" : "+v"(fr), "+v"(fq));
        const int row0 = u.pm * BM + wr * 64 + fr, col0 = u.pn * BM + wc * 64 + 8 * fq;
#pragma unroll
        for (int ai = 0; ai < 2; ++ai)
#pragma unroll
            for (int m = 0; m < 4; ++m) { const int row = row0 + ai * HALF + m * 16; const float r = ((u.pm == pm0) ? rsl[ai * HALF + wr * 64 + m * 16 + fr] : row_rstd_slow(P, row)) * mul;
                bf16_t* rowp = Z + (size_t)row * LDZ + col0;
#pragma unroll
                for (int bj = 0; bj < 2; ++bj) { const f32x4 v0 = acc[ai][bj][m][0] * r, v1 = acc[ai][bj][m][1] * r;
                    u32x4 w; w.x = cvt_pk_bf16(v0[0], v0[1]); w.y = cvt_pk_bf16(v0[2], v0[3]); w.z = cvt_pk_bf16(v1[0], v1[1]); w.w = cvt_pk_bf16(v1[2], v1[3]);
                    *(u32x4*)(rowp + bj * 32) = w; } }
    }
};
struct EpiZ8 {
    static constexpr bool PERM = true, AFTER_DRAIN = false, IDEMP = true;
    bf16_t* Z; const float* P; const float* SX; float iwq; int pm0; const PG8_LAS float* rsl; unsigned char* GT; int gpn0;
    __device__ __forceinline__ void operator()(const f32x4 (&acc)[2][2][4][2], const Unit& u, int wr, int wc, int fr_in, int fq_in) const {
        int fr = fr_in, fq = fq_in; asm volatile("" : "+v"(fr), "+v"(fq));
        const int row0 = u.pm * BM + wr * 64 + fr, col0 = u.pn * BM + wc * 64 + 8 * fq;
#pragma unroll
        for (int ai = 0; ai < 2; ++ai)
#pragma unroll
            for (int m = 0; m < 4; ++m) { const int row = row0 + ai * HALF + m * 16; const float r = (u.pm == pm0) ? rsl[ai * HALF + wr * 64 + m * 16 + fr] : row_rstd_slow(P, row) * iwq * __builtin_amdgcn_rcpf(SX[row]);
                const bool gate = u.pn >= gpn0; const int gi = u.pn - gpn0;
                unsigned char* dst = gate ? GT + (((size_t)((gi >> 4) * 1024 + u.pm * 16 + (gi & 15)) * 8 + (wr * 4 + wc)) * 16 + (ai * 4 + m) * 2) * 1024 + (fr + 16 * fq) * 16 : (unsigned char*)(Z + (size_t)row * LDZ + col0);
                const int bstep = gate ? 1024 : 64;
#pragma unroll
                for (int bj = 0; bj < 2; ++bj) { const i32x4 i0 = __builtin_bit_cast(i32x4, acc[ai][bj][m][0]), i1 = __builtin_bit_cast(i32x4, acc[ai][bj][m][1]);
                    const f32x4 v0 = (f32x4){(float)i0[0], (float)i0[1], (float)i0[2], (float)i0[3]} * r, v1 = (f32x4){(float)i1[0], (float)i1[1], (float)i1[2], (float)i1[3]} * r;
                    u32x4 w; w.x = cvt_pk_bf16(v0[0], v0[1]); w.y = cvt_pk_bf16(v0[2], v0[3]); w.z = cvt_pk_bf16(v1[0], v1[1]); w.w = cvt_pk_bf16(v1[2], v1[3]);
                    *(u32x4*)(dst + bj * bstep) = w; } }
    }
};
#define PG8_SIG8(s0, s1, g, b0, b1) do { s0[0] = sigmoidf_(bf_lo(g.x) + b0[0]); s0[1] = sigmoidf_(bf_hi(g.x) + b0[1]); s0[2] = sigmoidf_(bf_lo(g.y) + b0[2]); s0[3] = sigmoidf_(bf_hi(g.y) + b0[3]); \
    s1[0] = sigmoidf_(bf_lo(g.z) + b1[0]); s1[1] = sigmoidf_(bf_hi(g.z) + b1[1]); s1[2] = sigmoidf_(bf_lo(g.w) + b1[2]); s1[3] = sigmoidf_(bf_hi(g.w) + b1[3]); } while (0)
struct EpiGateA {
    static constexpr bool PERM = true, AFTER_DRAIN = false, IDEMP = true;
    const unsigned char* G; const float* bias; unsigned char* T; PG8_LAS float* SS;
    __device__ __forceinline__ void operator()(const f32x4 (&acc)[2][2][4][2], const Unit& u, int wr, int wc, int fr_in, int fq_in) const {
        int fr = fr_in, fq = fq_in; asm volatile("" : "+v"(fr), "+v"(fq));
        const int row0 = u.pm * BM + wr * 64 + fr, col0 = u.pn * BM + wc * 64 + 8 * fq;
        f32x4 bv[2][2]; u32x4 gl[8][2], w[8][2]; float ss = 0.f;
        const size_t tofs = ((size_t)(u.pm * 16 + u.pn) * 8 + (wr * 4 + wc)) * 16384 + (fr + 16 * fq) * 16;
#pragma unroll
        for (int g = 0; g < 8; ++g) { const unsigned char* gp = G + tofs + g * 2048; gl[g][0] = *(const u32x4*)gp; gl[g][1] = *(const u32x4*)(gp + 1024); }
#pragma unroll
        for (int bj = 0; bj < 2; ++bj)
#pragma unroll
            for (int n = 0; n < 2; ++n) bv[bj][n] = *(const f32x4*)(bias + col0 + bj * 32 + 4 * n);
#pragma unroll
        for (int g = 0; g < 8; ++g) { const int ai = g >> 2, m = g & 3;
#pragma unroll
            for (int bj = 0; bj < 2; ++bj) { const u32x4 gg = gl[g][bj]; f32x4 s0, s1; PG8_SIG8(s0, s1, gg, bv[bj][0], bv[bj][1]); const f32x4 v0 = s0 * acc[ai][bj][m][0], v1 = s1 * acc[ai][bj][m][1];
                ss += ((v0[0] * v0[0] + v0[1] * v0[1]) + (v0[2] * v0[2] + v0[3] * v0[3])) + ((v1[0] * v1[0] + v1[1] * v1[1]) + (v1[2] * v1[2] + v1[3] * v1[3]));
                w[g][bj].x = cvt_pk_bf16(v0[0], v0[1]); w[g][bj].y = cvt_pk_bf16(v0[2], v0[3]); w[g][bj].z = cvt_pk_bf16(v1[0], v1[1]); w[g][bj].w = cvt_pk_bf16(v1[2], v1[3]); }
            asm volatile("" : "+v"(w[g][0]), "+v"(w[g][1])); }
        asm volatile("" ::: "memory");
#pragma unroll
        for (int g = 0; g < 8; ++g) { unsigned char* tp = T + tofs + g * 2048; *(u32x4*)tp = w[g][0]; *(u32x4*)(tp + 1024) = w[g][1]; }
        { const int ln = fr + 16 * fq;
#pragma unroll
          for (int o = 1; o < 64; o <<= 1) ss += shx(ss, ln, o);
          if (ln == 0) { PG8_LAS float* sp = SS + wr * 4 + wc; *sp = *sp + ss; } }
    }
};
struct EpiGateB {
    static constexpr bool PERM = true, AFTER_DRAIN = false, IDEMP = true;
    const bf16_t* G; const float* bias; const bf16_t* T; bf16_t* O; float mul;
    __device__ __forceinline__ void operator()(const f32x4 (&acc)[2][2][4][2], const Unit& u, int wr, int wc, int fr_in, int fq_in) const {
        int fr = fr_in, fq = fq_in; asm volatile("" : "+v"(fr), "+v"(fq));
        const int row0 = u.pm * BM + wr * 64 + fr, col0 = u.pn * BM + wc * 64 + 8 * fq;
        f32x4 bv[2][2]; u32x4 w[8][2];
#pragma unroll
        for (int bj = 0; bj < 2; ++bj)
#pragma unroll
            for (int n = 0; n < 2; ++n) bv[bj][n] = *(const f32x4*)(bias + col0 + bj * 32 + 4 * n);
#pragma unroll
        for (int ai = 0; ai < 2; ++ai) { u32x4 gl[4][2], tl[4][2];
#pragma unroll
            for (int m = 0; m < 4; ++m) { const int r = row0 + ai * HALF + m * 16; const bf16_t* gp = G + (size_t)r * LDZ + col0; const bf16_t* tp = T + (size_t)r * 4096 + col0;
                gl[m][0] = *(const u32x4*)gp; gl[m][1] = *(const u32x4*)(gp + 32); tl[m][0] = *(const u32x4*)tp; tl[m][1] = *(const u32x4*)(tp + 32); }
#pragma unroll
            for (int m = 0; m < 4; ++m) { const int g = ai * 4 + m;
#pragma unroll
                for (int bj = 0; bj < 2; ++bj) { const u32x4 gg = gl[m][bj], tt = tl[m][bj]; f32x4 s0, s1; PG8_SIG8(s0, s1, gg, bv[bj][0], bv[bj][1]);
                    f32x4 v0 = s0 * (acc[ai][bj][m][0] * mul), v1 = s1 * (acc[ai][bj][m][1] * mul);
                    v0[0] += bf_lo(tt.x); v0[1] += bf_hi(tt.x); v0[2] += bf_lo(tt.y); v0[3] += bf_hi(tt.y); v1[0] += bf_lo(tt.z); v1[1] += bf_hi(tt.z); v1[2] += bf_lo(tt.w); v1[3] += bf_hi(tt.w);
                    w[g][bj].x = cvt_pk_bf16(v0[0], v0[1]); w[g][bj].y = cvt_pk_bf16(v0[2], v0[3]); w[g][bj].z = cvt_pk_bf16(v1[0], v1[1]); w[g][bj].w = cvt_pk_bf16(v1[2], v1[3]); }
                asm volatile("" : "+v"(w[g][0]), "+v"(w[g][1])); } }
        asm volatile("" ::: "memory");
#pragma unroll
        for (int g = 0; g < 8; ++g) { bf16_t* op = O + (size_t)(row0 + (g >> 2) * HALF + (g & 3) * 16) * 4096 + col0; *(u32x4*)op = w[g][0]; *(u32x4*)(op + 32) = w[g][1]; }
    }
};
struct EpiGateB8 {
    static constexpr bool PERM = true, AFTER_DRAIN = false, IDEMP = true;
    const unsigned char* G; const float* bias; const unsigned char* T; unsigned char* O; float mul, qm;
    __device__ __forceinline__ void operator()(const f32x4 (&acc)[2][2][4][2], const Unit& u, int wr, int wc, int fr_in, int fq_in) const {
        int fr = fr_in, fq = fq_in; asm volatile("" : "+v"(fr), "+v"(fq));
        const int row0 = u.pm * BM + wr * 64 + fr, col0 = u.pn * BM + wc * 64 + 8 * fq;
        f32x4 bv[2][2]; u32x2 w[8][2];
#pragma unroll
        for (int bj = 0; bj < 2; ++bj)
#pragma unroll
            for (int n = 0; n < 2; ++n) bv[bj][n] = *(const f32x4*)(bias + col0 + bj * 32 + 4 * n);
#pragma unroll
        for (int ai = 0; ai < 2; ++ai) { u32x4 gl[4][2], tl[4][2];
#pragma unroll
            for (int m = 0; m < 4; ++m) { const size_t o_ = ((size_t)(u.pm * 16 + u.pn) * 8 + (wr * 4 + wc)) * 16384 + (fr + 16 * fq) * 16 + (ai * 4 + m) * 2048; const unsigned char* gp = G + o_; const unsigned char* tp = T + o_;
                gl[m][0] = *(const u32x4*)gp; gl[m][1] = *(const u32x4*)(gp + 1024); tl[m][0] = *(const u32x4*)tp; tl[m][1] = *(const u32x4*)(tp + 1024); }
#pragma unroll
            for (int m = 0; m < 4; ++m) { const int g = ai * 4 + m;
#pragma unroll
                for (int bj = 0; bj < 2; ++bj) { const u32x4 gg = gl[m][bj], tt = tl[m][bj]; f32x4 s0, s1; PG8_SIG8(s0, s1, gg, bv[bj][0], bv[bj][1]);
                    f32x4 v0 = s0 * (acc[ai][bj][m][0] * mul), v1 = s1 * (acc[ai][bj][m][1] * mul);
                    v0[0] += bf_lo(tt.x); v0[1] += bf_hi(tt.x); v0[2] += bf_lo(tt.y); v0[3] += bf_hi(tt.y); v1[0] += bf_lo(tt.z); v1[1] += bf_hi(tt.z); v1[2] += bf_lo(tt.w); v1[3] += bf_hi(tt.w);
                    { f32x4 p0 = (f32x4){v0[0] + v0[1], v0[0] - v0[1], v0[2] + v0[3], v0[2] - v0[3]}, p1 = (f32x4){v1[0] + v1[1], v1[0] - v1[1], v1[2] + v1[3], v1[2] - v1[3]};
                      f32x4 r0 = (f32x4){p0[0] + p0[2], p0[1] + p0[3], p0[0] - p0[2], p0[1] - p0[3]}, r1 = (f32x4){p1[0] + p1[2], p1[1] + p1[3], p1[0] - p1[2], p1[1] - p1[3]};
                      v0 = r0 + r1; v1 = r0 - r1; }
                    w[g][bj].x = q8x4(v0[0], v0[1], v0[2], v0[3], qm); w[g][bj].y = q8x4(v1[0], v1[1], v1[2], v1[3], qm); }
                asm volatile("" : "+v"(w[g][0]), "+v"(w[g][1])); } }
        asm volatile("" ::: "memory");
#pragma unroll
        for (int g = 0; g < 8; ++g) { unsigned char* op = O + (size_t)(row0 + (g >> 2) * HALF + (g & 3) * 16) * 4096 + u.pn * BM + wc * 64 + 16 * fq; *(u32x4*)op = (u32x4){w[g][0].x, w[g][0].y, w[g][1].x, w[g][1].y}; }
    }
};
struct EpiRes {
    static constexpr bool PERM = true, AFTER_DRAIN = false, IDEMP = false;
    bf16_t* XB; float* P; unsigned char* X8; const float* SXN; const PG8_LAS float* rq; int pm0; float dsc;
    __device__ __forceinline__ void operator()(const f32x4 (&acc)[2][2][4][2], const Unit& u, int wr, int wc, int fr_in, int fq_in) const {
        int fr = fr_in, fq = fq_in; asm volatile("" : "+v"(fr), "+v"(fq));
        const int row0 = u.pm * BM + wr * 64 + fr, col0 = u.pn * BM + wc * 64 + 8 * fq;
        u32x4 xl[8][2], w[8][2]; u32x2 w8[8][2]; float ssv[8];
#pragma unroll
        for (int g = 0; g < 8; ++g) { const bf16_t* xp = XB + (size_t)(row0 + (g >> 2) * HALF + (g & 3) * 16) * 4096 + col0; xl[g][0] = *(const u32x4*)xp; xl[g][1] = *(const u32x4*)(xp + 32); }
#pragma unroll
        for (int g = 0; g < 8; ++g) { const int ai = g >> 2, m = g & 3; float ss = 0.f; const float qg = (u.pm == pm0) ? rq[ai * HALF + wr * 64 + m * 16 + fr] : SXN[row0 + ai * HALF + m * 16];
#pragma unroll
            for (int bj = 0; bj < 2; ++bj) { const u32x4 xx = xl[g][bj]; const i32x4 ia = __builtin_bit_cast(i32x4, acc[ai][bj][m][0]), ib = __builtin_bit_cast(i32x4, acc[ai][bj][m][1]);
                const f32x4 a = (f32x4){(float)ia[0], (float)ia[1], (float)ia[2], (float)ia[3]} * dsc, b = (f32x4){(float)ib[0], (float)ib[1], (float)ib[2], (float)ib[3]} * dsc;
                u32x4 o; o.x = cvt_pk_bf16(bf_lo(xx.x) + a[0], bf_hi(xx.x) + a[1]); o.y = cvt_pk_bf16(bf_lo(xx.y) + a[2], bf_hi(xx.y) + a[3]); o.z = cvt_pk_bf16(bf_lo(xx.z) + b[0], bf_hi(xx.z) + b[1]); o.w = cvt_pk_bf16(bf_lo(xx.w) + b[2], bf_hi(xx.w) + b[3]);
                w[g][bj] = o;
                const float r0 = bf_lo(o.x), r1 = bf_hi(o.x), r2 = bf_lo(o.y), r3 = bf_hi(o.y), r4 = bf_lo(o.z), r5 = bf_hi(o.z), r6 = bf_lo(o.w), r7 = bf_hi(o.w);
                w8[g][bj].x = q8x4(r0, r1, r2, r3, qg); w8[g][bj].y = q8x4(r4, r5, r6, r7, qg);
                ss += ((r0 * r0 + r1 * r1) + (r2 * r2 + r3 * r3)) + ((r4 * r4 + r5 * r5) + (r6 * r6 + r7 * r7)); }
            ss += shx(ss, fr + 16 * fq, 16); ss += shx(ss, fr + 16 * fq, 32); ssv[g] = ss;
            asm volatile("" : "+v"(w[g][0]), "+v"(w[g][1]), "+v"(ssv[g]), "+v"(w8[g][0]), "+v"(w8[g][1])); }
        asm volatile("" ::: "memory");
#pragma unroll
        for (int g = 0; g < 8; ++g) { const int row = row0 + (g >> 2) * HALF + (g & 3) * 16; bf16_t* xp = XB + (size_t)row * 4096 + col0; *(u32x4*)xp = w[g][0]; *(u32x4*)(xp + 32) = w[g][1];
            unsigned char* x8 = X8 + (size_t)row * 4096 + u.pn * BM + wc * 64 + 16 * fq; *(u32x4*)x8 = (u32x4){w8[g][0].x, w8[g][0].y, w8[g][1].x, w8[g][1].y};
            if (fq == 0) P[(size_t)row * 64 + u.pn * 4 + wc] = ssv[g]; }
    }
};

__device__ __forceinline__ f32x4 zero4() { f32x4 z; asm volatile("v_mov_b32 %0, 0\n\tv_mov_b32 %1, 0\n\tv_mov_b32 %2, 0\n\tv_mov_b32 %3, 0" : "=v"(z[0]), "=v"(z[1]), "=v"(z[2]), "=v"(z[3])); return z; }
template <class Epi, class Sched, bool ALIGN_EPI = false, bool SP2 = false, bool F8 = false, bool BAL = false, bool I8 = false>
__device__ __forceinline__ void gemm_phase(PG8_LAS unsigned char* lds, const Gemm g, const Sched& S, const Epi& E, const int tid_in) {
    const int tid = tid_in, wid = __builtin_amdgcn_readfirstlane(tid >> 6), lane = tid & 63, wr = wid >> 2, wc = wid & 3, fr = lane & 15, fq = lane >> 4;
    const int K = g.K, nt = K / BK;
    unsigned voffA[2], voffB[2];
#pragma unroll
    for (int i = 0; i < 2; ++i) { int R, C; stage_rc(tid * 16 + i * 8192, R, C); const int Rb = (R >> 5) * 64 + (Epi::PERM ? perm32(R & 31) : (R & 31));
        voffA[i] = (unsigned)(R * K + C) * 2u; voffB[i] = (unsigned)(Rb * K + C) * 2u; }
    const unsigned kstep = (unsigned)(BK * 2);
    const unsigned hstep = (unsigned)HALF * (unsigned)K * 2u;
    const unsigned hstepB = 32u * (unsigned)K * 2u;
    const unsigned tstep = 2u * hstep;
    const unsigned ldsw = (unsigned)wid * 1024u;
    const int aoff = lds_byte(wr * 64 + fr, fq * 8), boff = lds_byte(wc * 32 + fr, fq * 8);
#define PG8_SA(b, h) (((b) * 2 + (h)) * HTB)
#define PG8_SB(b, h) ((4 + (b) * 2 + (h)) * HTB)
#define PG8_STAGE(bufoff, rs, gbase, voff) do { _Pragma("unroll") for (int _i = 0; _i < 2; ++_i) \
        __builtin_amdgcn_raw_ptr_buffer_load_lds(rs, (PG8_LAS void*)(lds + (bufoff) + ldsw + _i * 8192), 16, (int)(voff)[_i], (int)(gbase), 0, 0); } while (0)
#define PG8_STAGE_A(bufoff, gbase, voff) PG8_STAGE(bufoff, rsA, gbase, voff)
#define PG8_STAGE_B(bufoff, gbase, voff) PG8_STAGE(bufoff, rsB, gbase, voff)
#define PG8_LDA(dst, b, h) do { _Pragma("unroll") for (int m = 0; m < 4; ++m) _Pragma("unroll") for (int k = 0; k < 2; ++k) dst[m][k] = *(const PG8_LAS bf16x8*)(lds + PG8_SA(b, h) + aoff + m * 2048 + k * 1024); } while (0)
#define PG8_LDB(dst, b, h) do { _Pragma("unroll") for (int n = 0; n < 2; ++n) _Pragma("unroll") for (int k = 0; k < 2; ++k) dst[n][k] = *(const PG8_LAS bf16x8*)(lds + PG8_SB(b, h) + boff + n * 2048 + k * 1024); } while (0)
#define PG8_MMA(ai, bj, At, Bt) do { __builtin_amdgcn_s_setprio(1); if constexpr (I8) { \
          \
        _Pragma("unroll") for (int m = 0; m < 4; ++m) _Pragma("unroll") for (int n = 0; n < 2; ++n) _Pragma("unroll") for (int k = 0; k < 2; ++k) { \
            const i32x4 b_ = __builtin_bit_cast(i32x4, Bt[n][k]), a_ = __builtin_bit_cast(i32x4, At[m][k]); \
            asm volatile("v_mfma_i32_16x16x64_i8 %0, %1, %2, %0" : "+v"(acc[ai][bj][m][n]) : "v"(b_), "v"(a_)); } } else if constexpr (!F8) { _Pragma("unroll") for (int m = 0; m < 4; ++m) _Pragma("unroll") for (int n = 0; n < 2; ++n) _Pragma("unroll") for (int k = 0; k < 2; ++k) \
        acc[ai][bj][m][n] = __builtin_amdgcn_mfma_f32_16x16x32_bf16(Bt[n][k], At[m][k], acc[ai][bj][m][n], 0, 0, 0); } else { \
          \
          \
        _Pragma("unroll") for (int m = 0; m < 4; ++m) _Pragma("unroll") for (int n = 0; n < 2; ++n) { \
            const i32x4 b0_ = __builtin_bit_cast(i32x4, Bt[n][0]), b1_ = __builtin_bit_cast(i32x4, Bt[n][1]), a0_ = __builtin_bit_cast(i32x4, At[m][0]), a1_ = __builtin_bit_cast(i32x4, At[m][1]); \
            const i32x8 bb_ = __builtin_shufflevector(b0_, b1_, 0, 1, 2, 3, 4, 5, 6, 7), aa_ = __builtin_shufflevector(a0_, a1_, 0, 1, 2, 3, 4, 5, 6, 7); \
            asm volatile("v_mfma_f32_16x16x128_f8f6f4 %0, %1, %2, %0" : "+v"(acc[ai][bj][m][n]) : "v"(bb_), "v"(aa_)); } } \
        __builtin_amdgcn_s_setprio(0); } while (0)
#define PG8_WAIT_V(n) asm volatile("s_waitcnt vmcnt(" #n ")" ::: "memory")
#define PG8_WAIT_L(n) asm volatile("s_waitcnt lgkmcnt(" #n ")" ::: "memory")
#define PG8_BAR __builtin_amdgcn_s_barrier()
#define PG8_SCHED __builtin_amdgcn_sched_barrier(0)
    Unit cur, nxt; int ui = 0;
    if (!S.next(0, cur)) return;
    f32x4 acc[2][2][4][2];
#pragma unroll
    for (int a = 0; a < 2; ++a)
#pragma unroll
        for (int b = 0; b < 2; ++b)
#pragma unroll
            for (int m = 0; m < 4; ++m)
#pragma unroll
                for (int n = 0; n < 2; ++n) acc[a][b][m][n] = zero4();
    bf16x8 At[4][2], B0[2][2], B1[2][2];
    unsigned cA = (unsigned)cur.pm * tstep, cB = (unsigned)cur.pn * tstep;
    const __amdgpu_buffer_rsrc_t rsA = __builtin_amdgcn_make_buffer_rsrc((void*)g.A, 0, (int)((unsigned)g.M * (unsigned)K * 2u), 0x00020000), rsB = __builtin_amdgcn_make_buffer_rsrc((void*)g.Bt, 0, (int)((unsigned)g.N * (unsigned)K * 2u), 0x00020000);
    S.a_ready(cur);
    if constexpr (SP2) {
        PG8_STAGE_B(PG8_SB(0, 0), cB, voffB); PG8_STAGE_B(PG8_SB(0, 1), cB + hstepB, voffB); PG8_STAGE_A(PG8_SA(0, 0), cA, voffA); PG8_STAGE_A(PG8_SA(0, 1), cA + hstep, voffA);
        if (wr == 1) PG8_BAR;
        PG8_WAIT_V(2); PG8_BAR;
        if constexpr (BAL) { PG8_STAGE_B(PG8_SB(1, 0), cB + kstep, voffB); PG8_STAGE_B(PG8_SB(1, 1), cB + hstepB + kstep, voffB); PG8_WAIT_V(4); PG8_BAR; }
        else {
        PG8_STAGE_B(PG8_SB(1, 0), cB + kstep, voffB); PG8_STAGE_A(PG8_SA(1, 0), cA + kstep, voffA); PG8_STAGE_B(PG8_SB(1, 1), cB + hstepB + kstep, voffB);
        PG8_WAIT_V(6); PG8_BAR;
        }
    } else {
        PG8_STAGE_B(PG8_SB(0, 0), cB, voffB); PG8_STAGE_A(PG8_SA(0, 0), cA, voffA); PG8_STAGE_B(PG8_SB(0, 1), cB + hstepB, voffB); PG8_STAGE_A(PG8_SA(0, 1), cA + hstep, voffA);
        if (wr == 1) PG8_BAR;
        PG8_WAIT_V(4); PG8_BAR;
        PG8_STAGE_B(PG8_SB(1, 0), cB + kstep, voffB); PG8_STAGE_A(PG8_SA(1, 0), cA + kstep, voffA); PG8_STAGE_B(PG8_SB(1, 1), cB + hstepB + kstep, voffB);
        PG8_WAIT_V(6); PG8_BAR;
    }
    for (;;) {
        const bool has_next = S.next(ui + 1, nxt);
        const unsigned nA = has_next ? (unsigned)nxt.pm * tstep : cA, nB = has_next ? (unsigned)nxt.pn * tstep : cB;
        for (int t = 0; t < nt; t += 2) {
            const bool last = (t == nt - 2);
            const unsigned a1 = cA + (unsigned)(t + 1) * kstep;
            const unsigned a2 = last ? nA : cA + (unsigned)(t + 2) * kstep, b2 = last ? nB : cB + (unsigned)(t + 2) * kstep;
            const unsigned a3 = a2 + kstep, b3 = b2 + kstep;
            if (last && has_next) S.a_ready(nxt);
            if constexpr (SP2 && BAL) {
            PG8_LDB(B0, 0, 0); PG8_LDB(B1, 0, 1); PG8_SCHED; PG8_LDA(At, 0, 0); PG8_STAGE_A(PG8_SA(1, 0), a1, voffA); PG8_STAGE_A(PG8_SA(1, 1), a1 + hstep, voffA);
            PG8_WAIT_V(8); PG8_WAIT_L(0); PG8_BAR; PG8_MMA(0, 0, At, B0); PG8_MMA(0, 1, At, B1); PG8_BAR; PG8_SCHED;
            PG8_LDA(At, 0, 1); PG8_STAGE_B(PG8_SB(0, 0), b2, voffB); PG8_STAGE_B(PG8_SB(0, 1), b2 + hstepB, voffB);
            PG8_WAIT_V(6); PG8_WAIT_L(0); PG8_BAR; PG8_MMA(1, 0, At, B0); PG8_MMA(1, 1, At, B1); PG8_BAR; PG8_SCHED;
            PG8_LDB(B0, 1, 0); PG8_LDB(B1, 1, 1); PG8_SCHED; PG8_LDA(At, 1, 0); PG8_STAGE_A(PG8_SA(0, 0), a2, voffA); PG8_STAGE_A(PG8_SA(0, 1), a2 + hstep, voffA);
            PG8_WAIT_V(8); PG8_WAIT_L(0); PG8_BAR; PG8_MMA(0, 0, At, B0); PG8_MMA(0, 1, At, B1); PG8_BAR; PG8_SCHED;
            PG8_LDA(At, 1, 1); PG8_STAGE_B(PG8_SB(1, 0), b3, voffB); PG8_STAGE_B(PG8_SB(1, 1), b3 + hstepB, voffB);
            PG8_WAIT_V(6); PG8_WAIT_L(0); PG8_BAR; PG8_MMA(1, 0, At, B0); PG8_MMA(1, 1, At, B1); PG8_BAR; PG8_SCHED;
            } else if constexpr (SP2) {
            PG8_LDB(B0, 0, 0); PG8_LDB(B1, 0, 1); PG8_SCHED; PG8_LDA(At, 0, 0); PG8_STAGE_A(PG8_SA(1, 1), a1 + hstep, voffA);
            PG8_WAIT_V(8); PG8_WAIT_L(0); PG8_BAR; PG8_MMA(0, 0, At, B0); PG8_MMA(0, 1, At, B1); PG8_BAR; PG8_SCHED;
            PG8_LDA(At, 0, 1); PG8_STAGE_B(PG8_SB(0, 0), b2, voffB); PG8_STAGE_B(PG8_SB(0, 1), b2 + hstepB, voffB); PG8_STAGE_A(PG8_SA(0, 0), a2, voffA);
            PG8_WAIT_V(8); PG8_WAIT_L(0); PG8_BAR; PG8_MMA(1, 0, At, B0); PG8_MMA(1, 1, At, B1); PG8_BAR; PG8_SCHED;
            PG8_LDB(B0, 1, 0); PG8_LDB(B1, 1, 1); PG8_SCHED; PG8_LDA(At, 1, 0); PG8_STAGE_A(PG8_SA(0, 1), a2 + hstep, voffA);
            PG8_WAIT_V(8); PG8_WAIT_L(0); PG8_BAR; PG8_MMA(0, 0, At, B0); PG8_MMA(0, 1, At, B1); PG8_BAR; PG8_SCHED;
            PG8_LDA(At, 1, 1); PG8_STAGE_B(PG8_SB(1, 0), b3, voffB); PG8_STAGE_B(PG8_SB(1, 1), b3 + hstepB, voffB); PG8_STAGE_A(PG8_SA(1, 0), a3, voffA);
            PG8_WAIT_V(8); PG8_WAIT_L(0); PG8_BAR; PG8_MMA(1, 0, At, B0); PG8_MMA(1, 1, At, B1); PG8_BAR; PG8_SCHED;
            } else {
            PG8_LDB(B0, 0, 0); PG8_SCHED; PG8_LDA(At, 0, 0); PG8_STAGE_A(PG8_SA(1, 1), a1 + hstep, voffA);
            PG8_WAIT_L(8); PG8_BAR; PG8_WAIT_L(0); PG8_MMA(0, 0, At, B0); PG8_BAR; PG8_SCHED;
            PG8_LDB(B1, 0, 1); PG8_STAGE_B(PG8_SB(0, 0), b2, voffB);
            PG8_BAR; PG8_WAIT_L(0); PG8_MMA(0, 1, At, B1); PG8_BAR;
            PG8_LDA(At, 0, 1); PG8_STAGE_A(PG8_SA(0, 0), a2, voffA);
            PG8_BAR; PG8_WAIT_L(0); PG8_MMA(1, 0, At, B0); PG8_BAR; PG8_SCHED;
            PG8_STAGE_B(PG8_SB(0, 1), b2 + hstepB, voffB);
            PG8_WAIT_V(6); PG8_BAR; PG8_MMA(1, 1, At, B1); PG8_BAR;
            PG8_LDB(B0, 1, 0); PG8_SCHED; PG8_LDA(At, 1, 0); PG8_STAGE_A(PG8_SA(0, 1), a2 + hstep, voffA);
            PG8_WAIT_L(8); PG8_BAR; PG8_WAIT_L(0); PG8_MMA(0, 0, At, B0); PG8_BAR; PG8_SCHED;
            PG8_LDB(B1, 1, 1); PG8_STAGE_B(PG8_SB(1, 0), b3, voffB);
            PG8_BAR; PG8_WAIT_L(0); PG8_MMA(0, 1, At, B1); PG8_BAR;
            PG8_LDA(At, 1, 1); PG8_STAGE_A(PG8_SA(1, 0), a3, voffA);
            PG8_BAR; PG8_WAIT_L(0); PG8_MMA(1, 0, At, B0); PG8_BAR; PG8_SCHED;
            PG8_STAGE_B(PG8_SB(1, 1), b3 + hstepB, voffB);
            PG8_WAIT_V(6); PG8_BAR; PG8_MMA(1, 1, At, B1); PG8_BAR;
            }
        }
        if constexpr (F8 || I8) asm volatile("s_nop 15\n\ts_nop 15" ::: "memory");
        if constexpr (ALIGN_EPI) { if (wr == 0) PG8_BAR; }
        if constexpr (!Epi::AFTER_DRAIN) { int tl_ = tid; asm volatile("" : "+v"(tl_)); E(acc, cur, wr, wc, tl_ & 15, (tl_ >> 4) & 3); S.done(cur); }
        if (!has_next) break;
#pragma unroll
        for (int a = 0; a < 2; ++a)
#pragma unroll
            for (int b = 0; b < 2; ++b)
#pragma unroll
                for (int m = 0; m < 4; ++m)
#pragma unroll
                    for (int n = 0; n < 2; ++n) acc[a][b][m][n] = zero4();
        cur = nxt; cA = nA; cB = nB; ++ui;
        if constexpr (ALIGN_EPI) { if (wr == 1) PG8_BAR; }
    }
    PG8_WAIT_V(0);
    if constexpr (!ALIGN_EPI) { if (wr == 0) PG8_BAR; }
    PG8_BAR;
    if constexpr (Epi::AFTER_DRAIN) { E.fused(acc, cur, wr, wc, fr, fq, lds, wid, lane); S.done(cur); }
#undef PG8_SA
#undef PG8_SB
#undef PG8_STAGE
#undef PG8_STAGE_A
#undef PG8_STAGE_B
#undef PG8_LDA
#undef PG8_LDB
#undef PG8_MMA
#undef PG8_WAIT_V
#undef PG8_WAIT_L
#undef PG8_BAR
#undef PG8_SCHED
}
}
constexpr int NWAVES = 8;
#ifndef MK_PER_PHASE
#define MK_PER_PHASE 0
#endif
constexpr int D = 4096, BATCH = 4, SEQ = 4096, M = BATCH * SEQ, DEPTH = 4, IN_W = 19472, NZ = 19456;
constexpr int OFF_GQ = 0, OFF_GK = 1024, OFF_GV = 2048, OFF_GG = 4096, OFF_SQ = 6144, OFF_SK = 8192, OFF_SV = 8704, OFF_SG = 9216, OFF_GA = 11264, OFF_GB = 15360;
constexpr int LDZ = NZ;
#ifndef NZ_BF_COLS
#define NZ_BF_COLS 3072
#endif
constexpr int NZ_BF = NZ_BF_COLS, NZ_F8 = NZ - NZ_BF;
constexpr float QC_W = 4.0f, QC_X0 = 4.25f, QC_XP = 4.5f, QC_M = 4.3f;
constexpr float W8_SCALE = 64.0f, AB8_SCALE = 8.0f;
constexpr float RMS_EPS = 1e-6f;
constexpr int N_PHASES = 2 + 6 * DEPTH;
constexpr size_t MiB = 1u << 20;
constexpr size_t WS_CTL = 0, CTL_ZERO_BYTES = 1 * MiB;
constexpr size_t WS_WIN = 1 * MiB, WS_WDEC = 609 * MiB, WS_WGLA = 610 * MiB, WS_WSWA = 674 * MiB, WS_WOUT = 738 * MiB;
constexpr size_t WS_XRES = 866 * MiB, WS_XB = 1122 * MiB, WS_Z = 1250 * MiB, WS_GDEC = 1858 * MiB;
constexpr size_t WS_QT = 1859 * MiB, WS_KT = 1891 * MiB, WS_QI = 1923 * MiB, WS_U = 1955 * MiB, WS_SP = 2083 * MiB, WS_DECAY = 2211 * MiB;
constexpr size_t WS_AA = 2212 * MiB, WS_AB = 2276 * MiB, WS_TMP = 2340 * MiB, WS_MERGED = 2596 * MiB, WS_SSQP = 2724 * MiB, WS_X8 = 2936 * MiB, WS_SX = 3000 * MiB, WS_WIN8 = 3001 * MiB, WS_GT = 3321 * MiB, WS_END = 3577 * MiB;
static_assert(WS_WIN8 + (size_t)DEPTH * NZ_F8 * D <= WS_GT && WS_SSQP + 4 * MiB <= WS_X8, "int8 weight copies");
static_assert(WS_WIN + (size_t)DEPTH * NZ * D * 2 <= WS_WDEC && WS_Z + (size_t)M * NZ * 2 <= WS_GDEC && WS_XRES + (size_t)M * D * 4 <= WS_XB, "ws map");
constexpr int CW_TMO = 0, CW_BAR = 4096, CW_TS = 8192;
static_assert(CW_BAR + 3456 <= CW_TS && (size_t)(CW_TS + DEPTH * 256 * 8) * 4 <= CTL_ZERO_BYTES, "CTL map");
constexpr int RING_BYTES = 131072, LDSCTL_OFF = RING_BYTES, MISC_OFF = LDSCTL_OFF + 320, RS_OFF = LDSCTL_OFF + 1024, RS2_OFF = LDSCTL_OFF + 2048, WQ_OFF = LDSCTL_OFF + 3072, RS3_OFF = LDSCTL_OFF + 4096, MQ_OFF = LDSCTL_OFF + 3072 + 512, LDS_BYTES = 147456;

#define GAS __attribute__((address_space(1)))
#define LAS __attribute__((address_space(3)))
typedef unsigned short bf16;
typedef unsigned v4u __attribute__((ext_vector_type(4)));
typedef unsigned v2u __attribute__((ext_vector_type(2)));
typedef float f32x4 __attribute__((ext_vector_type(4)));
typedef short bf16x8 __attribute__((ext_vector_type(8)));
typedef short s16x4 __attribute__((ext_vector_type(4)));
typedef GAS unsigned gu32;
#define RLX_AGENT __ATOMIC_RELAXED, __HIP_MEMORY_SCOPE_AGENT
#define LDS_WAIT() asm volatile("s_waitcnt lgkmcnt(0)" ::: "memory")
__device__ __forceinline__ unsigned f2bf(float f) { unsigned u = __builtin_bit_cast(unsigned, f); return (u + 0x7fffu + ((u >> 16) & 1u)) >> 16; }
__device__ __forceinline__ unsigned pk2(float lo, float hi) { return pg8::cvt_pk_bf16(lo, hi); }
__device__ __forceinline__ float bf2f(unsigned short b) { return __uint_as_float(((unsigned)b) << 16); }
__device__ __forceinline__ float bflo(unsigned w) { return __uint_as_float(w << 16); }
__device__ __forceinline__ float bfhi(unsigned w) { return __uint_as_float(w & 0xffff0000u); }
#define MFMA16(a, b, c) __builtin_amdgcn_mfma_f32_16x16x32_bf16((a), (b), (c), 0, 0, 0)
__device__ __forceinline__ bf16x8 tr_frag(LAS unsigned char* base, int rs, int k0, int n0, int lane) {
    const int g = lane >> 4, q = (lane & 15) >> 2, p = lane & 3;
    LAS unsigned char* a = base + (k0 + 8 * g + q) * rs + (n0 + 4 * p) * 2;
    const s16x4 lo = __builtin_amdgcn_ds_read_tr16_b64_v4i16((LAS s16x4*)a);
    const s16x4 hi = __builtin_amdgcn_ds_read_tr16_b64_v4i16((LAS s16x4*)(a + 4 * rs));
    return (bf16x8){lo[0], lo[1], lo[2], lo[3], hi[0], hi[1], hi[2], hi[3]};
}
#define XB_TMO      128
#define XB_XCNT(j)  (256  + 64 * (j))
#define XB_XSUB(j)  (1280 + 64 * (j))
#define XB_XGEN(j)  (2304 + 64 * (j))
#define XB_TOP      3328
#define XB_TOPGEN   3392
#define XCD_BAR_WORDS 3456
#define XB_SPIN_CAP (1u << 18)

__device__ __forceinline__ unsigned xb_ld(unsigned* p)              { return __hip_atomic_load(p, __ATOMIC_RELAXED, __HIP_MEMORY_SCOPE_AGENT); }
__device__ __forceinline__ unsigned xb_add(unsigned* p, unsigned v) { return __hip_atomic_fetch_add(p, v, __ATOMIC_RELAXED, __HIP_MEMORY_SCOPE_AGENT); }
__device__ __forceinline__ unsigned xb_xcc_id() { return (unsigned)__builtin_amdgcn_s_getreg((3 << 11) | 20) & 0xFu; }
#define XB_SPIN(cond, bar) do { unsigned _sp = 0; while (cond) { __builtin_amdgcn_s_sleep(1); \
    if ((++_sp & 255u) == 0u) { if (xb_ld(&(bar)[XB_TMO])) break; if (_sp > XB_SPIN_CAP) { atomicAdd(&(bar)[XB_TMO], 1u); break; } } } } while (0)

struct XcdBarrier {
    unsigned* bar; unsigned x;
    volatile LAS unsigned* st;
};

__device__ __forceinline__ XcdBarrier xcd_barrier_post(unsigned* bar, volatile LAS unsigned* st) {
    XcdBarrier b; b.bar = bar; b.x = xb_xcc_id(); b.st = st;
    if (threadIdx.x == 0) (void)xb_add(&bar[XB_XCNT(b.x)], 1u);
    return b;
}
__device__ __forceinline__ void xcd_barrier_complete(unsigned* bar, unsigned x, unsigned& nloc, unsigned& nx) {
    const unsigned G = gridDim.x * gridDim.y * gridDim.z;
    unsigned sum, cnt, mine, sp = 0u;
    for (;;) {
        sum = 0u; cnt = 0u; mine = 0u;
#pragma unroll
        for (unsigned j = 0; j < 16; ++j) { const unsigned c = xb_ld(&bar[XB_XCNT(j)]); sum += c; cnt += (c > 0u) ? 1u : 0u; mine = (j == x) ? c : mine; }
        if (sum == G) break;
        __builtin_amdgcn_s_sleep(1);
        if ((++sp & 255u) == 0u) { if (xb_ld(&bar[XB_TMO])) break; if (sp > XB_SPIN_CAP) { atomicAdd(&bar[XB_TMO], 1u); break; } }
    }
    nloc = mine > 0u ? mine : 1u; nx = cnt > 0u ? cnt : 1u;
}

__device__ __forceinline__ void xcd_barrier(const XcdBarrier& b) {
    asm volatile("s_waitcnt vmcnt(0)" ::: "memory");
    __syncthreads();
    if (threadIdx.x == 0) {
        unsigned* bar = b.bar;
        __builtin_amdgcn_s_waitcnt(0);
        unsigned nloc = b.st[0], nx = b.st[1];
        if (nloc == 0u) { xcd_barrier_complete(bar, b.x, nloc, nx); b.st[0] = nloc; b.st[1] = nx; }
        const unsigned old = xb_add(&bar[XB_XSUB(b.x)], 1u);
        const unsigned gen = old / nloc;
        if (old + 1u == (gen + 1u) * nloc) {
            __builtin_amdgcn_fence(__ATOMIC_RELEASE, "agent");
            asm volatile("s_waitcnt vmcnt(0)" ::: "memory");
            const unsigned og = xb_add(&bar[XB_TOP], 1u);
            const unsigned tg = og / nx;
            if (og + 1u == (tg + 1u) * nx) xb_add(&bar[XB_TOPGEN], 1u);
            else XB_SPIN(xb_ld(&bar[XB_TOPGEN]) == tg, bar);
            __builtin_amdgcn_fence(__ATOMIC_ACQUIRE, "agent");
            xb_add(&bar[XB_XGEN(b.x)], 1u);
            asm volatile("s_waitcnt vmcnt(0)" ::: "memory");
        } else {
            XB_SPIN(xb_ld(&bar[XB_XGEN(b.x)]) == gen, bar);
            __builtin_amdgcn_fence(__ATOMIC_ACQUIRE, "agent");
            asm volatile("s_waitcnt vmcnt(0)" ::: "memory");
        }
    }
    __syncthreads();
}
struct Frame {
    LAS unsigned char* lds; volatile LAS unsigned* MISC; gu32* ctl; unsigned char* ws;
    int tid, lane, wave, G;
    const float *x, *norm_g, *w_in, *b_gates, *w_up, *b_dec, *gla_g, *sinks, *w_gla, *w_swa, *w_out, *fin_g; float* out;
};
__device__ __forceinline__ float wave_sum(float v, int lane_) {
#pragma unroll
    for (int o = 1; o < 64; o <<= 1) v += pg8::shx(v, lane_, o);
    return v;
}

__device__ __forceinline__ void p0_transpose_item(const float* W, size_t ldw, int scol, int K, bf16* WT, int drow, const float* gain, float scale, int mode  , LAS unsigned char* scr, int kb, int lane) {
    const bool f8 = mode != 0, had = mode == 3; if (mode == 3) mode = 2;
    const int k0 = 64 * kb, lr = lane >> 4, lc = lane & 15;
    f32x4 v[16];
#pragma unroll
    for (int i = 0; i < 16; ++i) v[i] = *(const GAS f32x4*)(W + (size_t)(k0 + 4 * i + lr) * ldw + scol + 4 * lc);
    if (had) {
#pragma unroll
        for (int i = 0; i < 16; ++i) {
#pragma unroll
            for (int e = 0; e < 4; ++e) { const float o = pg8::shx(v[i][e], lane, 16); v[i][e] = (lane & 16) ? o - v[i][e] : v[i][e] + o; }
#pragma unroll
            for (int e = 0; e < 4; ++e) { const float o = pg8::shx(v[i][e], lane, 32); v[i][e] = (lane & 32) ? o - v[i][e] : v[i][e] + o; } }
#pragma unroll
        for (int i = 0; i < 16; i += 2) { const f32x4 a = v[i] + v[i + 1], b = v[i] - v[i + 1]; v[i] = a; v[i + 1] = b; }
    }
#pragma unroll
    for (int i = 0; i < 16; ++i) { const float gk = gain ? gain[k0 + 4 * i + lr] * scale : scale; f32x4 a = v[i] * gk;
        v2u o;
        if (mode == 2) { unsigned u[4];
            _Pragma("unroll") for (int e = 0; e < 4; ++e) u[e] = __float_as_uint(__builtin_amdgcn_fmed3f(__builtin_fmaf(v[i][e], gk, 12582912.0f), 12582912.0f - 127.0f, 12582912.0f + 127.0f));
            o.x = __builtin_amdgcn_perm(u[1], u[0], 0x05040100u); o.y = __builtin_amdgcn_perm(u[3], u[2], 0x05040100u); }
        else { o.x = pk2(a[0], a[1]); o.y = pk2(a[2], a[3]); }
        *(LAS v2u*)(scr + (4 * i + lr) * 144 + 8 * lc) = o; }
    LDS_WAIT(); asm volatile("" ::: "memory");
#pragma unroll
    for (int kh = 0; kh < 2; ++kh)
#pragma unroll
        for (int nq = 0; nq < 4; ++nq) { const bf16x8 t = tr_frag(scr, 144, 32 * kh, 16 * nq, lane);
            if (!f8) *(GAS bf16x8*)(WT + (size_t)(drow + 16 * nq + lc) * K + k0 + 32 * kh + 8 * lr) = t;
            else if (mode == 2) { const v4u tt = __builtin_bit_cast(v4u, t); v2u o; o.x = __builtin_amdgcn_perm(tt.y, tt.x, 0x06040200u); o.y = __builtin_amdgcn_perm(tt.w, tt.z, 0x06040200u);
                   *(GAS v2u*)((unsigned char*)WT + (size_t)(drow + 16 * nq + lc) * K + pg8::kperm8(k0 + 32 * kh + 8 * lr)) = o; }
            else { int q0 = __builtin_amdgcn_cvt_pk_fp8_f32(bf2f((unsigned short)t[0]), bf2f((unsigned short)t[1]), 0, false); q0 = __builtin_amdgcn_cvt_pk_fp8_f32(bf2f((unsigned short)t[2]), bf2f((unsigned short)t[3]), q0, true);
                   int q1 = __builtin_amdgcn_cvt_pk_fp8_f32(bf2f((unsigned short)t[4]), bf2f((unsigned short)t[5]), 0, false); q1 = __builtin_amdgcn_cvt_pk_fp8_f32(bf2f((unsigned short)t[6]), bf2f((unsigned short)t[7]), q1, true);
                   v2u o; o.x = (unsigned)q0; o.y = (unsigned)q1; *(GAS v2u*)((unsigned char*)WT + (size_t)(drow + 16 * nq + lc) * K + k0 + 32 * kh + 8 * lr) = o; } }
    LDS_WAIT(); asm volatile("" ::: "memory");
}
__device__ __forceinline__ void p0_prologue(Frame& F) {
    LAS unsigned char* scr = F.lds + F.wave * 16384;
    const int gw = blockIdx.x * NWAVES + F.wave, NGW = F.G * NWAVES;
    LAS float* wq = (LAS float*)(F.lds + WQ_OFF); LAS float* wred = (LAS float*)(F.lds + WQ_OFF + 64);
    for (int l = 0; l < DEPTH; ++l) { float s = 0.f;
#pragma unroll 4
        for (int j = 0; j < 16; ++j) { const int k = 256 * j; const float gk = F.norm_g[l * D + k]; const float a = F.w_in[((size_t)l * D + k) * IN_W + 8192 + 2 * F.tid] * gk, b = F.w_in[((size_t)l * D + k) * IN_W + 8192 + 2 * F.tid + 1] * gk; s += a * a + b * b; }
        s = wave_sum(s, F.lane); if (F.lane == 0) wred[l * 8 + F.wave] = s;
        float s2 = 0.f;
#pragma unroll 4
        for (int j = 0; j < 16; ++j) { const float a = F.w_out[((size_t)l * D + 256 * j) * D + 2 * F.tid], b = F.w_out[((size_t)l * D + 256 * j) * D + 2 * F.tid + 1]; s2 += a * a + b * b; }
        s2 = wave_sum(s2, F.lane); if (F.lane == 0) wred[(DEPTH + l) * 8 + F.wave] = s2; }
    __syncthreads();
    if (F.tid < 2 * DEPTH) { float s = 0.f;
#pragma unroll
        for (int w_ = 0; w_ < 8; ++w_) s += wred[F.tid * 8 + w_];
        const float q = 127.0f / QC_W * __builtin_amdgcn_rsqf(s * (1.0f / 16384.0f) + 1e-30f); wq[F.tid] = q; ((float*)(F.ws + WS_SX))[2 * M + F.tid] = q; }
    __syncthreads();
    constexpr int I_IN = 64 * 304, I_GLA = 32 * 64, I_OUT = 64 * 64, I_L = I_IN + 2 * I_GLA + I_OUT;
    for (int it = gw; it < DEPTH * I_L; it += NGW) {
        const int l = it / I_L; int r = it - l * I_L;
        if (r < I_IN) { const int kb = r / 304, nb = r - kb * 304; const int scol = nb < 96 ? nb * 64 : nb * 64 + 16;
            if (nb < NZ_BF / 64) p0_transpose_item(F.w_in + (size_t)l * D * IN_W, IN_W, scol, D, (bf16*)(F.ws + WS_WIN) + (size_t)l * NZ * D, nb * 64, F.norm_g + l * D, 1.0f, 0, scr, kb, F.lane);
            else p0_transpose_item(F.w_in + (size_t)l * D * IN_W, IN_W, scol, D, (bf16*)(F.ws + WS_WIN8 + (size_t)l * NZ_F8 * D), nb * 64 - NZ_BF, F.norm_g + l * D, wq[l], 2, scr, kb, F.lane);
            continue; }
        r -= I_IN;
        if (r < I_GLA) { const int kb = r >> 6, nb = r & 63; p0_transpose_item(F.w_gla + (size_t)l * 2048 * D, D, nb * 64, 2048, (bf16*)(F.ws + WS_WGLA) + (size_t)l * D * 2048, nb * 64, nullptr, 1.0f, 0, scr, kb, F.lane); continue; }
        r -= I_GLA;
        if (r < I_GLA) { const int kb = r >> 6, nb = r & 63; p0_transpose_item(F.w_swa + (size_t)l * 2048 * D, D, nb * 64, 2048, (bf16*)(F.ws + WS_WSWA + (size_t)l * D * 2048), nb * 64, nullptr, W8_SCALE, 1, scr, kb, F.lane); continue; }
        r -= I_GLA;
        { const int kb = r >> 6, nb = r & 63; p0_transpose_item(F.w_out + (size_t)l * D * D, D, nb * 64, D, (bf16*)(F.ws + WS_WOUT + (size_t)l * D * D), nb * 64, nullptr, wq[DEPTH + l] * 0.35355339f, 3, scr, kb, F.lane); }
    }
    for (int idx = blockIdx.x * (NWAVES * 64) + F.tid; idx < DEPTH * 16 * D; idx += F.G * NWAVES * 64) {
        const int l = idx >> 16, j = (idx >> 12) & 15, k = idx & 4095;
        ((bf16*)(F.ws + WS_WDEC))[idx] = (bf16)f2bf(F.norm_g[l * D + k] * F.w_in[((size_t)l * D + k) * IN_W + 6144 + j]);
    }
    float* ssqp = (float*)(F.ws + WS_SSQP); float* sx0 = (float*)(F.ws + WS_SX);
    for (int m = gw; m < M; m += NGW) {
        const GAS f32x4* xr = (const GAS f32x4*)(F.x + (size_t)m * D) + F.lane; GAS v2u* o8 = (GAS v2u*)((bf16*)(F.ws + WS_XB) + (size_t)m * D) + F.lane; GAS unsigned* q8 = (GAS unsigned*)(F.ws + WS_X8 + (size_t)m * D) + F.lane; float s = 0.f;
        v2u w[16];
#pragma unroll
        for (int j = 0; j < 16; ++j) { const f32x4 v = xr[64 * j]; w[j].x = pk2(v.x, v.y); w[j].y = pk2(v.z, v.w); o8[64 * j] = w[j];
            const float r0 = bflo(w[j].x), r1 = bfhi(w[j].x), r2 = bflo(w[j].y), r3 = bfhi(w[j].y); s += (r0 * r0 + r1 * r1) + (r2 * r2 + r3 * r3); }
        s = wave_sum(s, F.lane); ssqp[(size_t)m * 64 + F.lane] = (F.lane == 0) ? s : 0.f;
        const float q = 127.0f / QC_X0 * __builtin_amdgcn_rsqf(s * (1.0f / D) + RMS_EPS);
        if (F.lane == 0) sx0[m] = q;
#pragma unroll
        for (int j = 0; j < 16; ++j) { const int c = 4 * F.lane + 256 * j; *(GAS unsigned*)(F.ws + WS_X8 + (size_t)m * D + pg8::kperm8(c & ~7) + (c & 7)) = pg8::q8x4(bflo(w[j].x), bfhi(w[j].x), bflo(w[j].y), bfhi(w[j].y), q); }
    }
}
__device__ __forceinline__ void final_norm(Frame& F) {
    const int gw = blockIdx.x * NWAVES + F.wave, NGW = F.G * NWAVES;
    const bf16* X = (const bf16*)(F.ws + WS_XB);
    for (int m = gw; m < M; m += NGW) {
        const GAS v4u* xr = (const GAS v4u*)(X + (size_t)m * D) + F.lane; const GAS f32x4* gr = (const GAS f32x4*)F.fin_g + 2 * F.lane; GAS f32x4* orow = (GAS f32x4*)(F.out + (size_t)m * D) + 2 * F.lane;
        v4u v[8]; float s = 0.f;
#pragma unroll
        for (int j = 0; j < 8; ++j) { v[j] = xr[64 * j]; const float r0 = bflo(v[j].x), r1 = bfhi(v[j].x), r2 = bflo(v[j].y), r3 = bfhi(v[j].y), r4 = bflo(v[j].z), r5 = bfhi(v[j].z), r6 = bflo(v[j].w), r7 = bfhi(v[j].w);
            s += ((r0 * r0 + r1 * r1) + (r2 * r2 + r3 * r3)) + ((r4 * r4 + r5 * r5) + (r6 * r6 + r7 * r7)); }
        const float rs = __builtin_amdgcn_rsqf(wave_sum(s, F.lane) * (1.0f / D) + RMS_EPS);
#pragma unroll
        for (int j = 0; j < 8; ++j) { const f32x4 g0 = gr[128 * j], g1 = gr[128 * j + 1];
            orow[128 * j] = (f32x4){bflo(v[j].x) * rs * g0[0], bfhi(v[j].x) * rs * g0[1], bflo(v[j].y) * rs * g0[2], bfhi(v[j].y) * rs * g0[3]};
            orow[128 * j + 1] = (f32x4){bflo(v[j].z) * rs * g1[0], bfhi(v[j].z) * rs * g1[1], bflo(v[j].w) * rs * g1[2], bfhi(v[j].w) * rs * g1[3]}; }
    }
}
__device__ __forceinline__ void gdec_phase(Frame& F, int l) {
    LAS float* red = (LAS float*)F.lds;
    const bf16* Wd = (const bf16*)(F.ws + WS_WDEC) + (size_t)l * 16 * D; const bf16* XBp = (const bf16*)(F.ws + WS_XB); const float* ssqp = (const float*)(F.ws + WS_SSQP); float* GD = (float*)(F.ws + WS_GDEC);
    const int lane = F.lane, fr = lane & 15, fq = lane >> 4;
    for (int rb = blockIdx.x; rb < M / 64; rb += F.G) {
        const int r0 = (F.G == 256) ? ((8 * (rb & 7) + ((rb >> 3) & 7)) * 256 + (rb >> 6) * 64) : rb * 64, k0 = F.wave * 512;
        f32x4 acc[4];
#pragma unroll
        for (int rt = 0; rt < 4; ++rt) acc[rt] = (f32x4){0.f, 0.f, 0.f, 0.f};
#pragma unroll 4
        for (int ks = 0; ks < 16; ++ks) { const int k = k0 + ks * 32 + 8 * fq;
            const bf16x8 X = *(const GAS bf16x8*)(Wd + (size_t)fr * D + k);
#pragma unroll
            for (int rt = 0; rt < 4; ++rt) { const bf16x8 Y = *(const GAS bf16x8*)(XBp + (size_t)(r0 + rt * 16 + fr) * D + k); acc[rt] = MFMA16(X, Y, acc[rt]); } }
#pragma unroll
        for (int rt = 0; rt < 4; ++rt) *(LAS f32x4*)(red + ((F.wave * 4 + rt) * 64 + lane) * 4) = acc[rt];
        __syncthreads();
        if (F.tid < 256) { const int rt = F.tid >> 6, ln = F.tid & 63; f32x4 s = (f32x4){0.f, 0.f, 0.f, 0.f};
#pragma unroll
            for (int w = 0; w < 8; ++w) s += *(LAS f32x4*)(red + ((w * 4 + rt) * 64 + ln) * 4);
            const int row = r0 + rt * 16 + (ln & 15); const float rs = pg8::row_rstd(ssqp, row);
            *(GAS f32x4*)(GD + (size_t)row * 16 + 4 * (ln >> 4)) = s * rs; }
        __syncthreads();
    }
}
constexpr int NGROUP = BATCH * 8 * 8;
constexpr int GA_GD = 0, GA_BL = 4096, GA_KS = GA_BL + 64 * 528, GA_V = GA_KS + 64 * 272, GA_SEG = GA_V + 64 * 528, GA_BRL = GA_SEG + 2048, GA_EB = GA_BRL + 1024, GA_EL = GA_EB + 512, GA_END = GA_EL + 512;
static_assert(GA_END <= RING_BYTES, "GLA-a LDS map");
__device__ __forceinline__ void gla_a_phase(Frame& F, int l) {
    LAS unsigned char* lds = F.lds;
    LAS float* gd = (LAS float*)(lds + GA_GD); LAS float* bL = (LAS float*)(lds + GA_BL); LAS unsigned char* ksL = lds + GA_KS; LAS unsigned char* Vl = lds + GA_V; LAS float* seg = (LAS float*)(lds + GA_SEG); LAS float* brl = (LAS float*)(lds + GA_BRL); LAS float* ebL = (LAS float*)(lds + GA_EB); LAS float* elL = (LAS float*)(lds + GA_EL);
    const int tid = F.tid, lane = F.lane, w = F.wave, d = tid & 127, tq = tid >> 7, fr = lane & 15, fq = lane >> 4;
    const bf16* Z = (const bf16*)(F.ws + WS_Z); const float* GD = (const float*)(F.ws + WS_GDEC);
    bf16* QT = (bf16*)(F.ws + WS_QT); bf16* KT = (bf16*)(F.ws + WS_KT); bf16* SLOC = (bf16*)(F.ws + WS_U);
    float* EBREF = (float*)(F.ws + WS_QI); float* ELR = EBREF + (size_t)BATCH * 8 * 64 * 128; float* DG = ELR + (size_t)BATCH * 8 * 64 * 128;
    const float SC = 0.08838834764831845f;
    f32x4 pgd; v4u pv[4], pq[2], pk[2];
#define GA_FETCH(item_) do { const int n_ = (item_) & 63, h_ = ((item_) >> 6) & 7, b_ = (item_) >> 9, t0_ = b_ * SEQ + n_ * 64; \
        pgd = *(const GAS f32x4*)(GD + (size_t)t0_ * 16 + (tid & 255) * 4); \
        _Pragma("unroll") for (int i = 0; i < 4; ++i) { const int c = tid + 512 * i, t = c >> 5, dv0 = (c & 31) * 8; pv[i] = *(const GAS v4u*)(Z + (size_t)(t0_ + t) * LDZ + OFF_GV + h_ * 256 + dv0); } \
        _Pragma("unroll") for (int i = 0; i < 2; ++i) { const int id = tid + 512 * i, t = id >> 4, d0 = (id & 15) * 8; const size_t zr = (size_t)(t0_ + t) * LDZ + h_ * 128 + d0; pq[i] = *(const GAS v4u*)(Z + zr + OFF_GQ); pk[i] = *(const GAS v4u*)(Z + zr + OFF_GK); } } while (0)
    { const int g0_ = (int)blockIdx.x < NGROUP ? (int)blockIdx.x : NGROUP - 1; GA_FETCH((g0_ >> 3) * 64 + (g0_ & 7) * 8); }
    for (int gi = blockIdx.x; gi < NGROUP; gi += F.G) {
        const int bh = gi >> 3, g = gi & 7, h = bh & 7, b = bh >> 3;
        float wu[16];
#pragma unroll
        for (int r = 0; r < 16; ++r) wu[r] = F.w_up[(size_t)(l * 16 + r) * 1024 + h * 128 + d];
        const float bias = F.b_dec[l * 1024 + h * 128 + d];
        f32x4 acc[8][2];
#pragma unroll
        for (int i = 0; i < 8; ++i) { acc[i][0] = (f32x4){0.f, 0.f, 0.f, 0.f}; acc[i][1] = (f32x4){0.f, 0.f, 0.f, 0.f}; }
        float sumbl = 0.f;
#pragma unroll 1
        for (int j = 0; j < 8; ++j) {
            const int n = 8 * g + j, item = bh * 64 + n, t0 = b * SEQ + n * 64;
            if (tid < 256) *(LAS f32x4*)(gd + tid * 4) = pgd;
#pragma unroll
            for (int i = 0; i < 4; ++i) { const int c = tid + 512 * i, t = c >> 5, dv0 = (c & 31) * 8; *(LAS v4u*)(Vl + t * 528 + dv0 * 2) = pv[i]; }
            v4u q8[2], k8[2];
#pragma unroll
            for (int i = 0; i < 2; ++i) { q8[i] = pq[i]; k8[i] = pk[i]; }
            __syncthreads();
            { const int nx = (j < 7) ? item + 1 : ((gi + F.G) >> 3) * 64 + ((gi + F.G) & 7) * 8; if (j < 7 || gi + F.G < NGROUP) GA_FETCH(nx); }
            float c[16]; float run = 0.f;
#pragma unroll
            for (int i = 0; i < 16; ++i) { const int t = 16 * tq + i; float lg = bias; const f32x4 g0 = *(LAS f32x4*)(gd + t * 16), g1 = *(LAS f32x4*)(gd + t * 16 + 4), g2 = *(LAS f32x4*)(gd + t * 16 + 8), g3 = *(LAS f32x4*)(gd + t * 16 + 12);
                lg += g0[0] * wu[0] + g0[1] * wu[1] + g0[2] * wu[2] + g0[3] * wu[3]; lg += g1[0] * wu[4] + g1[1] * wu[5] + g1[2] * wu[6] + g1[3] * wu[7];
                lg += g2[0] * wu[8] + g2[1] * wu[9] + g2[2] * wu[10] + g2[3] * wu[11]; lg += g3[0] * wu[12] + g3[1] * wu[13] + g3[2] * wu[14] + g3[3] * wu[15];
                const float ls = fminf(lg, 0.f) - __logf(1.0f + __expf(-fabsf(lg))); const float la = fmaxf(ls * (1.0f / 16.0f), -1.0f); run += la; c[i] = run; }
            seg[tq * 128 + d] = run;
            __syncthreads();
            float pre = 0.f;
            if (tq > 0) pre += seg[d]; if (tq > 1) pre += seg[128 + d]; if (tq > 2) pre += seg[256 + d];
#pragma unroll
            for (int i = 0; i < 16; ++i) bL[(16 * tq + i) * 132 + d] = c[i] + pre;
            if (tq == 2) brl[d] = c[0] + pre;
            if (tq == 3) brl[128 + d] = c[15] + pre;
            __syncthreads();
            if (tid < 128) { const float bref = brl[tid], blast = brl[128 + tid], eb = __expf(bref), el = __expf(blast - bref); ebL[tid] = eb; elL[tid] = el; sumbl += blast;
                EBREF[(size_t)item * 128 + tid] = eb; ELR[(size_t)item * 128 + tid] = el; }
#pragma unroll
            for (int i = 0; i < 2; ++i) { const int id = tid + 512 * i, t = id >> 4, d0 = (id & 15) * 8;
                const f32x4 b0 = *(LAS f32x4*)(bL + t * 132 + d0), b1 = *(LAS f32x4*)(bL + t * 132 + d0 + 4), r0 = *(LAS f32x4*)(brl + d0), r1 = *(LAS f32x4*)(brl + d0 + 4);
                const float bb[8] = {b0[0], b0[1], b0[2], b0[3], b1[0], b1[1], b1[2], b1[3]}, rr[8] = {r0[0], r0[1], r0[2], r0[3], r1[0], r1[1], r1[2], r1[3]};
                const unsigned qw[4] = {q8[i].x, q8[i].y, q8[i].z, q8[i].w}, kw[4] = {k8[i].x, k8[i].y, k8[i].z, k8[i].w};
                float oq[8], ok[8];
#pragma unroll
                for (int jj = 0; jj < 8; ++jj) { const float q = ((jj & 1) ? bfhi(qw[jj >> 1]) : bflo(qw[jj >> 1])) * SC, k = (jj & 1) ? bfhi(kw[jj >> 1]) : bflo(kw[jj >> 1]);
                    const float e1 = __expf(bb[jj] - rr[jj]), e2 = __builtin_amdgcn_rcpf(e1);
                    oq[jj] = q * e1; ok[jj] = k * e2; }
                const size_t o = (size_t)(t0 + t) * 1024 + h * 128 + d0;
                v4u w4; w4.x = pk2(oq[0], oq[1]); w4.y = pk2(oq[2], oq[3]); w4.z = pk2(oq[4], oq[5]); w4.w = pk2(oq[6], oq[7]); *(GAS v4u*)(QT + o) = w4;
                w4.x = pk2(ok[0], ok[1]); w4.y = pk2(ok[2], ok[3]); w4.z = pk2(ok[4], ok[5]); w4.w = pk2(ok[6], ok[7]); *(GAS v4u*)(KT + o) = w4; *(LAS v4u*)(ksL + t * 272 + d0 * 2) = w4; }
            __syncthreads();
#pragma unroll
            for (int dkt = 0; dkt < 8; ++dkt) { const f32x4 e4 = *(LAS f32x4*)(ebL + dkt * 16 + 4 * fq); acc[dkt][0] *= e4; acc[dkt][1] *= e4; }
#pragma unroll
            for (int ks = 0; ks < 2; ++ks) { bf16x8 Y[2];
#pragma unroll
                for (int jv = 0; jv < 2; ++jv) Y[jv] = tr_frag(Vl, 528, ks * 32, (2 * w + jv) * 16, lane);
#pragma unroll
                for (int dkt = 0; dkt < 8; ++dkt) { const bf16x8 X = tr_frag(ksL, 272, ks * 32, dkt * 16, lane);
                    acc[dkt][0] = MFMA16(X, Y[0], acc[dkt][0]); acc[dkt][1] = MFMA16(X, Y[1], acc[dkt][1]); } }
#pragma unroll
            for (int dkt = 0; dkt < 8; ++dkt) { const f32x4 e4 = *(LAS f32x4*)(elL + dkt * 16 + 4 * fq); acc[dkt][0] *= e4; acc[dkt][1] *= e4; }
            __syncthreads();
        }
#pragma unroll
        for (int dkt = 0; dkt < 8; ++dkt)
#pragma unroll
            for (int jv = 0; jv < 2; ++jv) { const int dv = (2 * w + jv) * 16 + fr, dk = dkt * 16 + 4 * fq; const f32x4 a = acc[dkt][jv];
                v2u o; o.x = pk2(a[0], a[1]); o.y = pk2(a[2], a[3]); *(GAS v2u*)(SLOC + ((size_t)gi * 256 + dv) * 128 + dk) = o; }
        if (tid < 128) DG[(size_t)gi * 128 + tid] = __expf(sumbl);
    }
#undef GA_FETCH
}
__device__ __forceinline__ void gla_scan_phase(Frame& F) {
    const bf16* SLOC = (const bf16*)(F.ws + WS_U); bf16* SST = (bf16*)(F.ws + WS_SP); const float* DG = (const float*)(F.ws + WS_QI) + (size_t)2 * BATCH * 8 * 64 * 128;
    for (int idx = blockIdx.x * (NWAVES * 64) + F.tid; idx < BATCH * 8 * 256 * 16; idx += F.G * NWAVES * 64) {
        const int bh = idx >> 12, dv = (idx >> 4) & 255, dk0 = (idx & 15) * 8;
        float S[8]; float z0_; asm volatile("v_mov_b32 %0, 0" : "=v"(z0_));
#pragma unroll
        for (int j = 0; j < 8; ++j) S[j] = z0_;
#pragma unroll
        for (int g = 0; g < 8; ++g) { const size_t gi = (size_t)bh * 8 + g, off = (gi * 256 + dv) * 128 + dk0;
            const v4u u = *(const GAS v4u*)(SLOC + off); const f32x4 d0 = *(const GAS f32x4*)(DG + gi * 128 + dk0), d1 = *(const GAS f32x4*)(DG + gi * 128 + dk0 + 4);
            v4u o; o.x = pk2(S[0], S[1]); o.y = pk2(S[2], S[3]); o.z = pk2(S[4], S[5]); o.w = pk2(S[6], S[7]); *(GAS v4u*)(SST + off) = o;
            S[0] = d0[0] * S[0] + bflo(u.x); S[1] = d0[1] * S[1] + bfhi(u.x); S[2] = d0[2] * S[2] + bflo(u.y); S[3] = d0[3] * S[3] + bfhi(u.y);
            S[4] = d1[0] * S[4] + bflo(u.z); S[5] = d1[1] * S[5] + bfhi(u.z); S[6] = d1[2] * S[6] + bflo(u.w); S[7] = d1[3] * S[7] + bfhi(u.w); }
    }
}
constexpr int GC_QT = 0, GC_KT = 17408, GC_V = 34816, GC_AL = GC_V + 64 * 528, GC_PART = GC_AL + 64 * 144, GC_EB = GC_PART + 2048, GC_EL = GC_EB + 512, GC_END = GC_EL + 512;
static_assert(GC_END <= RING_BYTES, "GLA-c LDS map");
__device__ __forceinline__ void gla_c_phase(Frame& F, int l) {
    LAS unsigned char* lds = F.lds;
    LAS bf16* qT = (LAS bf16*)(lds + GC_QT); LAS bf16* kT = (LAS bf16*)(lds + GC_KT); LAS unsigned char* Vl = lds + GC_V; LAS bf16* Al = (LAS bf16*)(lds + GC_AL);
    LAS float* part = (LAS float*)(lds + GC_PART); LAS float* ebL = (LAS float*)(lds + GC_EB); LAS float* elL = (LAS float*)(lds + GC_EL);
    const int tid = F.tid, lane = F.lane, w = F.wave, fr = lane & 15, fq = lane >> 4;
    const bf16* Z = (const bf16*)(F.ws + WS_Z); const bf16* QT = (const bf16*)(F.ws + WS_QT); const bf16* KT = (const bf16*)(F.ws + WS_KT); const bf16* SST = (const bf16*)(F.ws + WS_SP);
    const float* EBREF = (const float*)(F.ws + WS_QI); const float* ELR = EBREF + (size_t)BATCH * 8 * 64 * 128;
    bf16* AA = (bf16*)(F.ws + WS_AA);
    v4u rq[2], rk[2], rv[4]; float reb, rel;
#define GC_FETCH(item_) do { const int n_ = (item_) & 63, h_ = ((item_) >> 6) & 7, b_ = (item_) >> 9, t0_ = b_ * SEQ + n_ * 64; \
        _Pragma("unroll") for (int i = 0; i < 2; ++i) { const int c = tid + 512 * i, t = c >> 4, d0 = (c & 15) * 8; const size_t g_ = (size_t)(t0_ + t) * 1024 + h_ * 128 + d0; rq[i] = *(const GAS v4u*)(QT + g_); rk[i] = *(const GAS v4u*)(KT + g_); } \
        _Pragma("unroll") for (int i = 0; i < 4; ++i) { const int c = tid + 512 * i, t = c >> 5, dv0 = (c & 31) * 8; rv[i] = *(const GAS v4u*)(Z + (size_t)(t0_ + t) * LDZ + OFF_GV + h_ * 256 + dv0); } \
        reb = EBREF[(size_t)(item_) * 128 + (tid & 127)]; rel = ELR[(size_t)(item_) * 128 + (tid & 127)]; } while (0)
    { const int g0_ = (int)blockIdx.x < NGROUP ? (int)blockIdx.x : NGROUP - 1; GC_FETCH((g0_ >> 3) * 64 + (g0_ & 7) * 8); }
    for (int gi = blockIdx.x; gi < NGROUP; gi += F.G) {
        const int bh = gi >> 3, g = gi & 7, h = bh & 7, b = bh >> 3;
        f32x4 Sa[8][2];
#pragma unroll
        for (int dkt = 0; dkt < 8; ++dkt)
#pragma unroll
            for (int jv = 0; jv < 2; ++jv) { const v2u s = *(const GAS v2u*)(SST + ((size_t)gi * 256 + (2 * w + jv) * 16 + fr) * 128 + dkt * 16 + 4 * fq); Sa[dkt][jv] = (f32x4){bflo(s.x), bfhi(s.x), bflo(s.y), bfhi(s.y)}; }
#pragma unroll 1
        for (int j = 0; j < 8; ++j) {
            const int n = 8 * g + j, item = bh * 64 + n, t0 = b * SEQ + n * 64;
#pragma unroll
            for (int i = 0; i < 2; ++i) { const int c = tid + 512 * i, t = c >> 4, d0 = (c & 15) * 8; *(LAS v4u*)(qT + t * 136 + d0) = rq[i]; *(LAS v4u*)(kT + t * 136 + d0) = rk[i]; }
#pragma unroll
            for (int i = 0; i < 4; ++i) { const int c = tid + 512 * i, t = c >> 5, dv0 = (c & 31) * 8; *(LAS v4u*)(Vl + t * 528 + dv0 * 2) = rv[i]; }
            if (tid < 128) { ebL[tid] = reb; elL[tid] = rel; }
            __syncthreads();
            { const int nx = (j < 7) ? item + 1 : ((gi + F.G) >> 3) * 64 + ((gi + F.G) & 7) * 8; if (j < 7 || gi + F.G < NGROUP) GC_FETCH(nx); }
            { const int it = w >> 1;
#pragma unroll
              for (int jj = 0; jj < 2; ++jj) { const int jt = 2 * (w & 1) + jj; f32x4 a = (f32x4){0.f, 0.f, 0.f, 0.f};
                  if (jt <= it) {
#pragma unroll
                      for (int ks = 0; ks < 4; ++ks) { const bf16x8 X = *(LAS bf16x8*)(kT + (jt * 16 + fr) * 136 + ks * 32 + 8 * fq); const bf16x8 Y = *(LAS bf16x8*)(qT + (it * 16 + fr) * 136 + ks * 32 + 8 * fq); a = MFMA16(X, Y, a); }
                      const int ii = it * 16 + fr, j0 = jt * 16 + 4 * fq;
#pragma unroll
                      for (int e = 0; e < 4; ++e) if (j0 + e > ii) a[e] = 0.f;
                  }
                  v2u o; o.x = pk2(a[0], a[1]); o.y = pk2(a[2], a[3]); *(LAS v2u*)(Al + (it * 16 + fr) * 72 + jt * 16 + 4 * fq) = o; } }
#pragma unroll
            for (int dkt = 0; dkt < 8; ++dkt) { const f32x4 e4 = *(LAS f32x4*)(ebL + dkt * 16 + 4 * fq); Sa[dkt][0] *= e4; Sa[dkt][1] *= e4; }
            __syncthreads();
            f32x4 acc[2][4];
#pragma unroll
            for (int jv = 0; jv < 2; ++jv)
#pragma unroll
                for (int tt = 0; tt < 4; ++tt) acc[jv][tt] = (f32x4){0.f, 0.f, 0.f, 0.f};
#pragma unroll
            for (int ks = 0; ks < 4; ++ks) { bf16x8 X[2];
#pragma unroll
                for (int jv = 0; jv < 2; ++jv) { const f32x4 s0 = Sa[2 * ks][jv], s1 = Sa[2 * ks + 1][jv]; v4u p; p.x = pk2(s0[0], s0[1]); p.y = pk2(s0[2], s0[3]); p.z = pk2(s1[0], s1[1]); p.w = pk2(s1[2], s1[3]); X[jv] = __builtin_bit_cast(bf16x8, p); }
#pragma unroll
                for (int tt = 0; tt < 4; ++tt) { const v2u y0 = *(LAS v2u*)(qT + (tt * 16 + fr) * 136 + ks * 32 + 4 * fq), y1 = *(LAS v2u*)(qT + (tt * 16 + fr) * 136 + ks * 32 + 16 + 4 * fq);
                    v4u yy; yy.x = y0.x; yy.y = y0.y; yy.z = y1.x; yy.w = y1.y; const bf16x8 Y = __builtin_bit_cast(bf16x8, yy);
                    acc[0][tt] = MFMA16(X[0], Y, acc[0][tt]); acc[1][tt] = MFMA16(X[1], Y, acc[1][tt]); } }
#pragma unroll
            for (int ks = 0; ks < 2; ++ks) { bf16x8 X[2];
#pragma unroll
                for (int jv = 0; jv < 2; ++jv) X[jv] = tr_frag(Vl, 528, ks * 32, (2 * w + jv) * 16, lane);
#pragma unroll
                for (int tt = 0; tt < 4; ++tt) { if (ks == 1 && tt < 2) continue; const bf16x8 Y = *(LAS bf16x8*)(Al + (tt * 16 + fr) * 72 + ks * 32 + 8 * fq); acc[0][tt] = MFMA16(X[0], Y, acc[0][tt]); acc[1][tt] = MFMA16(X[1], Y, acc[1][tt]); }
#pragma unroll
                for (int dkt = 0; dkt < 8; ++dkt) { const bf16x8 K = tr_frag((LAS unsigned char*)kT, 272, ks * 32, dkt * 16, lane);
                    Sa[dkt][0] = MFMA16(K, X[0], Sa[dkt][0]); Sa[dkt][1] = MFMA16(K, X[1], Sa[dkt][1]); } }
#pragma unroll
            for (int dkt = 0; dkt < 8; ++dkt) { const f32x4 e4 = *(LAS f32x4*)(elL + dkt * 16 + 4 * fq); Sa[dkt][0] *= e4; Sa[dkt][1] *= e4; }
            v2u gg[4][2];
#pragma unroll
            for (int jv = 0; jv < 2; ++jv)
#pragma unroll
                for (int tt = 0; tt < 4; ++tt) gg[tt][jv] = *(const GAS v2u*)(Z + (size_t)(t0 + tt * 16 + fr) * LDZ + OFF_GG + h * 256 + (2 * w + jv) * 16 + 4 * fq);
#pragma unroll
            for (int tt = 0; tt < 4; ++tt) { float s = 0.f;
#pragma unroll
                for (int jv = 0; jv < 2; ++jv) { const f32x4 a = acc[jv][tt]; s += (a[0] * a[0] + a[1] * a[1]) + (a[2] * a[2] + a[3] * a[3]); }
                s += pg8::shx(s, lane, 16); s += pg8::shx(s, lane, 32);
                if (fq == 0) part[(tt * 16 + fr) * 8 + w] = s; }
            __syncthreads();
#pragma unroll
            for (int tt = 0; tt < 4; ++tt) { const int t = tt * 16 + fr; const f32x4 p0 = *(LAS f32x4*)(part + t * 8), p1 = *(LAS f32x4*)(part + t * 8 + 4);
                const float rs = __builtin_amdgcn_rsqf(((p0[0] + p0[1]) + (p0[2] + p0[3]) + (p1[0] + p1[1]) + (p1[2] + p1[3])) * (1.0f / 256.0f) + RMS_EPS);
#pragma unroll
                for (int jv = 0; jv < 2; ++jv) { const int dv = (2 * w + jv) * 16 + 4 * fq; const v2u gv = gg[tt][jv]; const f32x4 a = acc[jv][tt]; const f32x4 gn = *(const GAS f32x4*)(F.gla_g + l * 256 + dv);
                    const float g0 = bflo(gv.x), g1 = bfhi(gv.x), g2 = bflo(gv.y), g3 = bfhi(gv.y);
                    const float o0 = a[0] * rs * gn[0] * g0 * __builtin_amdgcn_rcpf(1.0f + __expf(-g0)), o1 = a[1] * rs * gn[1] * g1 * __builtin_amdgcn_rcpf(1.0f + __expf(-g1));
                    const float o2 = a[2] * rs * gn[2] * g2 * __builtin_amdgcn_rcpf(1.0f + __expf(-g2)), o3 = a[3] * rs * gn[3] * g3 * __builtin_amdgcn_rcpf(1.0f + __expf(-g3));
                    v2u o; o.x = pk2(o0, o1); o.y = pk2(o2, o3); *(GAS v2u*)(AA + (size_t)(t0 + t) * 2048 + h * 256 + dv) = o; } }
        }
    }
    __syncthreads();
#undef GC_FETCH
}
constexpr int SW_K = 0, SW_V = 256 * 144, SW_P = SW_V + 288 * 144, SW_END = SW_P + 8 * 16 * 336;
static_assert(SW_END <= RING_BYTES, "SWA LDS map");
__device__ __forceinline__ void swa_phase(Frame& F, int l) {
    LAS unsigned char* lds = F.lds;
    LAS bf16* Kl = (LAS bf16*)(lds + SW_K); LAS unsigned char* Vl = lds + SW_V;
    const int tid = F.tid, lane = F.lane, w = F.wave, fr = lane & 15, fq = lane >> 4;
    LAS bf16* Pl = (LAS bf16*)(lds + SW_P + w * (16 * 336));
    const bf16* Z = (const bf16*)(F.ws + WS_Z); unsigned char* AB8 = F.ws + WS_AB;
    for (int i = tid; i < 32 * 144 / 4; i += NWAVES * 64) ((LAS unsigned*)(Vl + 256 * 144))[i] = 0u;
    const int NITEM = BATCH * 32 * 8;
    f32x4 pen0, pen8;
#pragma unroll
    for (int e = 0; e < 4; ++e) { pen0[e] = (4 * fq + e <= fr) ? -1e30f : 0.f; pen8[e] = (4 * fq + e > fr) ? -1e30f : 0.f; }
    v4u kreg[4], vreg[4];
#define SW_FETCH(item_) do { const int g_ = (item_) & 7, qb_ = ((item_) >> 3) & 31, b_ = (item_) >> 8, q0_ = b_ * SEQ + qb_ * 128; \
        _Pragma("unroll") for (int i = 0; i < 4; ++i) { const int c = tid + 512 * i, kr = c >> 3, d0 = (c & 7) * 8; int tok = q0_ - 128 + kr; if (tok < b_ * SEQ) tok = b_ * SEQ; \
            const size_t zr = (size_t)tok * LDZ + g_ * 64 + d0; kreg[i] = *(const GAS v4u*)(Z + zr + OFF_SK); vreg[i] = *(const GAS v4u*)(Z + zr + OFF_SV); } } while (0)
    SW_FETCH((int)blockIdx.x < NITEM ? (int)blockIdx.x : NITEM - 1);
    for (int item = blockIdx.x; item < NITEM; item += F.G) {
        const int g = item & 7, qb = (item >> 3) & 31, b = item >> 8, q0 = b * SEQ + qb * 128;
#pragma unroll
        for (int i = 0; i < 4; ++i) { const int c = tid + 512 * i, kr = c >> 3, d0 = (c & 7) * 8; *(LAS v4u*)(Kl + kr * 72 + d0) = kreg[i]; *(LAS v4u*)(Vl + kr * 144 + d0 * 2) = vreg[i]; }
        const int r = w >> 1, hq = g * 4 + r; const float sink = F.sinks[l * 32 + hq];
        bf16x8 Yc[2]; v2u gc[4];
        { const size_t qrow = (size_t)(q0 + 64 * (w & 1) + fr);
#pragma unroll
          for (int ks = 0; ks < 2; ++ks) Yc[ks] = *(const GAS bf16x8*)(Z + qrow * LDZ + OFF_SQ + hq * 64 + ks * 32 + 8 * fq);
#pragma unroll
          for (int c = 0; c < 4; ++c) gc[c] = *(const GAS v2u*)(Z + qrow * LDZ + OFF_SG + hq * 64 + c * 16 + 4 * fq); }
        __syncthreads();
        if (item + F.G < NITEM) SW_FETCH(item + F.G);
#pragma unroll 1
        for (int qt = 0; qt < 4; ++qt) {
            const int ql0 = 64 * (w & 1) + 16 * qt; const size_t qrow = (size_t)(q0 + ql0 + fr);
            bf16x8 Yn[2]; v2u gn[4];
            { const size_t qn = (size_t)(q0 + 64 * (w & 1) + 16 * ((qt + 1) & 3) + fr);
#pragma unroll
              for (int ks = 0; ks < 2; ++ks) Yn[ks] = *(const GAS bf16x8*)(Z + qn * LDZ + OFF_SQ + hq * 64 + ks * 32 + 8 * fq);
#pragma unroll
              for (int c = 0; c < 4; ++c) gn[c] = *(const GAS v2u*)(Z + qn * LDZ + OFF_SG + hq * 64 + c * 16 + 4 * fq); }
            f32x4 S[9];
#pragma unroll
            for (int kt = 0; kt < 9; ++kt) { f32x4 a = (f32x4){0.f, 0.f, 0.f, 0.f};
#pragma unroll
                for (int ks = 0; ks < 2; ++ks) { const bf16x8 X = *(LAS bf16x8*)(Kl + (ql0 + 16 * kt + fr) * 72 + ks * 32 + 8 * fq); a = MFMA16(X, Yc[ks], a); }
                S[kt] = a; }
            const int qpos = qb * 128 + ql0 + fr; const float CS = 0.125f * 1.4426950408889634f, sink2 = sink * 1.4426950408889634f;
            S[0] += pen0; S[8] += pen8;
            if (qb == 0) {
#pragma unroll
                for (int kt = 0; kt < 8; ++kt)
#pragma unroll
                    for (int e = 0; e < 4; ++e) if (qpos - 128 + 16 * kt + 4 * fq + e - fr < 0) S[kt][e] = -1e30f; }
            float mr = S[0][0];
#pragma unroll
            for (int kt = 0; kt < 9; ++kt) mr = fmaxf(fmaxf(mr, fmaxf(S[kt][0], S[kt][1])), fmaxf(S[kt][2], S[kt][3]));
            mr = fmaxf(mr, pg8::shx(mr, lane, 16)); mr = fmaxf(mr, pg8::shx(mr, lane, 32));
            const float m2 = fmaxf(mr * CS, sink2);
            float sum = 0.f;
#pragma unroll
            for (int kt = 0; kt < 9; ++kt) { f32x4 p;
#pragma unroll
                for (int e = 0; e < 4; ++e) { p[e] = __builtin_amdgcn_exp2f(S[kt][e] * CS - m2); sum += p[e]; }
                v2u o; o.x = pk2(p[0], p[1]); o.y = pk2(p[2], p[3]); *(LAS v2u*)(Pl + fr * 168 + 16 * kt + 4 * fq) = o; }
            { unsigned z0 = 0u; asm volatile("" : "+v"(z0)); v2u o; o.x = z0; o.y = z0; *(LAS v2u*)(Pl + fr * 168 + 144 + 4 * fq) = o; }
            sum += pg8::shx(sum, lane, 16); sum += pg8::shx(sum, lane, 32);
            const float iv = __builtin_amdgcn_rcpf(sum + __builtin_amdgcn_exp2f(sink2 - m2)) * AB8_SCALE;
            LDS_WAIT(); asm volatile("" ::: "memory");
            f32x4 O[4];
#pragma unroll
            for (int c = 0; c < 4; ++c) O[c] = (f32x4){0.f, 0.f, 0.f, 0.f};
#pragma unroll
            for (int k5 = 0; k5 < 5; ++k5) { const bf16x8 Y = *(LAS bf16x8*)(Pl + fr * 168 + k5 * 32 + 8 * fq);
#pragma unroll
                for (int c = 0; c < 4; ++c) { const bf16x8 X = tr_frag(Vl, 144, ql0 + 32 * k5, c * 16, lane); O[c] = MFMA16(X, Y, O[c]); } }
#pragma unroll
            for (int c = 0; c < 4; ++c) { const int dd = hq * 64 + c * 16 + 4 * fq; const v2u gv = gc[c];
                const float g0 = bflo(gv.x), g1 = bfhi(gv.x), g2 = bflo(gv.y), g3 = bfhi(gv.y);
                const float o0 = O[c][0] * iv * g0 * __builtin_amdgcn_rcpf(1.0f + __expf(-g0)), o1 = O[c][1] * iv * g1 * __builtin_amdgcn_rcpf(1.0f + __expf(-g1));
                const float o2 = O[c][2] * iv * g2 * __builtin_amdgcn_rcpf(1.0f + __expf(-g2)), o3 = O[c][3] * iv * g3 * __builtin_amdgcn_rcpf(1.0f + __expf(-g3));
                int q = __builtin_amdgcn_cvt_pk_fp8_f32(o0, o1, 0, false); q = __builtin_amdgcn_cvt_pk_fp8_f32(o2, o3, q, true); *(GAS unsigned*)(AB8 + qrow * 2048 + dd) = (unsigned)q; }
            asm volatile("" ::: "memory");
#pragma unroll
            for (int ks = 0; ks < 2; ++ks) Yc[ks] = Yn[ks];
#pragma unroll
            for (int c = 0; c < 4; ++c) gc[c] = gn[c];
        }
        __syncthreads();
    }
#undef SW_FETCH
}
#ifndef GEMM_BAL
#define GEMM_BAL true
#endif
#ifndef REP_PRO
#define REP_PRO 1
#endif
#ifndef REP_P1
#define REP_P1 1
#endif
#ifndef REP_GA
#define REP_GA 1
#endif
#ifndef REP_SWA
#define REP_SWA 1
#endif
#ifndef REP_SCAN
#define REP_SCAN 1
#endif
#ifndef REP_GC
#define REP_GC 1
#endif
#ifndef REP_P3
#define REP_P3 1
#endif
#ifndef REP_BAR
#define REP_BAR 1
#endif
#ifndef REP_P4
#define REP_P4 1
#endif
struct Args { const float* in[12]; float* out; unsigned char* ws; int ph_lo, ph_hi; };
static_assert(sizeof(Args) == 14 * 8 + 8, "Args has no holes");
__global__ void __launch_bounds__(NWAVES * 64, 2) hybrid_fwd(Args args) {
    extern __shared__ __attribute__((aligned(16))) unsigned char lds[];
    Frame F;
    F.lds = (LAS unsigned char*)lds; F.MISC = (volatile LAS unsigned*)(F.lds + MISC_OFF);
    F.tid = threadIdx.x; F.lane = F.tid & 63; F.wave = __builtin_amdgcn_readfirstlane(F.tid >> 6); F.G = gridDim.x;
    F.ws = args.ws; F.ctl = (gu32*)(args.ws + WS_CTL);
    F.x = args.in[0]; F.norm_g = args.in[1]; F.w_in = args.in[2]; F.b_gates = args.in[3]; F.w_up = args.in[4]; F.b_dec = args.in[5]; F.gla_g = args.in[6]; F.sinks = args.in[7];
    F.w_gla = args.in[8]; F.w_swa = args.in[9]; F.w_out = args.in[10]; F.fin_g = args.in[11]; F.out = args.out;
    for (int u = F.tid; u < (LDS_BYTES - LDSCTL_OFF) / 4; u += NWAVES * 64) ((LAS unsigned*)(F.lds + LDSCTL_OFF))[u] = 0u;
    __syncthreads();
    XcdBarrier bar; bar.bar = (unsigned*)(F.ctl + CW_BAR); bar.x = 0; bar.st = nullptr;
    if (!MK_PER_PHASE) bar = xcd_barrier_post((unsigned*)(F.ctl + CW_BAR), F.MISC + 8);
    const int wv0 = __builtin_amdgcn_readfirstlane(threadIdx.x >> 6);
    const int lo = args.ph_lo, hi = args.ph_hi;
#if MK_PER_PHASE
#define IN(k) (lo <= (k) && (k) < hi)
#else
#define IN(k) true
#endif
#define PHASE_BEGIN() do { unsigned m_ = ~0u; asm volatile("" : "+s"(m_)); int t_ = wv0 * 64 + (int)__builtin_amdgcn_mbcnt_hi(m_, __builtin_amdgcn_mbcnt_lo(m_, 0u)); asm volatile("" : "+v"(t_)); F.tid = t_; F.lane = t_ & 63; F.wave = __builtin_amdgcn_readfirstlane(t_ >> 6); unsigned long long z_ = 0ull; asm volatile("" : "+s"(z_)); unsigned char* w_ = args.ws + z_; F.ws = w_; F.ctl = (gu32*)(w_ + WS_CTL); } while (0)
#define SEAM(k) do { if (IN(k) && IN((k) + 1)) { unsigned long long z_ = 0ull; asm volatile("" : "+s"(z_)); bar.bar = (unsigned*)(args.ws + WS_CTL + z_) + CW_BAR; for (int rb_ = 0; rb_ < REP_BAR; ++rb_) xcd_barrier(bar); } } while (0)
    if (IN(0)) for (int rep = 0; rep < REP_PRO; ++rep) { PHASE_BEGIN(); p0_prologue(F); }
    SEAM(0);
    for (int l = 0; l < DEPTH; ++l) {
        const int p = 1 + 6 * l;
        if (IN(p)) for (int rep = 0; rep < REP_P1; ++rep) {
            PHASE_BEGIN(); const bf16* XBp = (const bf16*)(F.ws + WS_XB); bf16* Zp = (bf16*)(F.ws + WS_Z);
            gdec_phase(F, l);
            pg8::StaticOrder S; S.init(M, NZ_BF, F.G, (int)blockIdx.x);
            pg8::EpiZ E; E.Z = Zp; E.P = (const float*)(F.ws + WS_SSQP); E.rsl = (const LAS float*)(F.lds + RS_OFF); E.mul = 1.0f;
            const float* SXc = (const float*)(F.ws + WS_SX) + (size_t)(l & 1) * M; float* SXn = (float*)(F.ws + WS_SX) + (size_t)((l + 1) & 1) * M; const float iwq = 1.0f / ((const float*)(F.ws + WS_SX))[2 * M + l];
            { pg8::Unit u0; const bool has = S.next(0, u0); E.pm0 = has ? u0.pm : -1;
              if (has && F.tid < 256) { const int row = u0.pm * 256 + F.tid; const float rstd = pg8::row_rstd(E.P, row); ((LAS float*)(F.lds + RS_OFF))[F.tid] = rstd;
                  ((LAS float*)(F.lds + RS2_OFF))[F.tid] = rstd * iwq * __builtin_amdgcn_rcpf(SXc[row]); SXn[row] = (127.0f / QC_XP) * rstd; ((LAS float*)(F.lds + RS3_OFF))[F.tid] = (127.0f / QC_XP) * rstd; }
              __syncthreads(); }
            { pg8::Gemm g{XBp, (const bf16*)(F.ws + WS_WIN) + (size_t)l * NZ * D, M, NZ_BF, D};
              pg8::gemm_phase<pg8::EpiZ, pg8::StaticOrder, true, true, false, GEMM_BAL>(F.lds, g, S, E, F.tid); }
            { pg8::StaticOrder S8; S8.init(M, NZ_F8, F.G, (int)blockIdx.x); pg8::Unit u0; const bool has = S8.next(0, u0);
              pg8::EpiZ8 E8{Zp + NZ_BF, E.P, SXc, iwq, (!has || u0.pm != E.pm0) ? -1 : E.pm0, (const LAS float*)(F.lds + RS2_OFF), F.ws + WS_GT, (OFF_GA - NZ_BF) / 256};
              pg8::Gemm g{(const bf16*)(F.ws + WS_X8), (const bf16*)(F.ws + WS_WIN8 + (size_t)l * NZ_F8 * D), M, NZ_F8, D / 2};
              pg8::gemm_phase<pg8::EpiZ8, pg8::StaticOrder, true, true, false, GEMM_BAL, true>(F.lds, g, S8, E8, F.tid); }
        }
        SEAM(p);
        if (IN(p + 1)) { for (int rep = 0; rep < REP_GA; ++rep) { PHASE_BEGIN(); gla_a_phase(F, l); } for (int rep = 0; rep < REP_SWA; ++rep) { PHASE_BEGIN(); swa_phase(F, l); } }
        SEAM(p + 1);
        if (IN(p + 2)) for (int rep = 0; rep < REP_SCAN; ++rep) { PHASE_BEGIN(); gla_scan_phase(F); }
        SEAM(p + 2);
        if (IN(p + 3)) for (int rep = 0; rep < REP_GC; ++rep) { PHASE_BEGIN(); gla_c_phase(F, l); }
        SEAM(p + 3);
        if (IN(p + 4)) for (int rep = 0; rep < REP_P3; ++rep) {
            { PHASE_BEGIN(); bf16* Zp = (bf16*)(F.ws + WS_Z); pg8::Gemm g{(const bf16*)(F.ws + WS_AA), (const bf16*)(F.ws + WS_WGLA) + (size_t)l * D * 2048, M, D, 2048}; pg8::StaticOrder S; S.init(M, D, F.G, (int)blockIdx.x);
              LAS float* mred = (LAS float*)(F.lds + MQ_OFF + 16); if (F.tid < 8) mred[F.tid] = 0.f; __syncthreads();
              int nu = ((M / 256) * (D / 256) - (int)blockIdx.x + F.G - 1) / F.G; asm volatile("" : "+s"(nu));
              pg8::EpiGateA E{F.ws + WS_GT, F.b_gates + (size_t)(l * 2 + 0) * D, F.ws + WS_TMP, (LAS float*)mred};
              pg8::gemm_phase<pg8::EpiGateA, pg8::StaticOrder, true, true, false, GEMM_BAL>(F.lds, g, S, E, F.tid);
              __syncthreads();
              if (F.tid == 0) { float t = 0.f;
#pragma unroll
                  for (int w_ = 0; w_ < 8; ++w_) t += mred[w_];
                  *(LAS float*)(F.lds + MQ_OFF) = (127.0f / QC_M) * __builtin_amdgcn_rsqf(t / (65536.0f * (float)(nu > 0 ? nu : 1)) + 1e-30f); }
              __syncthreads(); }
            { PHASE_BEGIN(); bf16* Zp = (bf16*)(F.ws + WS_Z); pg8::Gemm g{(const bf16*)(F.ws + WS_AB), (const bf16*)(F.ws + WS_WSWA + (size_t)l * D * 2048), M, D, 1024}; pg8::StaticOrder S; S.init(M, D, F.G, (int)blockIdx.x);
              pg8::EpiGateB8 E{F.ws + WS_GT + (size_t)1024 * 131072, F.b_gates + (size_t)(l * 2 + 1) * D, F.ws + WS_TMP, F.ws + WS_MERGED, 1.0f / (W8_SCALE * AB8_SCALE), *(const LAS float*)(F.lds + MQ_OFF) * 0.35355339f};
              pg8::gemm_phase<pg8::EpiGateB8, pg8::StaticOrder, true, true, true, GEMM_BAL>(F.lds, g, S, E, F.tid); }
        }
        SEAM(p + 4);
        if (IN(p + 5)) for (int rep = 0; rep < REP_P4; ++rep) {
            PHASE_BEGIN(); pg8::Gemm g{(const bf16*)(F.ws + WS_MERGED), (const bf16*)(F.ws + WS_WOUT + (size_t)l * D * D), M, D, D / 2};
            pg8::EpiRes E{(bf16*)(F.ws + (rep ? WS_TMP : WS_XB)), (float*)(F.ws + (rep ? WS_TMP + 192 * MiB : WS_SSQP)), F.ws + (rep ? WS_TMP + 128 * MiB : WS_X8), (const float*)(F.ws + WS_SX) + (size_t)((l + 1) & 1) * M, (const LAS float*)(F.lds + RS3_OFF), -1, 1.0f / (*(const LAS float*)(F.lds + MQ_OFF) * ((const float*)(F.ws + WS_SX))[2 * M + DEPTH + l])};
            { pg8::StaticOrder S0; S0.init(M, D, F.G, (int)blockIdx.x); pg8::Unit u0; if (S0.next(0, u0)) E.pm0 = u0.pm; }
#if defined(PROBE_P4_HOT)
            if (rep) { pg8::HotOrder S; S.init(M, D, F.G, (int)blockIdx.x); pg8::gemm_phase<pg8::EpiRes, pg8::HotOrder, false, true, false, GEMM_BAL, true>(F.lds, g, S, E, F.tid); } else
#endif
            { pg8::StaticOrder S; S.init(M, D, F.G, (int)blockIdx.x); pg8::gemm_phase<pg8::EpiRes, pg8::StaticOrder, true, true, false, GEMM_BAL, true>(F.lds, g, S, E, F.tid); }
        }
        SEAM(p + 5);

    }
    if (IN(N_PHASES - 1)) { PHASE_BEGIN(); final_norm(F); }
#undef IN
#undef SEAM
}

extern "C" void kernel_launch(void* const* d_in, const int* in_sizes, int n_in, void* d_out, int out_size, void* d_ws, size_t ws_size, hipStream_t stream) {
    static int grid = 0;
    if (grid == 0) {
        if (n_in != 12 || in_sizes[0] != M * D || out_size != M * D || ws_size < WS_END) { fprintf(stderr, "kernel_launch: unexpected shapes (n_in %d, in0 %d, out %d, ws %zu < %zu); nothing launched\n", n_in, n_in > 0 ? in_sizes[0] : -1, out_size, ws_size, (size_t)WS_END); grid = -1; return; }
        int dev = 0, cus = 0, per_cu = 0;
        if (hipGetDevice(&dev) != hipSuccess || hipDeviceGetAttribute(&cus, hipDeviceAttributeMultiprocessorCount, dev) != hipSuccess) { grid = -1; return; }
        if (hipFuncSetAttribute((const void*)hybrid_fwd, hipFuncAttributeMaxDynamicSharedMemorySize, LDS_BYTES) != hipSuccess) { fprintf(stderr, "kernel_launch: hipFuncSetAttribute failed\n"); grid = -1; return; }
        if (hipOccupancyMaxActiveBlocksPerMultiprocessor(&per_cu, (const void*)hybrid_fwd, NWAVES * 64, LDS_BYTES) != hipSuccess || per_cu < 1) { fprintf(stderr, "kernel_launch: occupancy query reports %d blocks per CU\n", per_cu); }
        (void)hipGetLastError();
        grid = cus;
    }
    if (grid < 0) return;
    if (hipMemsetAsync((char*)d_ws + WS_CTL, 0, CTL_ZERO_BYTES, stream) != hipSuccess) return;
    Args a{};
    for (int i = 0; i < 12; ++i) a.in[i] = (const float*)d_in[i];
    a.out = (float*)d_out; a.ws = (unsigned char*)d_ws;
#if MK_PER_PHASE
    for (int ph = 0; ph < N_PHASES; ++ph) { a.ph_lo = ph; a.ph_hi = ph + 1; hipLaunchKernelGGL(hybrid_fwd, dim3(grid), dim3(NWAVES * 64), LDS_BYTES, stream, a); }
#else
    a.ph_lo = 0; a.ph_hi = N_PHASES; hipLaunchKernelGGL(hybrid_fwd, dim3(grid), dim3(NWAVES * 64), LDS_BYTES, stream, a);
#endif
    const hipError_t le = hipPeekAtLastError();
    if (le != hipSuccess) fprintf(stderr, "kernel_launch: launch failed: %s\n", hipGetErrorName(le));
}
```

```cpp
#include <hip/hip_runtime.h>
#include <cstdio>
#include <cstdint>
#define NZ_BF_COLS 2048
namespace pg8 {
#define PG8_LAS __attribute__((address_space(3)))
typedef unsigned short bf16_t;
typedef short bf16x8 __attribute__((ext_vector_type(8)));
typedef float f32x4 __attribute__((ext_vector_type(4)));
typedef unsigned u32x4 __attribute__((ext_vector_type(4)));
typedef int i32x4 __attribute__((ext_vector_type(4)));
typedef int i32x8 __attribute__((ext_vector_type(8)));
constexpr int BM = 256, BK = 64, HALF = 128, HTB = HALF * BK * 2  , STAGE_BYTES = 8 * HTB, NXCD = 8, WGM = 8;

__host__ __device__ __forceinline__ int lds_byte(int r, int c) { const int st = (r >> 4) * 2 + (c >> 5), rr = r & 15, cc = c & 31, ob = rr * 64 + cc * 2; return st * 1024 + (ob ^ (((ob >> 9) & 1) << 5)); }
__host__ __device__ __forceinline__ void stage_rc(int b, int& R, int& C) { const int st = b / 1024, sb = b % 1024, swz = sb ^ (((sb >> 9) & 1) << 5); R = (st >> 1) * 16 + swz / 64; C = (st & 1) * 32 + (swz % 64) / 2; }
__host__ __device__ __forceinline__ int perm32(int rho) { const int n = rho >> 4, i = rho & 15; return 8 * (i >> 2) + 4 * n + (i & 3); }

struct Unit { int pm, pn; };
struct Gemm { const bf16_t* A; const bf16_t* Bt; int M, N, K; };

struct StaticOrder {
    int nM, nN, nwg, G, c;
    __host__ __device__ void init(int M, int N, int G_, int c_) { nM = M / BM; nN = N / BM; nwg = nM * nN; G = G_; c = c_; }
    __host__ __device__ bool next(int i, Unit& u) const {
        const long L = (long)i * G + c; if (L >= nwg) return false;
        int wgid = (int)L; { const int q = nwg / NXCD, r = nwg % NXCD, xcd = wgid % NXCD, off = wgid / NXCD; wgid = (xcd < r ? xcd * (q + 1) : r * (q + 1) + (xcd - r) * q) + off; }
        const int nig = WGM * nN, gid = wgid / nig, fm = gid * WGM, gsz = (nM - fm) < WGM ? (nM - fm) : WGM;
        u.pm = fm + ((wgid % nig) % gsz); u.pn = (wgid % nig) / gsz; return true;
    }
    __device__ __forceinline__ void a_ready(const Unit&) const {}
    __device__ __forceinline__ void done(const Unit&) const {}
};
typedef unsigned u32x2 __attribute__((ext_vector_type(2)));
typedef float f32x2c __attribute__((ext_vector_type(2))); typedef __bf16 bf16x2c __attribute__((ext_vector_type(2)));
__device__ __forceinline__ unsigned cvt_pk_bf16(float lo, float hi) { const f32x2c v = {lo, hi}; return __builtin_bit_cast(unsigned, __builtin_convertvector(v, bf16x2c)); }
typedef float f32x2 __attribute__((ext_vector_type(2)));
struct HotOrder : StaticOrder { __host__ __device__ bool next(int i, Unit& u) const { const bool r = StaticOrder::next(i, u); u.pm = c & 7; u.pn = 0; return r; } };
constexpr int LDZ = 19456;
__device__ __forceinline__ float bf_lo(unsigned w) { return __uint_as_float(w << 16); }
__device__ __forceinline__ float bf_hi(unsigned w) { return __uint_as_float(w & 0xffff0000u); }
__device__ __forceinline__ float sigmoidf_(float x) { return __builtin_amdgcn_rcpf(1.0f + __expf(-x)); }
__host__ __device__ __forceinline__ int kperm8(int k) { return (k & ~63) | ((k & 0x18) << 1) | ((k >> 2) & 8) | (k & 7); }
__device__ __forceinline__ unsigned q8x4(float a, float b, float c, float d, float q) {
    const float MG = 12582912.0f, LO = MG - 127.0f, HI = MG + 127.0f;
    const unsigned i0 = __float_as_uint(__builtin_amdgcn_fmed3f(__builtin_fmaf(a, q, MG), LO, HI)), i1 = __float_as_uint(__builtin_amdgcn_fmed3f(__builtin_fmaf(b, q, MG), LO, HI));
    const unsigned i2 = __float_as_uint(__builtin_amdgcn_fmed3f(__builtin_fmaf(c, q, MG), LO, HI)), i3 = __float_as_uint(__builtin_amdgcn_fmed3f(__builtin_fmaf(d, q, MG), LO, HI));
    return __builtin_amdgcn_perm(i1, i0, 0x0c0c0400u) | __builtin_amdgcn_perm(i3, i2, 0x04000c0cu);
}
__device__ __forceinline__ float shx(float v, int lane, int mask) { return __int_as_float(__builtin_amdgcn_ds_bpermute((lane ^ mask) << 2, __float_as_int(v))); }
__device__ __forceinline__ float row_ssq(const float* P, int row) {
    const f32x4* p = (const f32x4*)(P + (size_t)row * 64); float s = 0.f;
#pragma unroll
    for (int j = 0; j < 16; ++j) { const f32x4 v = p[j]; s += (v[0] + v[1]) + (v[2] + v[3]); }
    return s;
}
__device__ __forceinline__ float row_rstd(const float* P, int row) { return __builtin_amdgcn_rsqf(row_ssq(P, row) * (1.0f / 4096.0f) + 1e-6f); }
__device__ __forceinline__ float row_rstd_slow(const float* P, int row) {
    const f32x4* p = (const f32x4*)(P + (size_t)row * 64); float s = 0.f;
#pragma unroll 1
    for (int j = 0; j < 16; ++j) { const f32x4 v = p[j]; s += (v[0] + v[1]) + (v[2] + v[3]); }
    return __builtin_amdgcn_rsqf(s * (1.0f / 4096.0f) + 1e-6f);
}
struct EpiZ {
    static constexpr bool PERM = true, AFTER_DRAIN = false, IDEMP = true;
    bf16_t* Z; const float* P; int pm0; const PG8_LAS float* rsl; float mul;
    __device__ __forceinline__ void operator()(const f32x4 (&acc)[2][2][4][2], const Unit& u, int wr, int wc, int fr_in, int fq_in) const {
        int fr = fr_in, fq = fq_in; asm volatile("" : "+v"(fr), "+v"(fq));
        const int row0 = u.pm * BM + wr * 64 + fr, col0 = u.pn * BM + wc * 64 + 8 * fq;
#pragma unroll
        for (int ai = 0; ai < 2; ++ai)
#pragma unroll
            for (int m = 0; m < 4; ++m) { const int row = row0 + ai * HALF + m * 16; const float r = ((u.pm == pm0) ? rsl[ai * HALF + wr * 64 + m * 16 + fr] : row_rstd_slow(P, row)) * mul;
                bf16_t* rowp = Z + (size_t)row * LDZ + col0;
#pragma unroll
                for (int bj = 0; bj < 2; ++bj) { const f32x4 v0 = acc[ai][bj][m][0] * r, v1 = acc[ai][bj][m][1] * r;
                    u32x4 w; w.x = cvt_pk_bf16(v0[0], v0[1]); w.y = cvt_pk_bf16(v0[2], v0[3]); w.z = cvt_pk_bf16(v1[0], v1[1]); w.w = cvt_pk_bf16(v1[2], v1[3]);
                    *(u32x4*)(rowp + bj * 32) = w; } }
    }
};
struct EpiZ8 {
    static constexpr bool PERM = true, AFTER_DRAIN = false, IDEMP = true;
    bf16_t* Z; const float* P; const float* SX; float iwq; int pm0; const PG8_LAS float* rsl; unsigned char* GT; int gpn0;
    __device__ __forceinline__ void operator()(const f32x4 (&acc)[2][2][4][2], const Unit& u, int wr, int wc, int fr_in, int fq_in) const {
        int fr = fr_in, fq = fq_in; asm volatile("" : "+v"(fr), "+v"(fq));
        const int row0 = u.pm * BM + wr * 64 + fr, col0 = u.pn * BM + wc * 64 + 8 * fq;
#pragma unroll
        for (int ai = 0; ai < 2; ++ai)
#pragma unroll
            for (int m = 0; m < 4; ++m) { const int row = row0 + ai * HALF + m * 16; const float r = (u.pm == pm0) ? rsl[ai * HALF + wr * 64 + m * 16 + fr] : row_rstd_slow(P, row) * iwq * __builtin_amdgcn_rcpf(SX[row]);
                const bool gate = u.pn >= gpn0; const int gi = u.pn - gpn0;
                unsigned char* dst = gate ? GT + (((size_t)((gi >> 4) * 1024 + u.pm * 16 + (gi & 15)) * 8 + (wr * 4 + wc)) * 16 + (ai * 4 + m) * 2) * 1024 + (fr + 16 * fq) * 16 : (unsigned char*)(Z + (size_t)row * LDZ + col0);
                const int bstep = gate ? 1024 : 64;
#pragma unroll
                for (int bj = 0; bj < 2; ++bj) { const i32x4 i0 = __builtin_bit_cast(i32x4, acc[ai][bj][m][0]), i1 = __builtin_bit_cast(i32x4, acc[ai][bj][m][1]);
                    const f32x4 v0 = (f32x4){(float)i0[0], (float)i0[1], (float)i0[2], (float)i0[3]} * r, v1 = (f32x4){(float)i1[0], (float)i1[1], (float)i1[2], (float)i1[3]} * r;
                    u32x4 w; w.x = cvt_pk_bf16(v0[0], v0[1]); w.y = cvt_pk_bf16(v0[2], v0[3]); w.z = cvt_pk_bf16(v1[0], v1[1]); w.w = cvt_pk_bf16(v1[2], v1[3]);
                    *(u32x4*)(dst + bj * bstep) = w; } }
    }
};
#define PG8_SIG8(s0, s1, g, b0, b1) do { s0[0] = sigmoidf_(bf_lo(g.x) + b0[0]); s0[1] = sigmoidf_(bf_hi(g.x) + b0[1]); s0[2] = sigmoidf_(bf_lo(g.y) + b0[2]); s0[3] = sigmoidf_(bf_hi(g.y) + b0[3]); \
    s1[0] = sigmoidf_(bf_lo(g.z) + b1[0]); s1[1] = sigmoidf_(bf_hi(g.z) + b1[1]); s1[2] = sigmoidf_(bf_lo(g.w) + b1[2]); s1[3] = sigmoidf_(bf_hi(g.w) + b1[3]); } while (0)
struct EpiGateA {
    static constexpr bool PERM = true, AFTER_DRAIN = false, IDEMP = true;
    const unsigned char* G; const float* bias; unsigned char* T; PG8_LAS float* SS;
    __device__ __forceinline__ void operator()(const f32x4 (&acc)[2][2][4][2], const Unit& u, int wr, int wc, int fr_in, int fq_in) const {
        int fr = fr_in, fq = fq_in; asm volatile("" : "+v"(fr), "+v"(fq));
        const int row0 = u.pm * BM + wr * 64 + fr, col0 = u.pn * BM + wc * 64 + 8 * fq;
        f32x4 bv[2][2]; u32x4 gl[8][2], w[8][2]; float ss = 0.f;
        const size_t tofs = ((size_t)(u.pm * 16 + u.pn) * 8 + (wr * 4 + wc)) * 16384 + (fr + 16 * fq) * 16;
#pragma unroll
        for (int g = 0; g < 8; ++g) { const unsigned char* gp = G + tofs + g * 2048; gl[g][0] = *(const u32x4*)gp; gl[g][1] = *(const u32x4*)(gp + 1024); }
#pragma unroll
        for (int bj = 0; bj < 2; ++bj)
#pragma unroll
            for (int n = 0; n < 2; ++n) bv[bj][n] = *(const f32x4*)(bias + col0 + bj * 32 + 4 * n);
#pragma unroll
        for (int g = 0; g < 8; ++g) { const int ai = g >> 2, m = g & 3;
#pragma unroll
            for (int bj = 0; bj < 2; ++bj) { const u32x4 gg = gl[g][bj]; f32x4 s0, s1; PG8_SIG8(s0, s1, gg, bv[bj][0], bv[bj][1]); const f32x4 v0 = s0 * acc[ai][bj][m][0], v1 = s1 * acc[ai][bj][m][1];
                ss += ((v0[0] * v0[0] + v0[1] * v0[1]) + (v0[2] * v0[2] + v0[3] * v0[3])) + ((v1[0] * v1[0] + v1[1] * v1[1]) + (v1[2] * v1[2] + v1[3] * v1[3]));
                w[g][bj].x = cvt_pk_bf16(v0[0], v0[1]); w[g][bj].y = cvt_pk_bf16(v0[2], v0[3]); w[g][bj].z = cvt_pk_bf16(v1[0], v1[1]); w[g][bj].w = cvt_pk_bf16(v1[2], v1[3]); }
            asm volatile("" : "+v"(w[g][0]), "+v"(w[g][1])); }
        asm volatile("" ::: "memory");
#pragma unroll
        for (int g = 0; g < 8; ++g) { unsigned char* tp = T + tofs + g * 2048; *(u32x4*)tp = w[g][0]; *(u32x4*)(tp + 1024) = w[g][1]; }
        { const int ln = fr + 16 * fq;
#pragma unroll
          for (int o = 1; o < 64; o <<= 1) ss += shx(ss, ln, o);
          if (ln == 0) { PG8_LAS float* sp = SS + wr * 4 + wc; *sp = *sp + ss; } }
    }
};
struct EpiGateB {
    static constexpr bool PERM = true, AFTER_DRAIN = false, IDEMP = true;
    const bf16_t* G; const float* bias; const bf16_t* T; bf16_t* O; float mul;
    __device__ __forceinline__ void operator()(const f32x4 (&acc)[2][2][4][2], const Unit& u, int wr, int wc, int fr_in, int fq_in) const {
        int fr = fr_in, fq = fq_in; asm volatile("" : "+v"(fr), "+v"(fq));
        const int row0 = u.pm * BM + wr * 64 + fr, col0 = u.pn * BM + wc * 64 + 8 * fq;
        f32x4 bv[2][2]; u32x4 w[8][2];
#pragma unroll
        for (int bj = 0; bj < 2; ++bj)
#pragma unroll
            for (int n = 0; n < 2; ++n) bv[bj][n] = *(const f32x4*)(bias + col0 + bj * 32 + 4 * n);
#pragma unroll
        for (int ai = 0; ai < 2; ++ai) { u32x4 gl[4][2], tl[4][2];
#pragma unroll
            for (int m = 0; m < 4; ++m) { const int r = row0 + ai * HALF + m * 16; const bf16_t* gp = G + (size_t)r * LDZ + col0; const bf16_t* tp = T + (size_t)r * 4096 + col0;
                gl[m][0] = *(const u32x4*)gp; gl[m][1] = *(const u32x4*)(gp + 32); tl[m][0] = *(const u32x4*)tp; tl[m][1] = *(const u32x4*)(tp + 32); }
#pragma unroll
            for (int m = 0; m < 4; ++m) { const int g = ai * 4 + m;
#pragma unroll
                for (int bj = 0; bj < 2; ++bj) { const u32x4 gg = gl[m][bj], tt = tl[m][bj]; f32x4 s0, s1; PG8_SIG8(s0, s1, gg, bv[bj][0], bv[bj][1]);
                    f32x4 v0 = s0 * (acc[ai][bj][m][0] * mul), v1 = s1 * (acc[ai][bj][m][1] * mul);
                    v0[0] += bf_lo(tt.x); v0[1] += bf_hi(tt.x); v0[2] += bf_lo(tt.y); v0[3] += bf_hi(tt.y); v1[0] += bf_lo(tt.z); v1[1] += bf_hi(tt.z); v1[2] += bf_lo(tt.w); v1[3] += bf_hi(tt.w);
                    w[g][bj].x = cvt_pk_bf16(v0[0], v0[1]); w[g][bj].y = cvt_pk_bf16(v0[2], v0[3]); w[g][bj].z = cvt_pk_bf16(v1[0], v1[1]); w[g][bj].w = cvt_pk_bf16(v1[2], v1[3]); }
                asm volatile("" : "+v"(w[g][0]), "+v"(w[g][1])); } }
        asm volatile("" ::: "memory");
#pragma unroll
        for (int g = 0; g < 8; ++g) { bf16_t* op = O + (size_t)(row0 + (g >> 2) * HALF + (g & 3) * 16) * 4096 + col0; *(u32x4*)op = w[g][0]; *(u32x4*)(op + 32) = w[g][1]; }
    }
};
struct EpiGateB8 {
    static constexpr bool PERM = true, AFTER_DRAIN = false, IDEMP = true;
    const unsigned char* G; const float* bias; const unsigned char* T; unsigned char* O; float mul, qm;
    __device__ __forceinline__ void operator()(const f32x4 (&acc)[2][2][4][2], const Unit& u, int wr, int wc, int fr_in, int fq_in) const {
        int fr = fr_in, fq = fq_in; asm volatile("" : "+v"(fr), "+v"(fq));
        const int row0 = u.pm * BM + wr * 64 + fr, col0 = u.pn * BM + wc * 64 + 8 * fq;
        f32x4 bv[2][2]; u32x2 w[8][2];
#pragma unroll
        for (int bj = 0; bj < 2; ++bj)
#pragma unroll
            for (int n = 0; n < 2; ++n) bv[bj][n] = *(const f32x4*)(bias + col0 + bj * 32 + 4 * n);
#pragma unroll
        for (int ai = 0; ai < 2; ++ai) { u32x4 gl[4][2], tl[4][2];
#pragma unroll
            for (int m = 0; m < 4; ++m) { const size_t o_ = ((size_t)(u.pm * 16 + u.pn) * 8 + (wr * 4 + wc)) * 16384 + (fr + 16 * fq) * 16 + (ai * 4 + m) * 2048; const unsigned char* gp = G + o_; const unsigned char* tp = T + o_;
                gl[m][0] = *(const u32x4*)gp; gl[m][1] = *(const u32x4*)(gp + 1024); tl[m][0] = *(const u32x4*)tp; tl[m][1] = *(const u32x4*)(tp + 1024); }
#pragma unroll
            for (int m = 0; m < 4; ++m) { const int g = ai * 4 + m;
#pragma unroll
                for (int bj = 0; bj < 2; ++bj) { const u32x4 gg = gl[m][bj], tt = tl[m][bj]; f32x4 s0, s1; PG8_SIG8(s0, s1, gg, bv[bj][0], bv[bj][1]);
                    f32x4 v0 = s0 * (acc[ai][bj][m][0] * mul), v1 = s1 * (acc[ai][bj][m][1] * mul);
                    v0[0] += bf_lo(tt.x); v0[1] += bf_hi(tt.x); v0[2] += bf_lo(tt.y); v0[3] += bf_hi(tt.y); v1[0] += bf_lo(tt.z); v1[1] += bf_hi(tt.z); v1[2] += bf_lo(tt.w); v1[3] += bf_hi(tt.w);
                    { f32x4 p0 = (f32x4){v0[0] + v0[1], v0[0] - v0[1], v0[2] + v0[3], v0[2] - v0[3]}, p1 = (f32x4){v1[0] + v1[1], v1[0] - v1[1], v1[2] + v1[3], v1[2] - v1[3]};
                      f32x4 r0 = (f32x4){p0[0] + p0[2], p0[1] + p0[3], p0[0] - p0[2], p0[1] - p0[3]}, r1 = (f32x4){p1[0] + p1[2], p1[1] + p1[3], p1[0] - p1[2], p1[1] - p1[3]};
                      v0 = r0 + r1; v1 = r0 - r1; }
                    w[g][bj].x = q8x4(v0[0], v0[1], v0[2], v0[3], qm); w[g][bj].y = q8x4(v1[0], v1[1], v1[2], v1[3], qm); }
                asm volatile("" : "+v"(w[g][0]), "+v"(w[g][1])); } }
        asm volatile("" ::: "memory");
#pragma unroll
        for (int g = 0; g < 8; ++g) { unsigned char* op = O + (size_t)(row0 + (g >> 2) * HALF + (g & 3) * 16) * 4096 + u.pn * BM + wc * 64 + 16 * fq; *(u32x4*)op = (u32x4){w[g][0].x, w[g][0].y, w[g][1].x, w[g][1].y}; }
    }
};
struct EpiRes {
    static constexpr bool PERM = true, AFTER_DRAIN = false, IDEMP = false;
    bf16_t* XB; float* P; unsigned char* X8; const float* SXN; const PG8_LAS float* rq; int pm0; float dsc;
    __device__ __forceinline__ void operator()(const f32x4 (&acc)[2][2][4][2], const Unit& u, int wr, int wc, int fr_in, int fq_in) const {
        int fr = fr_in, fq = fq_in; asm volatile("" : "+v"(fr), "+v"(fq));
        const int row0 = u.pm * BM + wr * 64 + fr, col0 = u.pn * BM + wc * 64 + 8 * fq;
        u32x4 xl[8][2], w[8][2]; u32x2 w8[8][2]; float ssv[8];
#pragma unroll
        for (int g = 0; g < 8; ++g) { const bf16_t* xp = XB + (size_t)(row0 + (g >> 2) * HALF + (g & 3) * 16) * 4096 + col0; xl[g][0] = *(const u32x4*)xp; xl[g][1] = *(const u32x4*)(xp + 32); }
#pragma unroll
        for (int g = 0; g < 8; ++g) { const int ai = g >> 2, m = g & 3; float ss = 0.f; const float qg = (u.pm == pm0) ? rq[ai * HALF + wr * 64 + m * 16 + fr] : SXN[row0 + ai * HALF + m * 16];
#pragma unroll
            for (int bj = 0; bj < 2; ++bj) { const u32x4 xx = xl[g][bj]; const i32x4 ia = __builtin_bit_cast(i32x4, acc[ai][bj][m][0]), ib = __builtin_bit_cast(i32x4, acc[ai][bj][m][1]);
                const f32x4 a = (f32x4){(float)ia[0], (float)ia[1], (float)ia[2], (float)ia[3]} * dsc, b = (f32x4){(float)ib[0], (float)ib[1], (float)ib[2], (float)ib[3]} * dsc;
                u32x4 o; o.x = cvt_pk_bf16(bf_lo(xx.x) + a[0], bf_hi(xx.x) + a[1]); o.y = cvt_pk_bf16(bf_lo(xx.y) + a[2], bf_hi(xx.y) + a[3]); o.z = cvt_pk_bf16(bf_lo(xx.z) + b[0], bf_hi(xx.z) + b[1]); o.w = cvt_pk_bf16(bf_lo(xx.w) + b[2], bf_hi(xx.w) + b[3]);
                w[g][bj] = o;
                const float r0 = bf_lo(o.x), r1 = bf_hi(o.x), r2 = bf_lo(o.y), r3 = bf_hi(o.y), r4 = bf_lo(o.z), r5 = bf_hi(o.z), r6 = bf_lo(o.w), r7 = bf_hi(o.w);
                w8[g][bj].x = q8x4(r0, r1, r2, r3, qg); w8[g][bj].y = q8x4(r4, r5, r6, r7, qg);
                ss += ((r0 * r0 + r1 * r1) + (r2 * r2 + r3 * r3)) + ((r4 * r4 + r5 * r5) + (r6 * r6 + r7 * r7)); }
            ss += shx(ss, fr + 16 * fq, 16); ss += shx(ss, fr + 16 * fq, 32); ssv[g] = ss;
            asm volatile("" : "+v"(w[g][0]), "+v"(w[g][1]), "+v"(ssv[g]), "+v"(w8[g][0]), "+v"(w8[g][1])); }
        asm volatile("" ::: "memory");
#pragma unroll
        for (int g = 0; g < 8; ++g) { const int row = row0 + (g >> 2) * HALF + (g & 3) * 16; bf16_t* xp = XB + (size_t)row * 4096 + col0; *(u32x4*)xp = w[g][0]; *(u32x4*)(xp + 32) = w[g][1];
            unsigned char* x8 = X8 + (size_t)row * 4096 + u.pn * BM + wc * 64 + 16 * fq; *(u32x4*)x8 = (u32x4){w8[g][0].x, w8[g][0].y, w8[g][1].x, w8[g][1].y};
            if (fq == 0) P[(size_t)row * 64 + u.pn * 4 + wc] = ssv[g]; }
    }
};

__device__ __forceinline__ f32x4 zero4() { f32x4 z; asm volatile("v_mov_b32 %0, 0\n\tv_mov_b32 %1, 0\n\tv_mov_b32 %2, 0\n\tv_mov_b32 %3, 0" : "=v"(z[0]), "=v"(z[1]), "=v"(z[2]), "=v"(z[3])); return z; }
template <class Epi, class Sched, bool ALIGN_EPI = false, bool SP2 = false, bool F8 = false, bool BAL = false, bool I8 = false>
__device__ __forceinline__ void gemm_phase(PG8_LAS unsigned char* lds, const Gemm g, const Sched& S, const Epi& E, const int tid_in) {
    const int tid = tid_in, wid = __builtin_amdgcn_readfirstlane(tid >> 6), lane = tid & 63, wr = wid >> 2, wc = wid & 3, fr = lane & 15, fq = lane >> 4;
    const int K = g.K, nt = K / BK;
    unsigned voffA[2], voffB[2];
#pragma unroll
    for (int i = 0; i < 2; ++i) { int R, C; stage_rc(tid * 16 + i * 8192, R, C); const int Rb = (R >> 5) * 64 + (Epi::PERM ? perm32(R & 31) : (R & 31));
        voffA[i] = (unsigned)(R * K + C) * 2u; voffB[i] = (unsigned)(Rb * K + C) * 2u; }
    const unsigned kstep = (unsigned)(BK * 2);
    const unsigned hstep = (unsigned)HALF * (unsigned)K * 2u;
    const unsigned hstepB = 32u * (unsigned)K * 2u;
    const unsigned tstep = 2u * hstep;
    const unsigned ldsw = (unsigned)wid * 1024u;
    const int aoff = lds_byte(wr * 64 + fr, fq * 8), boff = lds_byte(wc * 32 + fr, fq * 8);
#define PG8_SA(b, h) (((b) * 2 + (h)) * HTB)
#define PG8_SB(b, h) ((4 + (b) * 2 + (h)) * HTB)
#define PG8_STAGE(bufoff, rs, gbase, voff) do { _Pragma("unroll") for (int _i = 0; _i < 2; ++_i) \
        __builtin_amdgcn_raw_ptr_buffer_load_lds(rs, (PG8_LAS void*)(lds + (bufoff) + ldsw + _i * 8192), 16, (int)(voff)[_i], (int)(gbase), 0, 0); } while (0)
#define PG8_STAGE_A(bufoff, gbase, voff) PG8_STAGE(bufoff, rsA, gbase, voff)
#define PG8_STAGE_B(bufoff, gbase, voff) PG8_STAGE(bufoff, rsB, gbase, voff)
#define PG8_LDA(dst, b, h) do { _Pragma("unroll") for (int m = 0; m < 4; ++m) _Pragma("unroll") for (int k = 0; k < 2; ++k) dst[m][k] = *(const PG8_LAS bf16x8*)(lds + PG8_SA(b, h) + aoff + m * 2048 + k * 1024); } while (0)
#define PG8_LDB(dst, b, h) do { _Pragma("unroll") for (int n = 0; n < 2; ++n) _Pragma("unroll") for (int k = 0; k < 2; ++k) dst[n][k] = *(const PG8_LAS bf16x8*)(lds + PG8_SB(b, h) + boff + n * 2048 + k * 1024); } while (0)
#define PG8_MMA(ai, bj, At, Bt) do { __builtin_amdgcn_s_setprio(1); if constexpr (I8) { \
          \
        _Pragma("unroll") for (int m = 0; m < 4; ++m) _Pragma("unroll") for (int n = 0; n < 2; ++n) _Pragma("unroll") for (int k = 0; k < 2; ++k) { \
            const i32x4 b_ = __builtin_bit_cast(i32x4, Bt[n][k]), a_ = __builtin_bit_cast(i32x4, At[m][k]); \
            asm volatile("v_mfma_i32_16x16x64_i8 %0, %1, %2, %0" : "+v"(acc[ai][bj][m][n]) : "v"(b_), "v"(a_)); } } else if constexpr (!F8) { _Pragma("unroll") for (int m = 0; m < 4; ++m) _Pragma("unroll") for (int n = 0; n < 2; ++n) _Pragma("unroll") for (int k = 0; k < 2; ++k) \
        acc[ai][bj][m][n] = __builtin_amdgcn_mfma_f32_16x16x32_bf16(Bt[n][k], At[m][k], acc[ai][bj][m][n], 0, 0, 0); } else { \
          \
          \
        _Pragma("unroll") for (int m = 0; m < 4; ++m) _Pragma("unroll") for (int n = 0; n < 2; ++n) { \
            const i32x4 b0_ = __builtin_bit_cast(i32x4, Bt[n][0]), b1_ = __builtin_bit_cast(i32x4, Bt[n][1]), a0_ = __builtin_bit_cast(i32x4, At[m][0]), a1_ = __builtin_bit_cast(i32x4, At[m][1]); \
            const i32x8 bb_ = __builtin_shufflevector(b0_, b1_, 0, 1, 2, 3, 4, 5, 6, 7), aa_ = __builtin_shufflevector(a0_, a1_, 0, 1, 2, 3, 4, 5, 6, 7); \
            asm volatile("v_mfma_f32_16x16x128_f8f6f4 %0, %1, %2, %0" : "+v"(acc[ai][bj][m][n]) : "v"(bb_), "v"(aa_)); } } \
        __builtin_amdgcn_s_setprio(0); } while (0)
#define PG8_WAIT_V(n) asm volatile("s_waitcnt vmcnt(" #n ")" ::: "memory")
#define PG8_WAIT_L(n) asm volatile("s_waitcnt lgkmcnt(" #n ")" ::: "memory")
#define PG8_BAR __builtin_amdgcn_s_barrier()
#define PG8_SCHED __builtin_amdgcn_sched_barrier(0)
    Unit cur, nxt; int ui = 0;
    if (!S.next(0, cur)) return;
    f32x4 acc[2][2][4][2];
#pragma unroll
    for (int a = 0; a < 2; ++a)
#pragma unroll
        for (int b = 0; b < 2; ++b)
#pragma unroll
            for (int m = 0; m < 4; ++m)
#pragma unroll
                for (int n = 0; n < 2; ++n) acc[a][b][m][n] = zero4();
    bf16x8 At[4][2], B0[2][2], B1[2][2];
    unsigned cA = (unsigned)cur.pm * tstep, cB = (unsigned)cur.pn * tstep;
    const __amdgpu_buffer_rsrc_t rsA = __builtin_amdgcn_make_buffer_rsrc((void*)g.A, 0, (int)((unsigned)g.M * (unsigned)K * 2u), 0x00020000), rsB = __builtin_amdgcn_make_buffer_rsrc((void*)g.Bt, 0, (int)((unsigned)g.N * (unsigned)K * 2u), 0x00020000);
    S.a_ready(cur);
    if constexpr (SP2) {
        PG8_STAGE_B(PG8_SB(0, 0), cB, voffB); PG8_STAGE_B(PG8_SB(0, 1), cB + hstepB, voffB); PG8_STAGE_A(PG8_SA(0, 0), cA, voffA); PG8_STAGE_A(PG8_SA(0, 1), cA + hstep, voffA);
        if (wr == 1) PG8_BAR;
        PG8_WAIT_V(2); PG8_BAR;
        if constexpr (BAL) { PG8_STAGE_B(PG8_SB(1, 0), cB + kstep, voffB); PG8_STAGE_B(PG8_SB(1, 1), cB + hstepB + kstep, voffB); PG8_WAIT_V(4); PG8_BAR; }
        else {
        PG8_STAGE_B(PG8_SB(1, 0), cB + kstep, voffB); PG8_STAGE_A(PG8_SA(1, 0), cA + kstep, voffA); PG8_STAGE_B(PG8_SB(1, 1), cB + hstepB + kstep, voffB);
        PG8_WAIT_V(6); PG8_BAR;
        }
    } else {
        PG8_STAGE_B(PG8_SB(0, 0), cB, voffB); PG8_STAGE_A(PG8_SA(0, 0), cA, voffA); PG8_STAGE_B(PG8_SB(0, 1), cB + hstepB, voffB); PG8_STAGE_A(PG8_SA(0, 1), cA + hstep, voffA);
        if (wr == 1) PG8_BAR;
        PG8_WAIT_V(4); PG8_BAR;
        PG8_STAGE_B(PG8_SB(1, 0), cB + kstep, voffB); PG8_STAGE_A(PG8_SA(1, 0), cA + kstep, voffA); PG8_STAGE_B(PG8_SB(1, 1), cB + hstepB + kstep, voffB);
        PG8_WAIT_V(6); PG8_BAR;
    }
    for (;;) {
        const bool has_next = S.next(ui + 1, nxt);
        const unsigned nA = has_next ? (unsigned)nxt.pm * tstep : cA, nB = has_next ? (unsigned)nxt.pn * tstep : cB;
        for (int t = 0; t < nt; t += 2) {
            const bool last = (t == nt - 2);
            const unsigned a1 = cA + (unsigned)(t + 1) * kstep;
            const unsigned a2 = last ? nA : cA + (unsigned)(t + 2) * kstep, b2 = last ? nB : cB + (unsigned)(t + 2) * kstep;
            const unsigned a3 = a2 + kstep, b3 = b2 + kstep;
            if (last && has_next) S.a_ready(nxt);
            if constexpr (SP2 && BAL) {
            PG8_LDB(B0, 0, 0); PG8_LDB(B1, 0, 1); PG8_SCHED; PG8_LDA(At, 0, 0); PG8_STAGE_A(PG8_SA(1, 0), a1, voffA); PG8_STAGE_A(PG8_SA(1, 1), a1 + hstep, voffA);
            PG8_WAIT_V(8); PG8_WAIT_L(0); PG8_BAR; PG8_MMA(0, 0, At, B0); PG8_MMA(0, 1, At, B1); PG8_BAR; PG8_SCHED;
            PG8_LDA(At, 0, 1); PG8_STAGE_B(PG8_SB(0, 0), b2, voffB); PG8_STAGE_B(PG8_SB(0, 1), b2 + hstepB, voffB);
            PG8_WAIT_V(6); PG8_WAIT_L(0); PG8_BAR; PG8_MMA(1, 0, At, B0); PG8_MMA(1, 1, At, B1); PG8_BAR; PG8_SCHED;
            PG8_LDB(B0, 1, 0); PG8_LDB(B1, 1, 1); PG8_SCHED; PG8_LDA(At, 1, 0); PG8_STAGE_A(PG8_SA(0, 0), a2, voffA); PG8_STAGE_A(PG8_SA(0, 1), a2 + hstep, voffA);
            PG8_WAIT_V(8); PG8_WAIT_L(0); PG8_BAR; PG8_MMA(0, 0, At, B0); PG8_MMA(0, 1, At, B1); PG8_BAR; PG8_SCHED;
            PG8_LDA(At, 1, 1); PG8_STAGE_B(PG8_SB(1, 0), b3, voffB); PG8_STAGE_B(PG8_SB(1, 1), b3 + hstepB, voffB);
            PG8_WAIT_V(6); PG8_WAIT_L(0); PG8_BAR; PG8_MMA(1, 0, At, B0); PG8_MMA(1, 1, At, B1); PG8_BAR; PG8_SCHED;
            } else if constexpr (SP2) {
            PG8_LDB(B0, 0, 0); PG8_LDB(B1, 0, 1); PG8_SCHED; PG8_LDA(At, 0, 0); PG8_STAGE_A(PG8_SA(1, 1), a1 + hstep, voffA);
            PG8_WAIT_V(8); PG8_WAIT_L(0); PG8_BAR; PG8_MMA(0, 0, At, B0); PG8_MMA(0, 1, At, B1); PG8_BAR; PG8_SCHED;
            PG8_LDA(At, 0, 1); PG8_STAGE_B(PG8_SB(0, 0), b2, voffB); PG8_STAGE_B(PG8_SB(0, 1), b2 + hstepB, voffB); PG8_STAGE_A(PG8_SA(0, 0), a2, voffA);
            PG8_WAIT_V(8); PG8_WAIT_L(0); PG8_BAR; PG8_MMA(1, 0, At, B0); PG8_MMA(1, 1, At, B1); PG8_BAR; PG8_SCHED;
            PG8_LDB(B0, 1, 0); PG8_LDB(B1, 1, 1); PG8_SCHED; PG8_LDA(At, 1, 0); PG8_STAGE_A(PG8_SA(0, 1), a2 + hstep, voffA);
            PG8_WAIT_V(8); PG8_WAIT_L(0); PG8_BAR; PG8_MMA(0, 0, At, B0); PG8_MMA(0, 1, At, B1); PG8_BAR; PG8_SCHED;
            PG8_LDA(At, 1, 1); PG8_STAGE_B(PG8_SB(1, 0), b3, voffB); PG8_STAGE_B(PG8_SB(1, 1), b3 + hstepB, voffB); PG8_STAGE_A(PG8_SA(1, 0), a3, voffA);
            PG8_WAIT_V(8); PG8_WAIT_L(0); PG8_BAR; PG8_MMA(1, 0, At, B0); PG8_MMA(1, 1, At, B1); PG8_BAR; PG8_SCHED;
            } else {
            PG8_LDB(B0, 0, 0); PG8_SCHED; PG8_LDA(At, 0, 0); PG8_STAGE_A(PG8_SA(1, 1), a1 + hstep, voffA);
            PG8_WAIT_L(8); PG8_BAR; PG8_WAIT_L(0); PG8_MMA(0, 0, At, B0); PG8_BAR; PG8_SCHED;
            PG8_LDB(B1, 0, 1); PG8_STAGE_B(PG8_SB(0, 0), b2, voffB);
            PG8_BAR; PG8_WAIT_L(0); PG8_MMA(0, 1, At, B1); PG8_BAR;
            PG8_LDA(At, 0, 1); PG8_STAGE_A(PG8_SA(0, 0), a2, voffA);
            PG8_BAR; PG8_WAIT_L(0); PG8_MMA(1, 0, At, B0); PG8_BAR; PG8_SCHED;
            PG8_STAGE_B(PG8_SB(0, 1), b2 + hstepB, voffB);
            PG8_WAIT_V(6); PG8_BAR; PG8_MMA(1, 1, At, B1); PG8_BAR;
            PG8_LDB(B0, 1, 0); PG8_SCHED; PG8_LDA(At, 1, 0); PG8_STAGE_A(PG8_SA(0, 1), a2 + hstep, voffA);
            PG8_WAIT_L(8); PG8_BAR; PG8_WAIT_L(0); PG8_MMA(0, 0, At, B0); PG8_BAR; PG8_SCHED;
            PG8_LDB(B1, 1, 1); PG8_STAGE_B(PG8_SB(1, 0), b3, voffB);
            PG8_BAR; PG8_WAIT_L(0); PG8_MMA(0, 1, At, B1); PG8_BAR;
            PG8_LDA(At, 1, 1); PG8_STAGE_A(PG8_SA(1, 0), a3, voffA);
            PG8_BAR; PG8_WAIT_L(0); PG8_MMA(1, 0, At, B0); PG8_BAR; PG8_SCHED;
            PG8_STAGE_B(PG8_SB(1, 1), b3 + hstepB, voffB);
            PG8_WAIT_V(6); PG8_BAR; PG8_MMA(1, 1, At, B1); PG8_BAR;
            }
        }
        if constexpr (F8 || I8) asm volatile("s_nop 15\n\ts_nop 15" ::: "memory");
        if constexpr (ALIGN_EPI) { if (wr == 0) PG8_BAR; }
        if constexpr (!Epi::AFTER_DRAIN) { int tl_ = tid; asm volatile("" : "+v"(tl_)); E(acc, cur, wr, wc, tl_ & 15, (tl_ >> 4) & 3); S.done(cur); }
        if (!has_next) break;
#pragma unroll
        for (int a = 0; a < 2; ++a)
#pragma unroll
            for (int b = 0; b < 2; ++b)
#pragma unroll
                for (int m = 0; m < 4; ++m)
#pragma unroll
                    for (int n = 0; n < 2; ++n) acc[a][b][m][n] = zero4();
        cur = nxt; cA = nA; cB = nB; ++ui;
        if constexpr (ALIGN_EPI) { if (wr == 1) PG8_BAR; }
    }
    PG8_WAIT_V(0);
    if constexpr (!ALIGN_EPI) { if (wr == 0) PG8_BAR; }
    PG8_BAR;
    if constexpr (Epi::AFTER_DRAIN) { E.fused(acc, cur, wr, wc, fr, fq, lds, wid, lane); S.done(cur); }
#undef PG8_SA
#undef PG8_SB
#undef PG8_STAGE
#undef PG8_STAGE_A
#undef PG8_STAGE_B
#undef PG8_LDA
#undef PG8_LDB
#undef PG8_MMA
#undef PG8_WAIT_V
#undef PG8_WAIT_L
#undef PG8_BAR
#undef PG8_SCHED
}
}
constexpr int NWAVES = 8;
#ifndef MK_PER_PHASE
#define MK_PER_PHASE 0
#endif
constexpr int D = 4096, BATCH = 4, SEQ = 4096, M = BATCH * SEQ, DEPTH = 4, IN_W = 19472, NZ = 19456;
constexpr int OFF_GQ = 0, OFF_GK = 1024, OFF_GV = 2048, OFF_GG = 4096, OFF_SQ = 6144, OFF_SK = 8192, OFF_SV = 8704, OFF_SG = 9216, OFF_GA = 11264, OFF_GB = 15360;
constexpr int LDZ = NZ;
#ifndef NZ_BF_COLS
#define NZ_BF_COLS 3072
#endif
constexpr int NZ_BF = NZ_BF_COLS, NZ_F8 = NZ - NZ_BF;
constexpr float QC_W = 4.0f, QC_X0 = 4.25f, QC_XP = 4.5f, QC_M = 4.3f;
constexpr float W8_SCALE = 64.0f, AB8_SCALE = 8.0f;
constexpr float RMS_EPS = 1e-6f;
constexpr int N_PHASES = 2 + 6 * DEPTH;
constexpr size_t MiB = 1u << 20;
constexpr size_t WS_CTL = 0, CTL_ZERO_BYTES = 1 * MiB;
constexpr size_t WS_WIN = 1 * MiB, WS_WDEC = 609 * MiB, WS_WGLA = 610 * MiB, WS_WSWA = 674 * MiB, WS_WOUT = 738 * MiB;
constexpr size_t WS_XRES = 866 * MiB, WS_XB = 1122 * MiB, WS_Z = 1250 * MiB, WS_GDEC = 1858 * MiB;
constexpr size_t WS_QT = 1859 * MiB, WS_KT = 1891 * MiB, WS_QI = 1923 * MiB, WS_U = 1955 * MiB, WS_SP = 2083 * MiB, WS_DECAY = 2211 * MiB;
constexpr size_t WS_AA = 2212 * MiB, WS_AB = 2276 * MiB, WS_TMP = 2340 * MiB, WS_MERGED = 2596 * MiB, WS_SSQP = 2724 * MiB, WS_X8 = 2936 * MiB, WS_SX = 3000 * MiB, WS_WIN8 = 3001 * MiB, WS_GT = 3321 * MiB, WS_END = 3577 * MiB;
static_assert(WS_WIN8 + (size_t)DEPTH * NZ_F8 * D <= WS_GT && WS_SSQP + 4 * MiB <= WS_X8, "int8 weight copies");
static_assert(WS_WIN + (size_t)DEPTH * NZ * D * 2 <= WS_WDEC && WS_Z + (size_t)M * NZ * 2 <= WS_GDEC && WS_XRES + (size_t)M * D * 4 <= WS_XB, "ws map");
constexpr int CW_TMO = 0, CW_BAR = 4096, CW_TS = 8192;
static_assert(CW_BAR + 3456 <= CW_TS && (size_t)(CW_TS + DEPTH * 256 * 8) * 4 <= CTL_ZERO_BYTES, "CTL map");
constexpr int RING_BYTES = 131072, LDSCTL_OFF = RING_BYTES, MISC_OFF = LDSCTL_OFF + 320, RS_OFF = LDSCTL_OFF + 1024, RS2_OFF = LDSCTL_OFF + 2048, WQ_OFF = LDSCTL_OFF + 3072, RS3_OFF = LDSCTL_OFF + 4096, MQ_OFF = LDSCTL_OFF + 3072 + 512, LDS_BYTES = 147456;

#define GAS __attribute__((address_space(1)))
#define LAS __attribute__((address_space(3)))
typedef unsigned short bf16;
typedef unsigned v4u __attribute__((ext_vector_type(4)));
typedef unsigned v2u __attribute__((ext_vector_type(2)));
typedef float f32x4 __attribute__((ext_vector_type(4)));
typedef short bf16x8 __attribute__((ext_vector_type(8)));
typedef short s16x4 __attribute__((ext_vector_type(4)));
typedef GAS unsigned gu32;
#define RLX_AGENT __ATOMIC_RELAXED, __HIP_MEMORY_SCOPE_AGENT
#define LDS_WAIT() asm volatile("s_waitcnt lgkmcnt(0)" ::: "memory")
__device__ __forceinline__ unsigned f2bf(float f) { unsigned u = __builtin_bit_cast(unsigned, f); return (u + 0x7fffu + ((u >> 16) & 1u)) >> 16; }
__device__ __forceinline__ unsigned pk2(float lo, float hi) { return pg8::cvt_pk_bf16(lo, hi); }
__device__ __forceinline__ float bf2f(unsigned short b) { return __uint_as_float(((unsigned)b) << 16); }
__device__ __forceinline__ float bflo(unsigned w) { return __uint_as_float(w << 16); }
__device__ __forceinline__ float bfhi(unsigned w) { return __uint_as_float(w & 0xffff0000u); }
#define MFMA16(a, b, c) __builtin_amdgcn_mfma_f32_16x16x32_bf16((a), (b), (c), 0, 0, 0)
__device__ __forceinline__ bf16x8 tr_frag(LAS unsigned char* base, int rs, int k0, int n0, int lane) {
    const int g = lane >> 4, q = (lane & 15) >> 2, p = lane & 3;
    LAS unsigned char* a = base + (k0 + 8 * g + q) * rs + (n0 + 4 * p) * 2;
    const s16x4 lo = __builtin_amdgcn_ds_read_tr16_b64_v4i16((LAS s16x4*)a);
    const s16x4 hi = __builtin_amdgcn_ds_read_tr16_b64_v4i16((LAS s16x4*)(a + 4 * rs));
    return (bf16x8){lo[0], lo[1], lo[2], lo[3], hi[0], hi[1], hi[2], hi[3]};
}
#define XB_TMO      128
#define XB_XCNT(j)  (256  + 64 * (j))
#define XB_XSUB(j)  (1280 + 64 * (j))
#define XB_XGEN(j)  (2304 + 64 * (j))
#define XB_TOP      3328
#define XB_TOPGEN   3392
#define XCD_BAR_WORDS 3456
#define XB_SPIN_CAP (1u << 18)

__device__ __forceinline__ unsigned xb_ld(unsigned* p)              { return __hip_atomic_load(p, __ATOMIC_RELAXED, __HIP_MEMORY_SCOPE_AGENT); }
__device__ __forceinline__ unsigned xb_add(unsigned* p, unsigned v) { return __hip_atomic_fetch_add(p, v, __ATOMIC_RELAXED, __HIP_MEMORY_SCOPE_AGENT); }
__device__ __forceinline__ unsigned xb_xcc_id() { return (unsigned)__builtin_amdgcn_s_getreg((3 << 11) | 20) & 0xFu; }
#define XB_SPIN(cond, bar) do { unsigned _sp = 0; while (cond) { __builtin_amdgcn_s_sleep(1); \
    if ((++_sp & 255u) == 0u) { if (xb_ld(&(bar)[XB_TMO])) break; if (_sp > XB_SPIN_CAP) { atomicAdd(&(bar)[XB_TMO], 1u); break; } } } } while (0)

struct XcdBarrier {
    unsigned* bar; unsigned x;
    volatile LAS unsigned* st;
};

__device__ __forceinline__ XcdBarrier xcd_barrier_post(unsigned* bar, volatile LAS unsigned* st) {
    XcdBarrier b; b.bar = bar; b.x = xb_xcc_id(); b.st = st;
    if (threadIdx.x == 0) (void)xb_add(&bar[XB_XCNT(b.x)], 1u);
    return b;
}
__device__ __forceinline__ void xcd_barrier_complete(unsigned* bar, unsigned x, unsigned& nloc, unsigned& nx) {
    const unsigned G = gridDim.x * gridDim.y * gridDim.z;
    unsigned sum, cnt, mine, sp = 0u;
    for (;;) {
        sum = 0u; cnt = 0u; mine = 0u;
#pragma unroll
        for (unsigned j = 0; j < 16; ++j) { const unsigned c = xb_ld(&bar[XB_XCNT(j)]); sum += c; cnt += (c > 0u) ? 1u : 0u; mine = (j == x) ? c : mine; }
        if (sum == G) break;
        __builtin_amdgcn_s_sleep(1);
        if ((++sp & 255u) == 0u) { if (xb_ld(&bar[XB_TMO])) break; if (sp > XB_SPIN_CAP) { atomicAdd(&bar[XB_TMO], 1u); break; } }
    }
    nloc = mine > 0u ? mine : 1u; nx = cnt > 0u ? cnt : 1u;
}

__device__ __forceinline__ void xcd_barrier(const XcdBarrier& b) {
    asm volatile("s_waitcnt vmcnt(0)" ::: "memory");
    __syncthreads();
    if (threadIdx.x == 0) {
        unsigned* bar = b.bar;
        __builtin_amdgcn_s_waitcnt(0);
        unsigned nloc = b.st[0], nx = b.st[1];
        if (nloc == 0u) { xcd_barrier_complete(bar, b.x, nloc, nx); b.st[0] = nloc; b.st[1] = nx; }
        const unsigned old = xb_add(&bar[XB_XSUB(b.x)], 1u);
        const unsigned gen = old / nloc;
        if (old + 1u == (gen + 1u) * nloc) {
            __builtin_amdgcn_fence(__ATOMIC_RELEASE, "agent");
            asm volatile("s_waitcnt vmcnt(0)" ::: "memory");
            const unsigned og = xb_add(&bar[XB_TOP], 1u);
            const unsigned tg = og / nx;
            if (og + 1u == (tg + 1u) * nx) xb_add(&bar[XB_TOPGEN], 1u);
            else XB_SPIN(xb_ld(&bar[XB_TOPGEN]) == tg, bar);
            __builtin_amdgcn_fence(__ATOMIC_ACQUIRE, "agent");
            xb_add(&bar[XB_XGEN(b.x)], 1u);
            asm volatile("s_waitcnt vmcnt(0)" ::: "memory");
        } else {
            XB_SPIN(xb_ld(&bar[XB_XGEN(b.x)]) == gen, bar);
            __builtin_amdgcn_fence(__ATOMIC_ACQUIRE, "agent");
            asm volatile("s_waitcnt vmcnt(0)" ::: "memory");
        }
    }
    __syncthreads();
}
struct Frame {
    LAS unsigned char* lds; volatile LAS unsigned* MISC; gu32* ctl; unsigned char* ws;
    int tid, lane, wave, G;
    const float *x, *norm_g, *w_in, *b_gates, *w_up, *b_dec, *gla_g, *sinks, *w_gla, *w_swa, *w_out, *fin_g; float* out;
};
__device__ __forceinline__ float wave_sum(float v, int lane_) {
#pragma unroll
    for (int o = 1; o < 64; o <<= 1) v += pg8::shx(v, lane_, o);
    return v;
}

__device__ __forceinline__ void p0_transpose_item(const float* W, size_t ldw, int scol, int K, bf16* WT, int drow, const float* gain, float scale, int mode  , LAS unsigned char* scr, int kb, int lane) {
    const bool f8 = mode != 0, had = mode == 3; if (mode == 3) mode = 2;
    const int k0 = 64 * kb, lr = lane >> 4, lc = lane & 15;
    f32x4 v[16];
#pragma unroll
    for (int i = 0; i < 16; ++i) v[i] = *(const GAS f32x4*)(W + (size_t)(k0 + 4 * i + lr) * ldw + scol + 4 * lc);
    if (had) {
#pragma unroll
        for (int i = 0; i < 16; ++i) {
#pragma unroll
            for (int e = 0; e < 4; ++e) { const float o = pg8::shx(v[i][e], lane, 16); v[i][e] = (lane & 16) ? o - v[i][e] : v[i][e] + o; }
#pragma unroll
            for (int e = 0; e < 4; ++e) { const float o = pg8::shx(v[i][e], lane, 32); v[i][e] = (lane & 32) ? o - v[i][e] : v[i][e] + o; } }
#pragma unroll
        for (int i = 0; i < 16; i += 2) { const f32x4 a = v[i] + v[i + 1], b = v[i] - v[i + 1]; v[i] = a; v[i + 1] = b; }
    }
#pragma unroll
    for (int i = 0; i < 16; ++i) { const float gk = gain ? gain[k0 + 4 * i + lr] * scale : scale; f32x4 a = v[i] * gk;
        v2u o;
        if (mode == 2) { unsigned u[4];
            _Pragma("unroll") for (int e = 0; e < 4; ++e) u[e] = __float_as_uint(__builtin_amdgcn_fmed3f(__builtin_fmaf(v[i][e], gk, 12582912.0f), 12582912.0f - 127.0f, 12582912.0f + 127.0f));
            o.x = __builtin_amdgcn_perm(u[1], u[0], 0x05040100u); o.y = __builtin_amdgcn_perm(u[3], u[2], 0x05040100u); }
        else { o.x = pk2(a[0], a[1]); o.y = pk2(a[2], a[3]); }
        *(LAS v2u*)(scr + (4 * i + lr) * 144 + 8 * lc) = o; }
    LDS_WAIT(); asm volatile("" ::: "memory");
#pragma unroll
    for (int kh = 0; kh < 2; ++kh)
#pragma unroll
        for (int nq = 0; nq < 4; ++nq) { const bf16x8 t = tr_frag(scr, 144, 32 * kh, 16 * nq, lane);
            if (!f8) *(GAS bf16x8*)(WT + (size_t)(drow + 16 * nq + lc) * K + k0 + 32 * kh + 8 * lr) = t;
            else if (mode == 2) { const v4u tt = __builtin_bit_cast(v4u, t); v2u o; o.x = __builtin_amdgcn_perm(tt.y, tt.x, 0x06040200u); o.y = __builtin_amdgcn_perm(tt.w, tt.z, 0x06040200u);
                   *(GAS v2u*)((unsigned char*)WT + (size_t)(drow + 16 * nq + lc) * K + pg8::kperm8(k0 + 32 * kh + 8 * lr)) = o; }
            else { int q0 = __builtin_amdgcn_cvt_pk_fp8_f32(bf2f((unsigned short)t[0]), bf2f((unsigned short)t[1]), 0, false); q0 = __builtin_amdgcn_cvt_pk_fp8_f32(bf2f((unsigned short)t[2]), bf2f((unsigned short)t[3]), q0, true);
                   int q1 = __builtin_amdgcn_cvt_pk_fp8_f32(bf2f((unsigned short)t[4]), bf2f((unsigned short)t[5]), 0, false); q1 = __builtin_amdgcn_cvt_pk_fp8_f32(bf2f((unsigned short)t[6]), bf2f((unsigned short)t[7]), q1, true);
                   v2u o; o.x = (unsigned)q0; o.y = (unsigned)q1; *(GAS v2u*)((unsigned char*)WT + (size_t)(drow + 16 * nq + lc) * K + k0 + 32 * kh + 8 * lr) = o; } }
    LDS_WAIT(); asm volatile("" ::: "memory");
}
__device__ __forceinline__ void p0_prologue(Frame& F) {
    LAS unsigned char* scr = F.lds + F.wave * 16384;
    const int gw = blockIdx.x * NWAVES + F.wave, NGW = F.G * NWAVES;
    LAS float* wq = (LAS float*)(F.lds + WQ_OFF); LAS float* wred = (LAS float*)(F.lds + WQ_OFF + 64);
    for (int l = 0; l < DEPTH; ++l) { float s = 0.f;
#pragma unroll 4
        for (int j = 0; j < 16; ++j) { const int k = 256 * j; const float gk = F.norm_g[l * D + k]; const float a = F.w_in[((size_t)l * D + k) * IN_W + 8192 + 2 * F.tid] * gk, b = F.w_in[((size_t)l * D + k) * IN_W + 8192 + 2 * F.tid + 1] * gk; s += a * a + b * b; }
        s = wave_sum(s, F.lane); if (F.lane == 0) wred[l * 8 + F.wave] = s;
        float s2 = 0.f;
#pragma unroll 4
        for (int j = 0; j < 16; ++j) { const float a = F.w_out[((size_t)l * D + 256 * j) * D + 2 * F.tid], b = F.w_out[((size_t)l * D + 256 * j) * D + 2 * F.tid + 1]; s2 += a * a + b * b; }
        s2 = wave_sum(s2, F.lane); if (F.lane == 0) wred[(DEPTH + l) * 8 + F.wave] = s2; }
    __syncthreads();
    if (F.tid < 2 * DEPTH) { float s = 0.f;
#pragma unroll
        for (int w_ = 0; w_ < 8; ++w_) s += wred[F.tid * 8 + w_];
        const float q = 127.0f / QC_W * __builtin_amdgcn_rsqf(s * (1.0f / 16384.0f) + 1e-30f); wq[F.tid] = q; ((float*)(F.ws + WS_SX))[2 * M + F.tid] = q; }
    __syncthreads();
    constexpr int I_IN = 64 * 304, I_GLA = 32 * 64, I_OUT = 64 * 64, I_L = I_IN + 2 * I_GLA + I_OUT;
    for (int it = gw; it < DEPTH * I_L; it += NGW) {
        const int l = it / I_L; int r = it - l * I_L;
        if (r < I_IN) { const int kb = r / 304, nb = r - kb * 304; const int scol = nb < 96 ? nb * 64 : nb * 64 + 16;
            if (nb < NZ_BF / 64) p0_transpose_item(F.w_in + (size_t)l * D * IN_W, IN_W, scol, D, (bf16*)(F.ws + WS_WIN) + (size_t)l * NZ * D, nb * 64, F.norm_g + l * D, 1.0f, 0, scr, kb, F.lane);
            else p0_transpose_item(F.w_in + (size_t)l * D * IN_W, IN_W, scol, D, (bf16*)(F.ws + WS_WIN8 + (size_t)l * NZ_F8 * D), nb * 64 - NZ_BF, F.norm_g + l * D, wq[l], 2, scr, kb, F.lane);
            continue; }
        r -= I_IN;
        if (r < I_GLA) { const int kb = r >> 6, nb = r & 63; p0_transpose_item(F.w_gla + (size_t)l * 2048 * D, D, nb * 64, 2048, (bf16*)(F.ws + WS_WGLA) + (size_t)l * D * 2048, nb * 64, nullptr, 1.0f, 0, scr, kb, F.lane); continue; }
        r -= I_GLA;
        if (r < I_GLA) { const int kb = r >> 6, nb = r & 63; p0_transpose_item(F.w_swa + (size_t)l * 2048 * D, D, nb * 64, 2048, (bf16*)(F.ws + WS_WSWA + (size_t)l * D * 2048), nb * 64, nullptr, W8_SCALE, 1, scr, kb, F.lane); continue; }
        r -= I_GLA;
        { const int kb = r >> 6, nb = r & 63; p0_transpose_item(F.w_out + (size_t)l * D * D, D, nb * 64, D, (bf16*)(F.ws + WS_WOUT + (size_t)l * D * D), nb * 64, nullptr, wq[DEPTH + l] * 0.35355339f, 3, scr, kb, F.lane); }
    }
    for (int idx = blockIdx.x * (NWAVES * 64) + F.tid; idx < DEPTH * 16 * D; idx += F.G * NWAVES * 64) {
        const int l = idx >> 16, j = (idx >> 12) & 15, k = idx & 4095;
        ((bf16*)(F.ws + WS_WDEC))[idx] = (bf16)f2bf(F.norm_g[l * D + k] * F.w_in[((size_t)l * D + k) * IN_W + 6144 + j]);
    }
    float* ssqp = (float*)(F.ws + WS_SSQP); float* sx0 = (float*)(F.ws + WS_SX);
    for (int m = gw; m < M; m += NGW) {
        const GAS f32x4* xr = (const GAS f32x4*)(F.x + (size_t)m * D) + F.lane; GAS v2u* o8 = (GAS v2u*)((bf16*)(F.ws + WS_XB) + (size_t)m * D) + F.lane; GAS unsigned* q8 = (GAS unsigned*)(F.ws + WS_X8 + (size_t)m * D) + F.lane; float s = 0.f;
        v2u w[16];
#pragma unroll
        for (int j = 0; j < 16; ++j) { const f32x4 v = xr[64 * j]; w[j].x = pk2(v.x, v.y); w[j].y = pk2(v.z, v.w); o8[64 * j] = w[j];
            const float r0 = bflo(w[j].x), r1 = bfhi(w[j].x), r2 = bflo(w[j].y), r3 = bfhi(w[j].y); s += (r0 * r0 + r1 * r1) + (r2 * r2 + r3 * r3); }
        s = wave_sum(s, F.lane); ssqp[(size_t)m * 64 + F.lane] = (F.lane == 0) ? s : 0.f;
        const float q = 127.0f / QC_X0 * __builtin_amdgcn_rsqf(s * (1.0f / D) + RMS_EPS);
        if (F.lane == 0) sx0[m] = q;
#pragma unroll
        for (int j = 0; j < 16; ++j) { const int c = 4 * F.lane + 256 * j; *(GAS unsigned*)(F.ws + WS_X8 + (size_t)m * D + pg8::kperm8(c & ~7) + (c & 7)) = pg8::q8x4(bflo(w[j].x), bfhi(w[j].x), bflo(w[j].y), bfhi(w[j].y), q); }
    }
}
__device__ __forceinline__ void final_norm(Frame& F) {
    const int gw = blockIdx.x * NWAVES + F.wave, NGW = F.G * NWAVES;
    const bf16* X = (const bf16*)(F.ws + WS_XB);
    for (int m = gw; m < M; m += NGW) {
        const GAS v4u* xr = (const GAS v4u*)(X + (size_t)m * D) + F.lane; const GAS f32x4* gr = (const GAS f32x4*)F.fin_g + 2 * F.lane; GAS f32x4* orow = (GAS f32x4*)(F.out + (size_t)m * D) + 2 * F.lane;
        v4u v[8]; float s = 0.f;
#pragma unroll
        for (int j = 0; j < 8; ++j) { v[j] = xr[64 * j]; const float r0 = bflo(v[j].x), r1 = bfhi(v[j].x), r2 = bflo(v[j].y), r3 = bfhi(v[j].y), r4 = bflo(v[j].z), r5 = bfhi(v[j].z), r6 = bflo(v[j].w), r7 = bfhi(v[j].w);
            s += ((r0 * r0 + r1 * r1) + (r2 * r2 + r3 * r3)) + ((r4 * r4 + r5 * r5) + (r6 * r6 + r7 * r7)); }
        const float rs = __builtin_amdgcn_rsqf(wave_sum(s, F.lane) * (1.0f / D) + RMS_EPS);
#pragma unroll
        for (int j = 0; j < 8; ++j) { const f32x4 g0 = gr[128 * j], g1 = gr[128 * j + 1];
            orow[128 * j] = (f32x4){bflo(v[j].x) * rs * g0[0], bfhi(v[j].x) * rs * g0[1], bflo(v[j].y) * rs * g0[2], bfhi(v[j].y) * rs * g0[3]};
            orow[128 * j + 1] = (f32x4){bflo(v[j].z) * rs * g1[0], bfhi(v[j].z) * rs * g1[1], bflo(v[j].w) * rs * g1[2], bfhi(v[j].w) * rs * g1[3]}; }
    }
}
__device__ __forceinline__ void gdec_phase(Frame& F, int l) {
    LAS float* red = (LAS float*)F.lds;
    const bf16* Wd = (const bf16*)(F.ws + WS_WDEC) + (size_t)l * 16 * D; const bf16* XBp = (const bf16*)(F.ws + WS_XB); const float* ssqp = (const float*)(F.ws + WS_SSQP); float* GD = (float*)(F.ws + WS_GDEC);
    const int lane = F.lane, fr = lane & 15, fq = lane >> 4;
    for (int rb = blockIdx.x; rb < M / 64; rb += F.G) {
        const int r0 = (F.G == 256) ? ((8 * (rb & 7) + ((rb >> 3) & 7)) * 256 + (rb >> 6) * 64) : rb * 64, k0 = F.wave * 512;
        f32x4 acc[4];
#pragma unroll
        for (int rt = 0; rt < 4; ++rt) acc[rt] = (f32x4){0.f, 0.f, 0.f, 0.f};
#pragma unroll 4
        for (int ks = 0; ks < 16; ++ks) { const int k = k0 + ks * 32 + 8 * fq;
            const bf16x8 X = *(const GAS bf16x8*)(Wd + (size_t)fr * D + k);
#pragma unroll
            for (int rt = 0; rt < 4; ++rt) { const bf16x8 Y = *(const GAS bf16x8*)(XBp + (size_t)(r0 + rt * 16 + fr) * D + k); acc[rt] = MFMA16(X, Y, acc[rt]); } }
#pragma unroll
        for (int rt = 0; rt < 4; ++rt) *(LAS f32x4*)(red + ((F.wave * 4 + rt) * 64 + lane) * 4) = acc[rt];
        __syncthreads();
        if (F.tid < 256) { const int rt = F.tid >> 6, ln = F.tid & 63; f32x4 s = (f32x4){0.f, 0.f, 0.f, 0.f};
#pragma unroll
            for (int w = 0; w < 8; ++w) s += *(LAS f32x4*)(red + ((w * 4 + rt) * 64 + ln) * 4);
            const int row = r0 + rt * 16 + (ln & 15); const float rs = pg8::row_rstd(ssqp, row);
            *(GAS f32x4*)(GD + (size_t)row * 16 + 4 * (ln >> 4)) = s * rs; }
        __syncthreads();
    }
}
constexpr int NGROUP = BATCH * 8 * 8;
constexpr int GA_GD = 0, GA_BL = 4096, GA_KS = GA_BL + 64 * 528, GA_V = GA_KS + 64 * 272, GA_SEG = GA_V + 64 * 528, GA_BRL = GA_SEG + 2048, GA_EB = GA_BRL + 1024, GA_EL = GA_EB + 512, GA_END = GA_EL + 512;
static_assert(GA_END <= RING_BYTES, "GLA-a LDS map");
__device__ __forceinline__ void gla_a_phase(Frame& F, int l) {
    LAS unsigned char* lds = F.lds;
    LAS float* gd = (LAS float*)(lds + GA_GD); LAS float* bL = (LAS float*)(lds + GA_BL); LAS unsigned char* ksL = lds + GA_KS; LAS unsigned char* Vl = lds + GA_V; LAS float* seg = (LAS float*)(lds + GA_SEG); LAS float* brl = (LAS float*)(lds + GA_BRL); LAS float* ebL = (LAS float*)(lds + GA_EB); LAS float* elL = (LAS float*)(lds + GA_EL);
    const int tid = F.tid, lane = F.lane, w = F.wave, d = tid & 127, tq = tid >> 7, fr = lane & 15, fq = lane >> 4;
    const bf16* Z = (const bf16*)(F.ws + WS_Z); const float* GD = (const float*)(F.ws + WS_GDEC);
    bf16* QT = (bf16*)(F.ws + WS_QT); bf16* KT = (bf16*)(F.ws + WS_KT); bf16* SLOC = (bf16*)(F.ws + WS_U);
    float* EBREF = (float*)(F.ws + WS_QI); float* ELR = EBREF + (size_t)BATCH * 8 * 64 * 128; float* DG = ELR + (size_t)BATCH * 8 * 64 * 128;
    const float SC = 0.08838834764831845f;
    f32x4 pgd; v4u pv[4], pq[2], pk[2];
#define GA_FETCH(item_) do { const int n_ = (item_) & 63, h_ = ((item_) >> 6) & 7, b_ = (item_) >> 9, t0_ = b_ * SEQ + n_ * 64; \
        pgd = *(const GAS f32x4*)(GD + (size_t)t0_ * 16 + (tid & 255) * 4); \
        _Pragma("unroll") for (int i = 0; i < 4; ++i) { const int c = tid + 512 * i, t = c >> 5, dv0 = (c & 31) * 8; pv[i] = *(const GAS v4u*)(Z + (size_t)(t0_ + t) * LDZ + OFF_GV + h_ * 256 + dv0); } \
        _Pragma("unroll") for (int i = 0; i < 2; ++i) { const int id = tid + 512 * i, t = id >> 4, d0 = (id & 15) * 8; const size_t zr = (size_t)(t0_ + t) * LDZ + h_ * 128 + d0; pq[i] = *(const GAS v4u*)(Z + zr + OFF_GQ); pk[i] = *(const GAS v4u*)(Z + zr + OFF_GK); } } while (0)
    { const int g0_ = (int)blockIdx.x < NGROUP ? (int)blockIdx.x : NGROUP - 1; GA_FETCH((g0_ >> 3) * 64 + (g0_ & 7) * 8); }
    for (int gi = blockIdx.x; gi < NGROUP; gi += F.G) {
        const int bh = gi >> 3, g = gi & 7, h = bh & 7, b = bh >> 3;
        float wu[16];
#pragma unroll
        for (int r = 0; r < 16; ++r) wu[r] = F.w_up[(size_t)(l * 16 + r) * 1024 + h * 128 + d];
        const float bias = F.b_dec[l * 1024 + h * 128 + d];
        f32x4 acc[8][2];
#pragma unroll
        for (int i = 0; i < 8; ++i) { acc[i][0] = (f32x4){0.f, 0.f, 0.f, 0.f}; acc[i][1] = (f32x4){0.f, 0.f, 0.f, 0.f}; }
        float sumbl = 0.f;
#pragma unroll 1
        for (int j = 0; j < 8; ++j) {
            const int n = 8 * g + j, item = bh * 64 + n, t0 = b * SEQ + n * 64;
            if (tid < 256) *(LAS f32x4*)(gd + tid * 4) = pgd;
#pragma unroll
            for (int i = 0; i < 4; ++i) { const int c = tid + 512 * i, t = c >> 5, dv0 = (c & 31) * 8; *(LAS v4u*)(Vl + t * 528 + dv0 * 2) = pv[i]; }
            v4u q8[2], k8[2];
#pragma unroll
            for (int i = 0; i < 2; ++i) { q8[i] = pq[i]; k8[i] = pk[i]; }
            __syncthreads();
            { const int nx = (j < 7) ? item + 1 : ((gi + F.G) >> 3) * 64 + ((gi + F.G) & 7) * 8; if (j < 7 || gi + F.G < NGROUP) GA_FETCH(nx); }
            float c[16]; float run = 0.f;
#pragma unroll
            for (int i = 0; i < 16; ++i) { const int t = 16 * tq + i; float lg = bias; const f32x4 g0 = *(LAS f32x4*)(gd + t * 16), g1 = *(LAS f32x4*)(gd + t * 16 + 4), g2 = *(LAS f32x4*)(gd + t * 16 + 8), g3 = *(LAS f32x4*)(gd + t * 16 + 12);
                lg += g0[0] * wu[0] + g0[1] * wu[1] + g0[2] * wu[2] + g0[3] * wu[3]; lg += g1[0] * wu[4] + g1[1] * wu[5] + g1[2] * wu[6] + g1[3] * wu[7];
                lg += g2[0] * wu[8] + g2[1] * wu[9] + g2[2] * wu[10] + g2[3] * wu[11]; lg += g3[0] * wu[12] + g3[1] * wu[13] + g3[2] * wu[14] + g3[3] * wu[15];
                const float ls = fminf(lg, 0.f) - __logf(1.0f + __expf(-fabsf(lg))); const float la = fmaxf(ls * (1.0f / 16.0f), -1.0f); run += la; c[i] = run; }
            seg[tq * 128 + d] = run;
            __syncthreads();
            float pre = 0.f;
            if (tq > 0) pre += seg[d]; if (tq > 1) pre += seg[128 + d]; if (tq > 2) pre += seg[256 + d];
#pragma unroll
            for (int i = 0; i < 16; ++i) bL[(16 * tq + i) * 132 + d] = c[i] + pre;
            if (tq == 2) brl[d] = c[0] + pre;
            if (tq == 3) brl[128 + d] = c[15] + pre;
            __syncthreads();
            if (tid < 128) { const float bref = brl[tid], blast = brl[128 + tid], eb = __expf(bref), el = __expf(blast - bref); ebL[tid] = eb; elL[tid] = el; sumbl += blast;
                EBREF[(size_t)item * 128 + tid] = eb; ELR[(size_t)item * 128 + tid] = el; }
#pragma unroll
            for (int i = 0; i < 2; ++i) { const int id = tid + 512 * i, t = id >> 4, d0 = (id & 15) * 8;
                const f32x4 b0 = *(LAS f32x4*)(bL + t * 132 + d0), b1 = *(LAS f32x4*)(bL + t * 132 + d0 + 4), r0 = *(LAS f32x4*)(brl + d0), r1 = *(LAS f32x4*)(brl + d0 + 4);
                const float bb[8] = {b0[0], b0[1], b0[2], b0[3], b1[0], b1[1], b1[2], b1[3]}, rr[8] = {r0[0], r0[1], r0[2], r0[3], r1[0], r1[1], r1[2], r1[3]};
                const unsigned qw[4] = {q8[i].x, q8[i].y, q8[i].z, q8[i].w}, kw[4] = {k8[i].x, k8[i].y, k8[i].z, k8[i].w};
                float oq[8], ok[8];
#pragma unroll
                for (int jj = 0; jj < 8; ++jj) { const float q = ((jj & 1) ? bfhi(qw[jj >> 1]) : bflo(qw[jj >> 1])) * SC, k = (jj & 1) ? bfhi(kw[jj >> 1]) : bflo(kw[jj >> 1]);
                    const float e1 = __expf(bb[jj] - rr[jj]), e2 = __builtin_amdgcn_rcpf(e1);
                    oq[jj] = q * e1; ok[jj] = k * e2; }
                const size_t o = (size_t)(t0 + t) * 1024 + h * 128 + d0;
                v4u w4; w4.x = pk2(oq[0], oq[1]); w4.y = pk2(oq[2], oq[3]); w4.z = pk2(oq[4], oq[5]); w4.w = pk2(oq[6], oq[7]); *(GAS v4u*)(QT + o) = w4;
                w4.x = pk2(ok[0], ok[1]); w4.y = pk2(ok[2], ok[3]); w4.z = pk2(ok[4], ok[5]); w4.w = pk2(ok[6], ok[7]); *(GAS v4u*)(KT + o) = w4; *(LAS v4u*)(ksL + t * 272 + d0 * 2) = w4; }
            __syncthreads();
#pragma unroll
            for (int dkt = 0; dkt < 8; ++dkt) { const f32x4 e4 = *(LAS f32x4*)(ebL + dkt * 16 + 4 * fq); acc[dkt][0] *= e4; acc[dkt][1] *= e4; }
#pragma unroll
            for (int ks = 0; ks < 2; ++ks) { bf16x8 Y[2];
#pragma unroll
                for (int jv = 0; jv < 2; ++jv) Y[jv] = tr_frag(Vl, 528, ks * 32, (2 * w + jv) * 16, lane);
#pragma unroll
                for (int dkt = 0; dkt < 8; ++dkt) { const bf16x8 X = tr_frag(ksL, 272, ks * 32, dkt * 16, lane);
                    acc[dkt][0] = MFMA16(X, Y[0], acc[dkt][0]); acc[dkt][1] = MFMA16(X, Y[1], acc[dkt][1]); } }
#pragma unroll
            for (int dkt = 0; dkt < 8; ++dkt) { const f32x4 e4 = *(LAS f32x4*)(elL + dkt * 16 + 4 * fq); acc[dkt][0] *= e4; acc[dkt][1] *= e4; }
            __syncthreads();
        }
#pragma unroll
        for (int dkt = 0; dkt < 8; ++dkt)
#pragma unroll
            for (int jv = 0; jv < 2; ++jv) { const int dv = (2 * w + jv) * 16 + fr, dk = dkt * 16 + 4 * fq; const f32x4 a = acc[dkt][jv];
                v2u o; o.x = pk2(a[0], a[1]); o.y = pk2(a[2], a[3]); *(GAS v2u*)(SLOC + ((size_t)gi * 256 + dv) * 128 + dk) = o; }
        if (tid < 128) DG[(size_t)gi * 128 + tid] = __expf(sumbl);
    }
#undef GA_FETCH
}
__device__ __forceinline__ void gla_scan_phase(Frame& F) {
    const bf16* SLOC = (const bf16*)(F.ws + WS_U); bf16* SST = (bf16*)(F.ws + WS_SP); const float* DG = (const float*)(F.ws + WS_QI) + (size_t)2 * BATCH * 8 * 64 * 128;
    for (int idx = blockIdx.x * (NWAVES * 64) + F.tid; idx < BATCH * 8 * 256 * 16; idx += F.G * NWAVES * 64) {
        const int bh = idx >> 12, dv = (idx >> 4) & 255, dk0 = (idx & 15) * 8;
        float S[8]; float z0_; asm volatile("v_mov_b32 %0, 0" : "=v"(z0_));
#pragma unroll
        for (int j = 0; j < 8; ++j) S[j] = z0_;
#pragma unroll
        for (int g = 0; g < 8; ++g) { const size_t gi = (size_t)bh * 8 + g, off = (gi * 256 + dv) * 128 + dk0;
            const v4u u = *(const GAS v4u*)(SLOC + off); const f32x4 d0 = *(const GAS f32x4*)(DG + gi * 128 + dk0), d1 = *(const GAS f32x4*)(DG + gi * 128 + dk0 + 4);
            v4u o; o.x = pk2(S[0], S[1]); o.y = pk2(S[2], S[3]); o.z = pk2(S[4], S[5]); o.w = pk2(S[6], S[7]); *(GAS v4u*)(SST + off) = o;
            S[0] = d0[0] * S[0] + bflo(u.x); S[1] = d0[1] * S[1] + bfhi(u.x); S[2] = d0[2] * S[2] + bflo(u.y); S[3] = d0[3] * S[3] + bfhi(u.y);
            S[4] = d1[0] * S[4] + bflo(u.z); S[5] = d1[1] * S[5] + bfhi(u.z); S[6] = d1[2] * S[6] + bflo(u.w); S[7] = d1[3] * S[7] + bfhi(u.w); }
    }
}
constexpr int GC_QT = 0, GC_KT = 17408, GC_V = 34816, GC_AL = GC_V + 64 * 528, GC_PART = GC_AL + 64 * 144, GC_EB = GC_PART + 2048, GC_EL = GC_EB + 512, GC_END = GC_EL + 512;
static_assert(GC_END <= RING_BYTES, "GLA-c LDS map");
__device__ __forceinline__ void gla_c_phase(Frame& F, int l) {
    LAS unsigned char* lds = F.lds;
    LAS bf16* qT = (LAS bf16*)(lds + GC_QT); LAS bf16* kT = (LAS bf16*)(lds + GC_KT); LAS unsigned char* Vl = lds + GC_V; LAS bf16* Al = (LAS bf16*)(lds + GC_AL);
    LAS float* part = (LAS float*)(lds + GC_PART); LAS float* ebL = (LAS float*)(lds + GC_EB); LAS float* elL = (LAS float*)(lds + GC_EL);
    const int tid = F.tid, lane = F.lane, w = F.wave, fr = lane & 15, fq = lane >> 4;
    const bf16* Z = (const bf16*)(F.ws + WS_Z); const bf16* QT = (const bf16*)(F.ws + WS_QT); const bf16* KT = (const bf16*)(F.ws + WS_KT); const bf16* SST = (const bf16*)(F.ws + WS_SP);
    const float* EBREF = (const float*)(F.ws + WS_QI); const float* ELR = EBREF + (size_t)BATCH * 8 * 64 * 128;
    bf16* AA = (bf16*)(F.ws + WS_AA);
    v4u rq[2], rk[2], rv[4]; float reb, rel;
#define GC_FETCH(item_) do { const int n_ = (item_) & 63, h_ = ((item_) >> 6) & 7, b_ = (item_) >> 9, t0_ = b_ * SEQ + n_ * 64; \
        _Pragma("unroll") for (int i = 0; i < 2; ++i) { const int c = tid + 512 * i, t = c >> 4, d0 = (c & 15) * 8; const size_t g_ = (size_t)(t0_ + t) * 1024 + h_ * 128 + d0; rq[i] = *(const GAS v4u*)(QT + g_); rk[i] = *(const GAS v4u*)(KT + g_); } \
        _Pragma("unroll") for (int i = 0; i < 4; ++i) { const int c = tid + 512 * i, t = c >> 5, dv0 = (c & 31) * 8; rv[i] = *(const GAS v4u*)(Z + (size_t)(t0_ + t) * LDZ + OFF_GV + h_ * 256 + dv0); } \
        reb = EBREF[(size_t)(item_) * 128 + (tid & 127)]; rel = ELR[(size_t)(item_) * 128 + (tid & 127)]; } while (0)
    { const int g0_ = (int)blockIdx.x < NGROUP ? (int)blockIdx.x : NGROUP - 1; GC_FETCH((g0_ >> 3) * 64 + (g0_ & 7) * 8); }
    for (int gi = blockIdx.x; gi < NGROUP; gi += F.G) {
        const int bh = gi >> 3, g = gi & 7, h = bh & 7, b = bh >> 3;
        f32x4 Sa[8][2];
#pragma unroll
        for (int dkt = 0; dkt < 8; ++dkt)
#pragma unroll
            for (int jv = 0; jv < 2; ++jv) { const v2u s = *(const GAS v2u*)(SST + ((size_t)gi * 256 + (2 * w + jv) * 16 + fr) * 128 + dkt * 16 + 4 * fq); Sa[dkt][jv] = (f32x4){bflo(s.x), bfhi(s.x), bflo(s.y), bfhi(s.y)}; }
#pragma unroll 1
        for (int j = 0; j < 8; ++j) {
            const int n = 8 * g + j, item = bh * 64 + n, t0 = b * SEQ + n * 64;
#pragma unroll
            for (int i = 0; i < 2; ++i) { const int c = tid + 512 * i, t = c >> 4, d0 = (c & 15) * 8; *(LAS v4u*)(qT + t * 136 + d0) = rq[i]; *(LAS v4u*)(kT + t * 136 + d0) = rk[i]; }
#pragma unroll
            for (int i = 0; i < 4; ++i) { const int c = tid + 512 * i, t = c >> 5, dv0 = (c & 31) * 8; *(LAS v4u*)(Vl + t * 528 + dv0 * 2) = rv[i]; }
            if (tid < 128) { ebL[tid] = reb; elL[tid] = rel; }
            __syncthreads();
            { const int nx = (j < 7) ? item + 1 : ((gi + F.G) >> 3) * 64 + ((gi + F.G) & 7) * 8; if (j < 7 || gi + F.G < NGROUP) GC_FETCH(nx); }
            { const int it = w >> 1;
#pragma unroll
              for (int jj = 0; jj < 2; ++jj) { const int jt = 2 * (w & 1) + jj; f32x4 a = (f32x4){0.f, 0.f, 0.f, 0.f};
                  if (jt <= it) {
#pragma unroll
                      for (int ks = 0; ks < 4; ++ks) { const bf16x8 X = *(LAS bf16x8*)(kT + (jt * 16 + fr) * 136 + ks * 32 + 8 * fq); const bf16x8 Y = *(LAS bf16x8*)(qT + (it * 16 + fr) * 136 + ks * 32 + 8 * fq); a = MFMA16(X, Y, a); }
                      const int ii = it * 16 + fr, j0 = jt * 16 + 4 * fq;
#pragma unroll
                      for (int e = 0; e < 4; ++e) if (j0 + e > ii) a[e] = 0.f;
                  }
                  v2u o; o.x = pk2(a[0], a[1]); o.y = pk2(a[2], a[3]); *(LAS v2u*)(Al + (it * 16 + fr) * 72 + jt * 16 + 4 * fq) = o; } }
#pragma unroll
            for (int dkt = 0; dkt < 8; ++dkt) { const f32x4 e4 = *(LAS f32x4*)(ebL + dkt * 16 + 4 * fq); Sa[dkt][0] *= e4; Sa[dkt][1] *= e4; }
            __syncthreads();
            f32x4 acc[2][4];
#pragma unroll
            for (int jv = 0; jv < 2; ++jv)
#pragma unroll
                for (int tt = 0; tt < 4; ++tt) acc[jv][tt] = (f32x4){0.f, 0.f, 0.f, 0.f};
#pragma unroll
            for (int ks = 0; ks < 4; ++ks) { bf16x8 X[2];
#pragma unroll
                for (int jv = 0; jv < 2; ++jv) { const f32x4 s0 = Sa[2 * ks][jv], s1 = Sa[2 * ks + 1][jv]; v4u p; p.x = pk2(s0[0], s0[1]); p.y = pk2(s0[2], s0[3]); p.z = pk2(s1[0], s1[1]); p.w = pk2(s1[2], s1[3]); X[jv] = __builtin_bit_cast(bf16x8, p); }
#pragma unroll
                for (int tt = 0; tt < 4; ++tt) { const v2u y0 = *(LAS v2u*)(qT + (tt * 16 + fr) * 136 + ks * 32 + 4 * fq), y1 = *(LAS v2u*)(qT + (tt * 16 + fr) * 136 + ks * 32 + 16 + 4 * fq);
                    v4u yy; yy.x = y0.x; yy.y = y0.y; yy.z = y1.x; yy.w = y1.y; const bf16x8 Y = __builtin_bit_cast(bf16x8, yy);
                    acc[0][tt] = MFMA16(X[0], Y, acc[0][tt]); acc[1][tt] = MFMA16(X[1], Y, acc[1][tt]); } }
#pragma unroll
            for (int ks = 0; ks < 2; ++ks) { bf16x8 X[2];
#pragma unroll
                for (int jv = 0; jv < 2; ++jv) X[jv] = tr_frag(Vl, 528, ks * 32, (2 * w + jv) * 16, lane);
#pragma unroll
                for (int tt = 0; tt < 4; ++tt) { if (ks == 1 && tt < 2) continue; const bf16x8 Y = *(LAS bf16x8*)(Al + (tt * 16 + fr) * 72 + ks * 32 + 8 * fq); acc[0][tt] = MFMA16(X[0], Y, acc[0][tt]); acc[1][tt] = MFMA16(X[1], Y, acc[1][tt]); }
#pragma unroll
                for (int dkt = 0; dkt < 8; ++dkt) { const bf16x8 K = tr_frag((LAS unsigned char*)kT, 272, ks * 32, dkt * 16, lane);
                    Sa[dkt][0] = MFMA16(K, X[0], Sa[dkt][0]); Sa[dkt][1] = MFMA16(K, X[1], Sa[dkt][1]); } }
#pragma unroll
            for (int dkt = 0; dkt < 8; ++dkt) { const f32x4 e4 = *(LAS f32x4*)(elL + dkt * 16 + 4 * fq); Sa[dkt][0] *= e4; Sa[dkt][1] *= e4; }
            v2u gg[4][2];
#pragma unroll
            for (int jv = 0; jv < 2; ++jv)
#pragma unroll
                for (int tt = 0; tt < 4; ++tt) gg[tt][jv] = *(const GAS v2u*)(Z + (size_t)(t0 + tt * 16 + fr) * LDZ + OFF_GG + h * 256 + (2 * w + jv) * 16 + 4 * fq);
#pragma unroll
            for (int tt = 0; tt < 4; ++tt) { float s = 0.f;
#pragma unroll
                for (int jv = 0; jv < 2; ++jv) { const f32x4 a = acc[jv][tt]; s += (a[0] * a[0] + a[1] * a[1]) + (a[2] * a[2] + a[3] * a[3]); }
                s += pg8::shx(s, lane, 16); s += pg8::shx(s, lane, 32);
                if (fq == 0) part[(tt * 16 + fr) * 8 + w] = s; }
            __syncthreads();
#pragma unroll
            for (int tt = 0; tt < 4; ++tt) { const int t = tt * 16 + fr; const f32x4 p0 = *(LAS f32x4*)(part + t * 8), p1 = *(LAS f32x4*)(part + t * 8 + 4);
                const float rs = __builtin_amdgcn_rsqf(((p0[0] + p0[1]) + (p0[2] + p0[3]) + (p1[0] + p1[1]) + (p1[2] + p1[3])) * (1.0f / 256.0f) + RMS_EPS);
#pragma unroll
                for (int jv = 0; jv < 2; ++jv) { const int dv = (2 * w + jv) * 16 + 4 * fq; const v2u gv = gg[tt][jv]; const f32x4 a = acc[jv][tt]; const f32x4 gn = *(const GAS f32x4*)(F.gla_g + l * 256 + dv);
                    const float g0 = bflo(gv.x), g1 = bfhi(gv.x), g2 = bflo(gv.y), g3 = bfhi(gv.y);
                    const float o0 = a[0] * rs * gn[0] * g0 * __builtin_amdgcn_rcpf(1.0f + __expf(-g0)), o1 = a[1] * rs * gn[1] * g1 * __builtin_amdgcn_rcpf(1.0f + __expf(-g1));
                    const float o2 = a[2] * rs * gn[2] * g2 * __builtin_amdgcn_rcpf(1.0f + __expf(-g2)), o3 = a[3] * rs * gn[3] * g3 * __builtin_amdgcn_rcpf(1.0f + __expf(-g3));
                    v2u o; o.x = pk2(o0, o1); o.y = pk2(o2, o3); *(GAS v2u*)(AA + (size_t)(t0 + t) * 2048 + h * 256 + dv) = o; } }
        }
    }
    __syncthreads();
#undef GC_FETCH
}
constexpr int SW_K = 0, SW_V = 256 * 144, SW_P = SW_V + 288 * 144, SW_END = SW_P + 8 * 16 * 336;
static_assert(SW_END <= RING_BYTES, "SWA LDS map");
__device__ __forceinline__ void swa_phase(Frame& F, int l) {
    LAS unsigned char* lds = F.lds;
    LAS bf16* Kl = (LAS bf16*)(lds + SW_K); LAS unsigned char* Vl = lds + SW_V;
    const int tid = F.tid, lane = F.lane, w = F.wave, fr = lane & 15, fq = lane >> 4;
    LAS bf16* Pl = (LAS bf16*)(lds + SW_P + w * (16 * 336));
    const bf16* Z = (const bf16*)(F.ws + WS_Z); unsigned char* AB8 = F.ws + WS_AB;
    for (int i = tid; i < 32 * 144 / 4; i += NWAVES * 64) ((LAS unsigned*)(Vl + 256 * 144))[i] = 0u;
    const int NITEM = BATCH * 32 * 8;
    f32x4 pen0, pen8;
#pragma unroll
    for (int e = 0; e < 4; ++e) { pen0[e] = (4 * fq + e <= fr) ? -1e30f : 0.f; pen8[e] = (4 * fq + e > fr) ? -1e30f : 0.f; }
    v4u kreg[4], vreg[4];
#define SW_FETCH(item_) do { const int g_ = (item_) & 7, qb_ = ((item_) >> 3) & 31, b_ = (item_) >> 8, q0_ = b_ * SEQ + qb_ * 128; \
        _Pragma("unroll") for (int i = 0; i < 4; ++i) { const int c = tid + 512 * i, kr = c >> 3, d0 = (c & 7) * 8; int tok = q0_ - 128 + kr; if (tok < b_ * SEQ) tok = b_ * SEQ; \
            const size_t zr = (size_t)tok * LDZ + g_ * 64 + d0; kreg[i] = *(const GAS v4u*)(Z + zr + OFF_SK); vreg[i] = *(const GAS v4u*)(Z + zr + OFF_SV); } } while (0)
    SW_FETCH((int)blockIdx.x < NITEM ? (int)blockIdx.x : NITEM - 1);
    for (int item = blockIdx.x; item < NITEM; item += F.G) {
        const int g = item & 7, qb = (item >> 3) & 31, b = item >> 8, q0 = b * SEQ + qb * 128;
#pragma unroll
        for (int i = 0; i < 4; ++i) { const int c = tid + 512 * i, kr = c >> 3, d0 = (c & 7) * 8; *(LAS v4u*)(Kl + kr * 72 + d0) = kreg[i]; *(LAS v4u*)(Vl + kr * 144 + d0 * 2) = vreg[i]; }
        const int r = w >> 1, hq = g * 4 + r; const float sink = F.sinks[l * 32 + hq];
        bf16x8 Yc[2]; v2u gc[4];
        { const size_t qrow = (size_t)(q0 + 64 * (w & 1) + fr);
#pragma unroll
          for (int ks = 0; ks < 2; ++ks) Yc[ks] = *(const GAS bf16x8*)(Z + qrow * LDZ + OFF_SQ + hq * 64 + ks * 32 + 8 * fq);
#pragma unroll
          for (int c = 0; c < 4; ++c) gc[c] = *(const GAS v2u*)(Z + qrow * LDZ + OFF_SG + hq * 64 + c * 16 + 4 * fq); }
        __syncthreads();
        if (item + F.G < NITEM) SW_FETCH(item + F.G);
#pragma unroll 1
        for (int qt = 0; qt < 4; ++qt) {
            const int ql0 = 64 * (w & 1) + 16 * qt; const size_t qrow = (size_t)(q0 + ql0 + fr);
            bf16x8 Yn[2]; v2u gn[4];
            { const size_t qn = (size_t)(q0 + 64 * (w & 1) + 16 * ((qt + 1) & 3) + fr);
#pragma unroll
              for (int ks = 0; ks < 2; ++ks) Yn[ks] = *(const GAS bf16x8*)(Z + qn * LDZ + OFF_SQ + hq * 64 + ks * 32 + 8 * fq);
#pragma unroll
              for (int c = 0; c < 4; ++c) gn[c] = *(const GAS v2u*)(Z + qn * LDZ + OFF_SG + hq * 64 + c * 16 + 4 * fq); }
            f32x4 S[9];
#pragma unroll
            for (int kt = 0; kt < 9; ++kt) { f32x4 a = (f32x4){0.f, 0.f, 0.f, 0.f};
#pragma unroll
                for (int ks = 0; ks < 2; ++ks) { const bf16x8 X = *(LAS bf16x8*)(Kl + (ql0 + 16 * kt + fr) * 72 + ks * 32 + 8 * fq); a = MFMA16(X, Yc[ks], a); }
                S[kt] = a; }
            const int qpos = qb * 128 + ql0 + fr; const float CS = 0.125f * 1.4426950408889634f, sink2 = sink * 1.4426950408889634f;
            S[0] += pen0; S[8] += pen8;
            if (qb == 0) {
#pragma unroll
                for (int kt = 0; kt < 8; ++kt)
#pragma unroll
                    for (int e = 0; e < 4; ++e) if (qpos - 128 + 16 * kt + 4 * fq + e - fr < 0) S[kt][e] = -1e30f; }
            float mr = S[0][0];
#pragma unroll
            for (int kt = 0; kt < 9; ++kt) mr = fmaxf(fmaxf(mr, fmaxf(S[kt][0], S[kt][1])), fmaxf(S[kt][2], S[kt][3]));
            mr = fmaxf(mr, pg8::shx(mr, lane, 16)); mr = fmaxf(mr, pg8::shx(mr, lane, 32));
            const float m2 = fmaxf(mr * CS, sink2);
            float sum = 0.f;
#pragma unroll
            for (int kt = 0; kt < 9; ++kt) { f32x4 p;
#pragma unroll
                for (int e = 0; e < 4; ++e) { p[e] = __builtin_amdgcn_exp2f(S[kt][e] * CS - m2); sum += p[e]; }
                v2u o; o.x = pk2(p[0], p[1]); o.y = pk2(p[2], p[3]); *(LAS v2u*)(Pl + fr * 168 + 16 * kt + 4 * fq) = o; }
            { unsigned z0 = 0u; asm volatile("" : "+v"(z0)); v2u o; o.x = z0; o.y = z0; *(LAS v2u*)(Pl + fr * 168 + 144 + 4 * fq) = o; }
            sum += pg8::shx(sum, lane, 16); sum += pg8::shx(sum, lane, 32);
            const float iv = __builtin_amdgcn_rcpf(sum + __builtin_amdgcn_exp2f(sink2 - m2)) * AB8_SCALE;
            LDS_WAIT(); asm volatile("" ::: "memory");
            f32x4 O[4];
#pragma unroll
            for (int c = 0; c < 4; ++c) O[c] = (f32x4){0.f, 0.f, 0.f, 0.f};
#pragma unroll
            for (int k5 = 0; k5 < 5; ++k5) { const bf16x8 Y = *(LAS bf16x8*)(Pl + fr * 168 + k5 * 32 + 8 * fq);
#pragma unroll
                for (int c = 0; c < 4; ++c) { const bf16x8 X = tr_frag(Vl, 144, ql0 + 32 * k5, c * 16, lane); O[c] = MFMA16(X, Y, O[c]); } }
#pragma unroll
            for (int c = 0; c < 4; ++c) { const int dd = hq * 64 + c * 16 + 4 * fq; const v2u gv = gc[c];
                const float g0 = bflo(gv.x), g1 = bfhi(gv.x), g2 = bflo(gv.y), g3 = bfhi(gv.y);
                const float o0 = O[c][0] * iv * g0 * __builtin_amdgcn_rcpf(1.0f + __expf(-g0)), o1 = O[c][1] * iv * g1 * __builtin_amdgcn_rcpf(1.0f + __expf(-g1));
                const float o2 = O[c][2] * iv * g2 * __builtin_amdgcn_rcpf(1.0f + __expf(-g2)), o3 = O[c][3] * iv * g3 * __builtin_amdgcn_rcpf(1.0f + __expf(-g3));
                int q = __builtin_amdgcn_cvt_pk_fp8_f32(o0, o1, 0, false); q = __builtin_amdgcn_cvt_pk_fp8_f32(o2, o3, q, true); *(GAS unsigned*)(AB8 + qrow * 2048 + dd) = (unsigned)q; }
            asm volatile("" ::: "memory");
#pragma unroll
            for (int ks = 0; ks < 2; ++ks) Yc[ks] = Yn[ks];
#pragma unroll
            for (int c = 0; c < 4; ++c) gc[c] = gn[c];
        }
        __syncthreads();
    }
#undef SW_FETCH
}
#ifndef GEMM_BAL
#define GEMM_BAL true
#endif
#ifndef REP_PRO
#define REP_PRO 1
#endif
#ifndef REP_P1
#define REP_P1 1
#endif
#ifndef REP_GA
#define REP_GA 1
#endif
#ifndef REP_SWA
#define REP_SWA 1
#endif
#ifndef REP_SCAN
#define REP_SCAN 1
#endif
#ifndef REP_GC
#define REP_GC 1
#endif
#ifndef REP_P3
#define REP_P3 1
#endif
#ifndef REP_BAR
#define REP_BAR 1
#endif
#ifndef REP_P4
#define REP_P4 1
#endif
struct Args { const float* in[12]; float* out; unsigned char* ws; int ph_lo, ph_hi; };
static_assert(sizeof(Args) == 14 * 8 + 8, "Args has no holes");
__global__ void __launch_bounds__(NWAVES * 64, 2) hybrid_fwd(Args args) {
    extern __shared__ __attribute__((aligned(16))) unsigned char lds[];
    Frame F;
    F.lds = (LAS unsigned char*)lds; F.MISC = (volatile LAS unsigned*)(F.lds + MISC_OFF);
    F.tid = threadIdx.x; F.lane = F.tid & 63; F.wave = __builtin_amdgcn_readfirstlane(F.tid >> 6); F.G = gridDim.x;
    F.ws = args.ws; F.ctl = (gu32*)(args.ws + WS_CTL);
    F.x = args.in[0]; F.norm_g = args.in[1]; F.w_in = args.in[2]; F.b_gates = args.in[3]; F.w_up = args.in[4]; F.b_dec = args.in[5]; F.gla_g = args.in[6]; F.sinks = args.in[7];
    F.w_gla = args.in[8]; F.w_swa = args.in[9]; F.w_out = args.in[10]; F.fin_g = args.in[11]; F.out = args.out;
    for (int u = F.tid; u < (LDS_BYTES - LDSCTL_OFF) / 4; u += NWAVES * 64) ((LAS unsigned*)(F.lds + LDSCTL_OFF))[u] = 0u;
    __syncthreads();
    XcdBarrier bar; bar.bar = (unsigned*)(F.ctl + CW_BAR); bar.x = 0; bar.st = nullptr;
    if (!MK_PER_PHASE) bar = xcd_barrier_post((unsigned*)(F.ctl + CW_BAR), F.MISC + 8);
    const int wv0 = __builtin_amdgcn_readfirstlane(threadIdx.x >> 6);
    const int lo = args.ph_lo, hi = args.ph_hi;
#if MK_PER_PHASE
#define IN(k) (lo <= (k) && (k) < hi)
#else
#define IN(k) true
#endif
#define PHASE_BEGIN() do { unsigned m_ = ~0u; asm volatile("" : "+s"(m_)); int t_ = wv0 * 64 + (int)__builtin_amdgcn_mbcnt_hi(m_, __builtin_amdgcn_mbcnt_lo(m_, 0u)); asm volatile("" : "+v"(t_)); F.tid = t_; F.lane = t_ & 63; F.wave = __builtin_amdgcn_readfirstlane(t_ >> 6); unsigned long long z_ = 0ull; asm volatile("" : "+s"(z_)); unsigned char* w_ = args.ws + z_; F.ws = w_; F.ctl = (gu32*)(w_ + WS_CTL); } while (0)
#define SEAM(k) do { if (IN(k) && IN((k) + 1)) { unsigned long long z_ = 0ull; asm volatile("" : "+s"(z_)); bar.bar = (unsigned*)(args.ws + WS_CTL + z_) + CW_BAR; for (int rb_ = 0; rb_ < REP_BAR; ++rb_) xcd_barrier(bar); } } while (0)
    if (IN(0)) for (int rep = 0; rep < REP_PRO; ++rep) { PHASE_BEGIN(); p0_prologue(F); }
    SEAM(0);
    for (int l = 0; l < DEPTH; ++l) {
        const int p = 1 + 6 * l;
        if (IN(p)) for (int rep = 0; rep < REP_P1; ++rep) {
            PHASE_BEGIN(); const bf16* XBp = (const bf16*)(F.ws + WS_XB); bf16* Zp = (bf16*)(F.ws + WS_Z);
            gdec_phase(F, l);
            pg8::StaticOrder S; S.init(M, NZ_BF, F.G, (int)blockIdx.x);
            pg8::EpiZ E; E.Z = Zp; E.P = (const float*)(F.ws + WS_SSQP); E.rsl = (const LAS float*)(F.lds + RS_OFF); E.mul = 1.0f;
            const float* SXc = (const float*)(F.ws + WS_SX) + (size_t)(l & 1) * M; float* SXn = (float*)(F.ws + WS_SX) + (size_t)((l + 1) & 1) * M; const float iwq = 1.0f / ((const float*)(F.ws + WS_SX))[2 * M + l];
            { pg8::Unit u0; const bool has = S.next(0, u0); E.pm0 = has ? u0.pm : -1;
              if (has && F.tid < 256) { const int row = u0.pm * 256 + F.tid; const float rstd = pg8::row_rstd(E.P, row); ((LAS float*)(F.lds + RS_OFF))[F.tid] = rstd;
                  ((LAS float*)(F.lds + RS2_OFF))[F.tid] = rstd * iwq * __builtin_amdgcn_rcpf(SXc[row]); SXn[row] = (127.0f / QC_XP) * rstd; ((LAS float*)(F.lds + RS3_OFF))[F.tid] = (127.0f / QC_XP) * rstd; }
              __syncthreads(); }
            { pg8::Gemm g{XBp, (const bf16*)(F.ws + WS_WIN) + (size_t)l * NZ * D, M, NZ_BF, D};
              pg8::gemm_phase<pg8::EpiZ, pg8::StaticOrder, true, true, false, GEMM_BAL>(F.lds, g, S, E, F.tid); }
            { pg8::StaticOrder S8; S8.init(M, NZ_F8, F.G, (int)blockIdx.x); pg8::Unit u0; const bool has = S8.next(0, u0);
              pg8::EpiZ8 E8{Zp + NZ_BF, E.P, SXc, iwq, (!has || u0.pm != E.pm0) ? -1 : E.pm0, (const LAS float*)(F.lds + RS2_OFF), F.ws + WS_GT, (OFF_GA - NZ_BF) / 256};
              pg8::Gemm g{(const bf16*)(F.ws + WS_X8), (const bf16*)(F.ws + WS_WIN8 + (size_t)l * NZ_F8 * D), M, NZ_F8, D / 2};
              pg8::gemm_phase<pg8::EpiZ8, pg8::StaticOrder, true, true, false, GEMM_BAL, true>(F.lds, g, S8, E8, F.tid); }
        }
        SEAM(p);
        if (IN(p + 1)) { for (int rep = 0; rep < REP_GA; ++rep) { PHASE_BEGIN(); gla_a_phase(F, l); } for (int rep = 0; rep < REP_SWA; ++rep) { PHASE_BEGIN(); swa_phase(F, l); } }
        SEAM(p + 1);
        if (IN(p + 2)) for (int rep = 0; rep < REP_SCAN; ++rep) { PHASE_BEGIN(); gla_scan_phase(F); }
        SEAM(p + 2);
        if (IN(p + 3)) for (int rep = 0; rep < REP_GC; ++rep) { PHASE_BEGIN(); gla_c_phase(F, l); }
        SEAM(p + 3);
        if (IN(p + 4)) for (int rep = 0; rep < REP_P3; ++rep) {
            { PHASE_BEGIN(); bf16* Zp = (bf16*)(F.ws + WS_Z); pg8::Gemm g{(const bf16*)(F.ws + WS_AA), (const bf16*)(F.ws + WS_WGLA) + (size_t)l * D * 2048, M, D, 2048}; pg8::StaticOrder S; S.init(M, D, F.G, (int)blockIdx.x);
              LAS float* mred = (LAS float*)(F.lds + MQ_OFF + 16); if (F.tid < 8) mred[F.tid] = 0.f; __syncthreads();
              int nu = ((M / 256) * (D / 256) - (int)blockIdx.x + F.G - 1) / F.G; asm volatile("" : "+s"(nu));
              pg8::EpiGateA E{F.ws + WS_GT, F.b_gates + (size_t)(l * 2 + 0) * D, F.ws + WS_TMP, (LAS float*)mred};
              pg8::gemm_phase<pg8::EpiGateA, pg8::StaticOrder, true, true, false, GEMM_BAL>(F.lds, g, S, E, F.tid);
              __syncthreads();
              if (F.tid == 0) { float t = 0.f;
#pragma unroll
                  for (int w_ = 0; w_ < 8; ++w_) t += mred[w_];
                  *(LAS float*)(F.lds + MQ_OFF) = (127.0f / QC_M) * __builtin_amdgcn_rsqf(t / (65536.0f * (float)(nu > 0 ? nu : 1)) + 1e-30f); }
              __syncthreads(); }
            { PHASE_BEGIN(); bf16* Zp = (bf16*)(F.ws + WS_Z); pg8::Gemm g{(const bf16*)(F.ws + WS_AB), (const bf16*)(F.ws + WS_WSWA + (size_t)l * D * 2048), M, D, 1024}; pg8::StaticOrder S; S.init(M, D, F.G, (int)blockIdx.x);
              pg8::EpiGateB8 E{F.ws + WS_GT + (size_t)1024 * 131072, F.b_gates + (size_t)(l * 2 + 1) * D, F.ws + WS_TMP, F.ws + WS_MERGED, 1.0f / (W8_SCALE * AB8_SCALE), *(const LAS float*)(F.lds + MQ_OFF) * 0.35355339f};
              pg8::gemm_phase<pg8::EpiGateB8, pg8::StaticOrder, true, true, true, GEMM_BAL>(F.lds, g, S, E, F.tid); }
        }
        SEAM(p + 4);
        if (IN(p + 5)) for (int rep = 0; rep < REP_P4; ++rep) {
            PHASE_BEGIN(); pg8::Gemm g{(const bf16*)(F.ws + WS_MERGED), (const bf16*)(F.ws + WS_WOUT + (size_t)l * D * D), M, D, D / 2};
            pg8::EpiRes E{(bf16*)(F.ws + (rep ? WS_TMP : WS_XB)), (float*)(F.ws + (rep ? WS_TMP + 192 * MiB : WS_SSQP)), F.ws + (rep ? WS_TMP + 128 * MiB : WS_X8), (const float*)(F.ws + WS_SX) + (size_t)((l + 1) & 1) * M, (const LAS float*)(F.lds + RS3_OFF), -1, 1.0f / (*(const LAS float*)(F.lds + MQ_OFF) * ((const float*)(F.ws + WS_SX))[2 * M + DEPTH + l])};
            { pg8::StaticOrder S0; S0.init(M, D, F.G, (int)blockIdx.x); pg8::Unit u0; if (S0.next(0, u0)) E.pm0 = u0.pm; }
#if defined(PROBE_P4_HOT)
            if (rep) { pg8::HotOrder S; S.init(M, D, F.G, (int)blockIdx.x); pg8::gemm_phase<pg8::EpiRes, pg8::HotOrder, false, true, false, GEMM_BAL, true>(F.lds, g, S, E, F.tid); } else
#endif
            { pg8::StaticOrder S; S.init(M, D, F.G, (int)blockIdx.x); pg8::gemm_phase<pg8::EpiRes, pg8::StaticOrder, true, true, false, GEMM_BAL, true>(F.lds, g, S, E, F.tid); }
        }
        SEAM(p + 5);

    }
    if (IN(N_PHASES - 1)) { PHASE_BEGIN(); final_norm(F); }
#undef IN
#undef SEAM
}

extern "C" void kernel_launch(void* const* d_in, const int* in_sizes, int n_in, void* d_out, int out_size, void* d_ws, size_t ws_size, hipStream_t stream) {
    static int grid = 0;
    if (grid == 0) {
        if (n_in != 12 || in_sizes[0] != M * D || out_size != M * D || ws_size < WS_END) { fprintf(stderr, "kernel_launch: unexpected shapes (n_in %d, in0 %d, out %d, ws %zu < %zu); nothing launched\n", n_in, n_in > 0 ? in_sizes[0] : -1, out_size, ws_size, (size_t)WS_END); grid = -1; return; }
        int dev = 0, cus = 0, per_cu = 0;
        if (hipGetDevice(&dev) != hipSuccess || hipDeviceGetAttribute(&cus, hipDeviceAttributeMultiprocessorCount, dev) != hipSuccess) { grid = -1; return; }
        if (hipFuncSetAttribute((const void*)hybrid_fwd, hipFuncAttributeMaxDynamicSharedMemorySize, LDS_BYTES) != hipSuccess) { fprintf(stderr, "kernel_launch: hipFuncSetAttribute failed\n"); grid = -1; return; }
        if (hipOccupancyMaxActiveBlocksPerMultiprocessor(&per_cu, (const void*)hybrid_fwd, NWAVES * 64, LDS_BYTES) != hipSuccess || per_cu < 1) { fprintf(stderr, "kernel_launch: occupancy query reports %d blocks per CU\n", per_cu); }
        (void)hipGetLastError();
        grid = cus;
    }
    if (grid < 0) return;
    if (hipMemsetAsync((char*)d_ws + WS_CTL, 0, CTL_ZERO_BYTES, stream) != hipSuccess) return;
    Args a{};
    for (int i = 0; i < 12; ++i) a.in[i] = (const float*)d_in[i];
    a.out = (float*)d_out; a.ws = (unsigned char*)d_ws;
#if MK_PER_PHASE
    for (int ph = 0; ph < N_PHASES; ++ph) { a.ph_lo = ph; a.ph_hi = ph + 1; hipLaunchKernelGGL(hybrid_fwd, dim3(grid), dim3(NWAVES * 64), LDS_BYTES, stream, a); }
#else
    a.ph_lo = 0; a.ph_hi = N_PHASES; hipLaunchKernelGGL(hybrid_fwd, dim3(grid), dim3(NWAVES * 64), LDS_BYTES, stream, a);
#endif
    const hipError_t le = hipPeekAtLastError();
    if (le != hipSuccess) fprintf(stderr, "kernel_launch: launch failed: %s\n", hipGetErrorName(le));
}
```
